# Optimizing an MI355X kernel written in HIP

```python
import jax
import jax.numpy as jnp
from jax import lax
import numpy as np

D_MODEL = 1024
BATCH = 8
SEQ = 2048
DEPTH = 1

CHUNK = 64
HEAD_DIM = 64
N_HEADS_A = 8
N_HEADS_B = 8
WIDTH_A = N_HEADS_A * HEAD_DIM
WIDTH_B = N_HEADS_B * HEAD_DIM
BAND_CHUNKS = 9
MAX_REL = 128
ROPE_THETA = 500000.0
ROPE_DIM = HEAD_DIM // 4
N_IDX_HEADS = 8
IDX_DIM = 64
TOPK_MAX = 256
QBLOCK_B = CHUNK
N_EXPERTS = 64
N_EXPERT_GROUPS = 8
EXPERTS_PER_GROUP = N_EXPERTS // N_EXPERT_GROUPS
TOPK_GROUPS = 4
TOPK_EXPERTS = 8
D_EXPERT = 256
D_SHARED = 256
ROUTED_SCALE = 1.0
N_MOD = 6
DEEPNORM_ALPHA = (2.0 * DEPTH) ** 0.25
DEEPNORM_BETA = (8.0 * DEPTH) ** -0.25
LN_EPS = 1e-5
IN_SPLITS = (WIDTH_A, WIDTH_A, WIDTH_A, WIDTH_B, WIDTH_B, WIDTH_B,
             N_IDX_HEADS * IDX_DIM, IDX_DIM, N_IDX_HEADS, D_MODEL, D_MODEL)
D_IN = sum(IN_SPLITS)

kernel_name = 'hybrid_chunk_band_dsa_moe_block'


def layer_norm(z, gain=None, bias=None):
    zf = z.astype(jnp.float32)
    mu = zf.mean(-1, keepdims=True)
    var = jnp.square(zf - mu).mean(-1, keepdims=True)
    y = (zf - mu) * lax.rsqrt(var + LN_EPS)
    if gain is not None:
        y = y * gain.astype(jnp.float32) + bias.astype(jnp.float32)
    return y.astype(z.dtype)


def split_cols(z, sizes):
    outs, start = [], 0
    for n in sizes:
        outs.append(z[..., start:start + n])
        start += n
    return outs


def rotary_tables(positions, dtype):
    inv_freq = ROPE_THETA ** (-jnp.arange(0, ROPE_DIM, 2, dtype=jnp.float32) / ROPE_DIM)
    ang = positions.astype(jnp.float32)[..., None] * inv_freq
    return jnp.cos(ang).astype(dtype), jnp.sin(ang).astype(dtype)


def apply_rope(z, cos, sin):
    half = ROPE_DIM // 2
    z1, z2, rest = z[..., :half], z[..., half:ROPE_DIM], z[..., ROPE_DIM:]
    return jnp.concatenate([z1 * cos - z2 * sin, z2 * cos + z1 * sin, rest], axis=-1)


def chunk_band_attention(q, k, v, rel_bias):
    b, s, h, dh = q.shape
    n_chunks = s // CHUNK
    pad = (BAND_CHUNKS - 1) * CHUNK
    band = BAND_CHUNKS * CHUNK
    kp = jnp.pad(k, ((0, 0), (pad, 0), (0, 0), (0, 0)))
    vp = jnp.pad(v, ((0, 0), (pad, 0), (0, 0), (0, 0)))
    q_band_pos = jnp.arange(CHUNK)[:, None] + pad
    k_band_pos = jnp.arange(band)[None, :]
    rel_idx = jnp.clip(q_band_pos - k_band_pos, -MAX_REL, MAX_REL) + MAX_REL
    bias = rel_bias[:, rel_idx].astype(jnp.float32)
    scale = dh ** -0.5

    def one_chunk(ci):
        start = ci * CHUNK
        qc = lax.dynamic_slice_in_dim(q, start, CHUNK, axis=1)
        kc = lax.dynamic_slice_in_dim(kp, start, band, axis=1)
        vc = lax.dynamic_slice_in_dim(vp, start, band, axis=1)
        sc = jnp.einsum('bihd,bjhd->bhij', qc, kc).astype(jnp.float32) * scale + bias
        valid = (start - pad + jnp.arange(band)) >= 0
        sc = jnp.where(valid, sc, -jnp.inf)
        p = jax.nn.softmax(sc, axis=-1).astype(vc.dtype)
        return jnp.einsum('bhij,bjhd->bihd', p, vc)

    out = lax.map(one_chunk, jnp.arange(n_chunks))
    return out.transpose(1, 0, 2, 3, 4).reshape(b, s, h, dh)


def indexer_sparse_attention(q, k, v, q_idx, k_idx, w_idx):
    b, s, h, dh = q.shape
    k_sel = min(TOPK_MAX, s // 4)
    n_blocks = s // QBLOCK_B
    key_pos = jnp.arange(s)
    scale = dh ** -0.5
    idx_scale = IDX_DIM ** -0.5

    def one_block(bi):
        start = bi * QBLOCK_B
        qb = lax.dynamic_slice_in_dim(q, start, QBLOCK_B, axis=1)
        qib = lax.dynamic_slice_in_dim(q_idx, start, QBLOCK_B, axis=1)
        wb = lax.dynamic_slice_in_dim(w_idx, start, QBLOCK_B, axis=1)
        t_pos = start + jnp.arange(QBLOCK_B)
        limit = (t_pos // CHUNK + 1) * CHUNK
        admissible = key_pos[None, :] < limit[:, None]
        logits = jax.nn.relu(jnp.einsum('bthd,bsd->bths', qib, k_idx).astype(jnp.float32) * idx_scale)
        score = jnp.einsum('bths,bth->bts', logits, wb.astype(jnp.float32))
        score = jnp.where(admissible, score, -jnp.inf)
        top_val, top_idx = lax.top_k(score, k_sel)
        sel_valid = jnp.isfinite(top_val)
        kg = jax.vmap(lambda kk, ii: kk[ii])(k, top_idx)
        vg = jax.vmap(lambda vv, ii: vv[ii])(v, top_idx)
        sc = jnp.einsum('bthd,btkhd->bthk', qb, kg).astype(jnp.float32) * scale
        sc = jnp.where(sel_valid[:, :, None, :], sc, -jnp.inf)
        p = jax.nn.softmax(sc, axis=-1).astype(vg.dtype)
        return jnp.einsum('bthk,btkhd->bthd', p, vg)

    out = lax.map(one_block, jnp.arange(n_blocks))
    return out.transpose(1, 0, 2, 3, 4).reshape(b, s, h, dh)


def hybrid_mixer(u, cos, sin, w_in, rel_bias, idx_k_norm_g, idx_k_norm_b, w_branch_a, w_branch_b, w_out):
    b, s, _ = u.shape
    proj = jnp.dot(u, w_in)
    qa, ka, va, qb, kb, vb, qi, ki, wi, ga, gb = split_cols(proj, IN_SPLITS)
    oa = chunk_band_attention(qa.reshape(b, s, N_HEADS_A, HEAD_DIM),
                              ka.reshape(b, s, N_HEADS_A, HEAD_DIM),
                              va.reshape(b, s, N_HEADS_A, HEAD_DIM), rel_bias)
    cos4, sin4 = cos[:, :, None, :], sin[:, :, None, :]
    qb = apply_rope(qb.reshape(b, s, N_HEADS_B, HEAD_DIM), cos4, sin4)
    kb = apply_rope(kb.reshape(b, s, N_HEADS_B, HEAD_DIM), cos4, sin4)
    vb = vb.reshape(b, s, N_HEADS_B, HEAD_DIM)
    qi = apply_rope(qi.reshape(b, s, N_IDX_HEADS, IDX_DIM), cos4, sin4)
    ki = apply_rope(layer_norm(ki, idx_k_norm_g, idx_k_norm_b), cos, sin)
    wi = wi * (N_IDX_HEADS ** -0.5)
    ob = indexer_sparse_attention(qb, kb, vb, qi, ki, wi)
    ya = jnp.dot(oa.reshape(b, s, WIDTH_A), w_branch_a)
    yb = jnp.dot(ob.reshape(b, s, WIDTH_B), w_branch_b)
    merged = jax.nn.sigmoid(ga) * ya + jax.nn.sigmoid(gb) * yb
    return jnp.dot(merged, w_out)


def moe_ffn(u, w_router, router_bias, w_exp_gate, w_exp_up, w_exp_down, w_sh_gate, w_sh_up, w_sh_down):
    b, s, d = u.shape
    t = u.reshape(b * s, d)
    aff = jax.nn.sigmoid(jnp.dot(t, w_router).astype(jnp.float32))
    biased = aff + router_bias.astype(jnp.float32)
    grouped = biased.reshape(-1, N_EXPERT_GROUPS, EXPERTS_PER_GROUP)
    group_score = lax.top_k(grouped, 2)[0].sum(-1)
    _, top_groups = lax.top_k(group_score, TOPK_GROUPS)
    group_mask = jax.nn.one_hot(top_groups, N_EXPERT_GROUPS, dtype=jnp.float32).sum(1) > 0
    expert_mask = jnp.repeat(group_mask, EXPERTS_PER_GROUP, axis=1)
    _, top_e = lax.top_k(jnp.where(expert_mask, biased, -jnp.inf), TOPK_EXPERTS)
    top_aff = jnp.take_along_axis(aff, top_e, axis=1)
    top_w = top_aff / top_aff.sum(-1, keepdims=True) * ROUTED_SCALE
    combine = jnp.einsum('tk,tke->te', top_w,
                         jax.nn.one_hot(top_e, N_EXPERTS, dtype=jnp.float32)).astype(u.dtype)
    y = jnp.dot(jax.nn.silu(jnp.dot(t, w_sh_gate)) * jnp.dot(t, w_sh_up), w_sh_down)
    for g in range(N_EXPERT_GROUPS):
        sl = slice(g * EXPERTS_PER_GROUP, (g + 1) * EXPERTS_PER_GROUP)
        hg = jax.nn.silu(jnp.einsum('td,edf->tef', t, w_exp_gate[sl])) * jnp.einsum('td,edf->tef', t, w_exp_up[sl])
        y = y + jnp.einsum('tef,efd->td', hg * combine[:, sl, None], w_exp_down[sl])
    return y.reshape(b, s, d)


def setup_inputs(seed: int = 0) -> dict:
    key = jax.random.key(seed)
    ks = jax.random.split(key, 24)
    f32 = jnp.float32
    L, D = DEPTH, D_MODEL

    def nrm(k, shape, scale):
        return jax.random.normal(k, shape, f32) * scale

    x = nrm(ks[0], (BATCH, SEQ, D), 1.0)
    c = nrm(ks[1], (BATCH, D), 1.0)
    offsets = jax.random.randint(ks[2], (BATCH, 1), 0, 4096, dtype=jnp.int32)
    positions = offsets + jnp.arange(SEQ, dtype=jnp.int32)[None, :]
    return {
        'x': x,
        'c': c,
        'positions': positions,
        'w_ada': nrm(ks[3], (L, D, N_MOD * D), 0.5 * D ** -0.5),
        'b_ada': nrm(ks[4], (L, N_MOD * D), 0.01),
        'w_in': nrm(ks[5], (L, D, D_IN), D ** -0.5),
        'rel_bias': nrm(ks[6], (L, N_HEADS_A, 2 * MAX_REL + 1), 0.1),
        'idx_k_norm_g': 1.0 + nrm(ks[7], (L, IDX_DIM), 0.02),
        'idx_k_norm_b': nrm(ks[8], (L, IDX_DIM), 0.02),
        'w_branch_a': nrm(ks[9], (L, WIDTH_A, D), WIDTH_A ** -0.5),
        'w_branch_b': nrm(ks[10], (L, WIDTH_B, D), WIDTH_B ** -0.5),
        'w_out': nrm(ks[11], (L, D, D), DEEPNORM_BETA * D ** -0.5),
        'ln1_g': 1.0 + nrm(ks[12], (L, D), 0.02),
        'ln1_b': nrm(ks[13], (L, D), 0.02),
        'w_router': nrm(ks[14], (L, D, N_EXPERTS), D ** -0.5),
        'router_bias': nrm(ks[15], (L, N_EXPERTS), 0.01),
        'w_exp_gate': nrm(ks[16], (L, N_EXPERTS, D, D_EXPERT), D ** -0.5),
        'w_exp_up': nrm(ks[17], (L, N_EXPERTS, D, D_EXPERT), D ** -0.5),
        'w_exp_down': nrm(ks[18], (L, N_EXPERTS, D_EXPERT, D), DEEPNORM_BETA * D_EXPERT ** -0.5),
        'w_sh_gate': nrm(ks[19], (L, D, D_SHARED), D ** -0.5),
        'w_sh_up': nrm(ks[20], (L, D, D_SHARED), D ** -0.5),
        'w_sh_down': nrm(ks[21], (L, D_SHARED, D), DEEPNORM_BETA * D_SHARED ** -0.5),
        'ln2_g': 1.0 + nrm(ks[22], (L, D), 0.02),
        'ln2_b': nrm(ks[23], (L, D), 0.02),
    }


def reference(x, c, positions, w_ada, b_ada, w_in, rel_bias, idx_k_norm_g, idx_k_norm_b,
              w_branch_a, w_branch_b, w_out, ln1_g, ln1_b, w_router, router_bias,
              w_exp_gate, w_exp_up, w_exp_down, w_sh_gate, w_sh_up, w_sh_down, ln2_g, ln2_b):
    cos, sin = rotary_tables(positions, x.dtype)
    c_act = jax.nn.silu(c)
    for l in range(DEPTH):
        mod = jnp.dot(c_act, w_ada[l]) + b_ada[l]
        sh1, sc1, g1, sh2, sc2, g2 = jnp.split(mod[:, None, :], N_MOD, axis=-1)
        u = layer_norm(x) * (1 + sc1) + sh1
        mix = hybrid_mixer(u, cos, sin, w_in[l], rel_bias[l], idx_k_norm_g[l], idx_k_norm_b[l],
                           w_branch_a[l], w_branch_b[l], w_out[l])
        x = layer_norm(DEEPNORM_ALPHA * x + g1 * mix, ln1_g[l], ln1_b[l])
        u2 = layer_norm(x) * (1 + sc2) + sh2
        ffn = moe_ffn(u2, w_router[l], router_bias[l], w_exp_gate[l], w_exp_up[l], w_exp_down[l],
                      w_sh_gate[l], w_sh_up[l], w_sh_down[l])
        x = layer_norm(DEEPNORM_ALPHA * x + g2 * ffn, ln2_g[l], ln2_b[l])
    return x
```

```cpp
#include <hip/hip_runtime.h>
#include <hip/hip_bf16.h>
#include <cstdio>
#include <cstdint>
#include <cmath>
#ifndef MK_NAIVE_MASK
#define MK_NAIVE_MASK 0
#define MK_N_LAUNCHES 15
#endif
namespace pg8 {
#define PG8_LAS __attribute__((address_space(3)))
typedef unsigned short bf16_t;
typedef short bf16x8 __attribute__((ext_vector_type(8)));
typedef float f32x4 __attribute__((ext_vector_type(4)));
typedef float f32x2 __attribute__((ext_vector_type(2)));
typedef unsigned u32x4 __attribute__((ext_vector_type(4)));
typedef unsigned u32x2 __attribute__((ext_vector_type(2)));
constexpr int BM = 256, BK = 64, HALF = 128, HTB = HALF * BK * 2  , STAGE_BYTES = 8 * HTB, NXCD = 8, WGM = 8;

__host__ __device__ __forceinline__ int lds_byte(int r, int c) { const int st = (r >> 4) * 2 + (c >> 5), rr = r & 15, cc = c & 31, ob = rr * 64 + cc * 2; return st * 1024 + (ob ^ (((ob >> 9) & 1) << 5)); }
__host__ __device__ __forceinline__ void stage_rc(int b, int& R, int& C) { const int st = b / 1024, sb = b % 1024, swz = sb ^ (((sb >> 9) & 1) << 5); R = (st >> 1) * 16 + swz / 64; C = (st & 1) * 32 + (swz % 64) / 2; }
__host__ __device__ __forceinline__ int perm32(int rho) { const int n = rho >> 4, i = rho & 15; return 8 * (i >> 2) + 4 * n + (i & 3); }

struct Unit { int pm, pn, e, nrows; };

struct DenseOrder {
    int nM, nN, nwg, G, c; unsigned arow; const char* Bt; size_t btile;
    __device__ void init(int M, int N, int K, const void* Bt_, int G_, int c_) { nM = M / BM; nN = N / BM; nwg = nM * nN; G = G_; c = c_; arow = (unsigned)K * 2u; Bt = (const char*)Bt_; btile = (size_t)BM * K * 2; }
    __device__ __forceinline__ bool next(int i, Unit& u) const {
        const long L = (long)i * G + c; if (L >= nwg) return false;
        int wgid = (int)L; { const int q = nwg / NXCD, r = nwg % NXCD, xcd = wgid % NXCD, off = wgid / NXCD; wgid = (xcd < r ? xcd * (q + 1) : r * (q + 1) + (xcd - r) * q) + off; }
        const int nig = WGM * nN, gid = wgid / nig, fm = gid * WGM, gsz = (nM - fm) < WGM ? (nM - fm) : WGM;
        u.pm = fm + ((wgid % nig) % gsz); u.pn = (wgid % nig) / gsz; u.e = 0; u.nrows = 256; return true;
    }
    __device__ __forceinline__ unsigned a_off(const Unit& u, int row) const { return (unsigned)(u.pm * BM + row) * arow; }
    __device__ __forceinline__ const char* b_ptr(const Unit& u) const { return Bt + (size_t)u.pn * btile; }
};

__device__ __forceinline__ unsigned cvt_pk_bf16(float lo, float hi) { unsigned r; asm volatile("v_cvt_pk_bf16_f32 %0, %1, %2" : "=v"(r) : "v"(lo), "v"(hi)); return r; }

struct PanelStats {
    unsigned* xbuf;
    unsigned* cnt;
    unsigned* tmo;
    int ntn; float eps;
    unsigned code;
    __device__ __forceinline__ bool run(const f32x4 (&v)[2][2][4][2], const Unit& u, int wr, int wc, int fr, int fq, PG8_LAS unsigned char* lds, int wid, int lane) const {
        typedef float f32x2v __attribute__((ext_vector_type(2)));
        PG8_LAS f32x2v* P = (PG8_LAS f32x2v*)lds;
        PG8_LAS f32x2v* S = (PG8_LAS f32x2v*)(lds + 8192);
        PG8_LAS unsigned* flag = (PG8_LAS unsigned*)(lds + 8192 + 2048);
#pragma unroll
        for (int ai = 0; ai < 2; ++ai)
#pragma unroll
            for (int m = 0; m < 4; ++m) {
                float s = 0.f;
#pragma unroll
                for (int bj = 0; bj < 2; ++bj)
#pragma unroll
                    for (int n = 0; n < 2; ++n) { const f32x4 x = v[ai][bj][m][n]; s += (x[0] + x[1]) + (x[2] + x[3]); }
                s += __shfl_xor(s, 16); s += __shfl_xor(s, 32);
                const float mw = s * (1.0f / 64.0f); float q = 0.f;
#pragma unroll
                for (int bj = 0; bj < 2; ++bj)
#pragma unroll
                    for (int n = 0; n < 2; ++n) { const f32x4 d = v[ai][bj][m][n] - mw; q += (d[0] * d[0] + d[1] * d[1]) + (d[2] * d[2] + d[3] * d[3]); }
                q += __shfl_xor(q, 16); q += __shfl_xor(q, 32);
                if (fq == 0) P[(ai * HALF + wr * 64 + m * 16 + fr) * 4 + wc] = (f32x2v){mw, q};
            }
        asm volatile("s_waitcnt lgkmcnt(0)" ::: "memory"); __builtin_amdgcn_s_barrier(); asm volatile("" ::: "memory");
        const int row = wid * 32 + (lane & 31);
        if (lane < 32) {
            const f32x2v a = P[row * 4 + 0], b = P[row * 4 + 1], c = P[row * 4 + 2], d = P[row * 4 + 3];
            const float mt = (a.x + b.x + c.x + d.x) * 0.25f;
            const float da = a.x - mt, db = b.x - mt, dc = c.x - mt, dd = d.x - mt;
            const float m2 = (a.y + b.y) + (c.y + d.y) + 64.0f * ((da * da + db * db) + (dc * dc + dd * dd));
            unsigned long long* slot = (unsigned long long*)xbuf + ((size_t)(u.pm * BM + row) * 4 + u.pn);
            __hip_atomic_store(slot, ((unsigned long long)__float_as_uint(m2) << 32) | __float_as_uint(mt), __ATOMIC_RELAXED, __HIP_MEMORY_SCOPE_AGENT);
        }
        asm volatile("s_waitcnt vmcnt(0)" ::: "memory");
        if (lane == 0) __hip_atomic_fetch_add(cnt + 64 * u.pm, 1u, __ATOMIC_RELAXED, __HIP_MEMORY_SCOPE_AGENT);
        if (wid == 0) {
            bool dead = false; const unsigned long long t0 = __builtin_amdgcn_s_memrealtime(); const unsigned want = 8u * (unsigned)ntn;
            for (;;) {
                if ((unsigned)__builtin_amdgcn_readfirstlane(__hip_atomic_load(cnt + 64 * u.pm, __ATOMIC_RELAXED, __HIP_MEMORY_SCOPE_AGENT)) >= want) break;
                if (__builtin_amdgcn_s_memrealtime() - t0 > 2000000ull) {
                    if (lane == 0) { unsigned expect = 0u; __hip_atomic_compare_exchange_strong(tmo + 1, &expect, code | (unsigned)(u.pm & 0xff), __ATOMIC_RELAXED, __ATOMIC_RELAXED, __HIP_MEMORY_SCOPE_AGENT);
                                     __hip_atomic_store(tmo, 1u, __ATOMIC_RELAXED, __HIP_MEMORY_SCOPE_AGENT); }
                    dead = true; break; }
                __builtin_amdgcn_s_sleep(2);
            }
            __builtin_amdgcn_fence(__ATOMIC_ACQUIRE, "agent");
            if (lane == 0) flag[0] = dead ? 1u : 0u;
        }
        asm volatile("s_waitcnt vmcnt(0) lgkmcnt(0)" ::: "memory"); __builtin_amdgcn_s_barrier(); asm volatile("" ::: "memory");
        const bool bad = flag[0] != 0u;
        if (lane < 32) {
            const unsigned long long* slot = (const unsigned long long*)xbuf + (size_t)(u.pm * BM + row) * 4; float mt[4], m2[4]; float ms = 0.f;
#pragma unroll
            for (int t = 0; t < 4; ++t) { if (t < ntn) { const unsigned long long w = __hip_atomic_load(slot + t, __ATOMIC_RELAXED, __HIP_MEMORY_SCOPE_AGENT); mt[t] = __uint_as_float((unsigned)w); m2[t] = __uint_as_float((unsigned)(w >> 32)); } else { mt[t] = 0.f; m2[t] = 0.f; } ms += mt[t]; }
            const float mean = ms / (float)ntn; float q = 0.f;
#pragma unroll
            for (int t = 0; t < 4; ++t) if (t < ntn) { const float dm = mt[t] - mean; q += m2[t] + 256.0f * dm * dm; }
            S[row] = (f32x2v){mean, 1.0f / sqrtf(q / (256.0f * (float)ntn) + eps)};
        }
        asm volatile("s_waitcnt lgkmcnt(0)" ::: "memory"); __builtin_amdgcn_s_barrier(); asm volatile("" ::: "memory");
        return bad;
    }
};

struct Gemm { const bf16_t* A; int K; };

template <class Epi, class Sched, bool ALIGN_EPI = false>
__device__ __forceinline__ void gemm_phase(PG8_LAS unsigned char* lds, const Gemm g, const Sched& S, const Epi& E) {
    int tid_ = threadIdx.x; asm volatile("" : "+v"(tid_));
    const int tid = tid_, wid = __builtin_amdgcn_readfirstlane(tid >> 6), lane = tid & 63, wr = wid >> 2, wc = wid & 3, fr = lane & 15, fq = lane >> 4;
    const int K = g.K, nt = K / BK;
    int RA[2], CA2[2]; unsigned voffB[2];
#pragma unroll
    for (int i = 0; i < 2; ++i) { int R, C; stage_rc(tid * 16 + i * 8192, R, C); const int Rb = Epi::PERM ? ((R & ~31) + perm32(R & 31)) : R;
        RA[i] = R; CA2[i] = C * 2; voffB[i] = (unsigned)(Rb * K + C) * 2u; }
    const size_t kstep = (size_t)(BK * 2);
    const size_t hstep = (size_t)HALF * K * 2;
    const unsigned ldsw = (unsigned)wid * 1024u;
    const int aoff = lds_byte(wr * 64 + fr, fq * 8), boff = lds_byte(wc * 32 + fr, fq * 8);
    const char* Abase = (const char*)g.A;
#define PG8_SA(b, h) (((b) * 2 + (h)) * HTB)
#define PG8_SB(b, h) ((4 + (b) * 2 + (h)) * HTB)
#define PG8_STAGE(bufoff, gbase, voff) do { _Pragma("unroll") for (int _i = 0; _i < 2; ++_i) \
        __builtin_amdgcn_global_load_lds((const unsigned*)((const char*)(gbase) + (voff)[_i]), (PG8_LAS unsigned*)(lds + (bufoff) + ldsw + _i * 8192), 16, 0, 0); } while (0)
#define PG8_STAGEA(bufoff, offs, koff) do { _Pragma("unroll") for (int _i = 0; _i < 2; ++_i) \
        __builtin_amdgcn_global_load_lds((const unsigned*)((Abase + (size_t)(koff)) + (size_t)(offs)[_i]), (PG8_LAS unsigned*)(lds + (bufoff) + ldsw + _i * 8192), 16, 0, 0); } while (0)
#define PG8_LDA(dst, b, h) do { _Pragma("unroll") for (int m = 0; m < 4; ++m) _Pragma("unroll") for (int k = 0; k < 2; ++k) dst[m][k] = *(const PG8_LAS bf16x8*)(lds + PG8_SA(b, h) + aoff + m * 2048 + k * 1024); } while (0)
#define PG8_LDB(dst, b, h) do { _Pragma("unroll") for (int n = 0; n < 2; ++n) _Pragma("unroll") for (int k = 0; k < 2; ++k) dst[n][k] = *(const PG8_LAS bf16x8*)(lds + PG8_SB(b, h) + boff + n * 2048 + k * 1024); } while (0)
#define PG8_MMA(ai, bj, At, Bt) do { __builtin_amdgcn_s_setprio(1); _Pragma("unroll") for (int m = 0; m < 4; ++m) _Pragma("unroll") for (int n = 0; n < 2; ++n) _Pragma("unroll") for (int k = 0; k < 2; ++k) \
        acc[ai][bj][m][n] = __builtin_amdgcn_mfma_f32_16x16x32_bf16(Bt[n][k], At[m][k], acc[ai][bj][m][n], 0, 0, 0); __builtin_amdgcn_s_setprio(0); } while (0)
#define PG8_WAIT_V(n) asm volatile("s_waitcnt vmcnt(" #n ")" ::: "memory")
#define PG8_WAIT_L(n) asm volatile("s_waitcnt lgkmcnt(" #n ")" ::: "memory")
#define PG8_BAR __builtin_amdgcn_s_barrier()
#define PG8_SCHED __builtin_amdgcn_sched_barrier(0)
    Unit cur, nxt; int ui = 0;
    if (!S.next(0, cur)) return;
    f32x4 acc[2][2][4][2];
#pragma unroll
    for (int a = 0; a < 2; ++a)
#pragma unroll
        for (int b = 0; b < 2; ++b)
#pragma unroll
            for (int m = 0; m < 4; ++m)
#pragma unroll
                for (int n = 0; n < 2; ++n) acc[a][b][m][n] = (f32x4){0.f, 0.f, 0.f, 0.f};
    bf16x8 At[4][2], B0[2][2], B1[2][2];
    unsigned ca0[2], ca1[2], na0[2], na1[2];
#pragma unroll
    for (int i = 0; i < 2; ++i) { ca0[i] = S.a_off(cur, RA[i]) + (unsigned)CA2[i]; ca1[i] = S.a_off(cur, HALF + RA[i]) + (unsigned)CA2[i]; }
    const char* cB = S.b_ptr(cur);
    {
        PG8_STAGE(PG8_SB(0, 0), cB, voffB); PG8_STAGE(PG8_SB(0, 1), cB + hstep, voffB); PG8_STAGEA(PG8_SA(0, 0), ca0, 0); PG8_STAGEA(PG8_SA(0, 1), ca1, 0);
        if (wr == 1) PG8_BAR;
        PG8_WAIT_V(2); PG8_BAR;
        PG8_STAGE(PG8_SB(1, 0), cB + kstep, voffB); PG8_STAGEA(PG8_SA(1, 0), ca0, kstep); PG8_STAGE(PG8_SB(1, 1), cB + hstep + kstep, voffB);
        PG8_WAIT_V(6); PG8_BAR;
    }
    for (;;) {
        const bool has_next = S.next(ui + 1, nxt);
        const char* nB = cB;
#pragma unroll
        for (int i = 0; i < 2; ++i) { na0[i] = ca0[i]; na1[i] = ca1[i]; }
        if (has_next) { nB = S.b_ptr(nxt);
#pragma unroll
            for (int i = 0; i < 2; ++i) { int R, C; stage_rc(tid * 16 + i * 8192, R, C); na0[i] = S.a_off(nxt, R) + (unsigned)(C * 2); na1[i] = S.a_off(nxt, HALF + R) + (unsigned)(C * 2); } }
#pragma unroll 1
        for (int t = 0; t < nt; t += 2) {
            const bool last = (t == nt - 2);
            const size_t k1 = (size_t)(t + 1) * kstep;
            const size_t k2 = last ? (size_t)0 : (size_t)(t + 2) * kstep, k3 = k2 + kstep;
            const char* b2 = (last ? nB : cB) + k2; const char* b3 = b2 + kstep;
            PG8_LDB(B0, 0, 0); PG8_LDB(B1, 0, 1); PG8_SCHED; PG8_LDA(At, 0, 0); PG8_STAGEA(PG8_SA(1, 1), ca1, k1);
            if (last) {
#pragma unroll
                for (int i = 0; i < 2; ++i) { ca0[i] = na0[i]; ca1[i] = na1[i]; } }
            PG8_WAIT_V(8); PG8_WAIT_L(0); PG8_BAR; PG8_MMA(0, 0, At, B0); PG8_MMA(0, 1, At, B1); PG8_BAR; PG8_SCHED;
            PG8_LDA(At, 0, 1); PG8_STAGE(PG8_SB(0, 0), b2, voffB); PG8_STAGE(PG8_SB(0, 1), b2 + hstep, voffB); PG8_STAGEA(PG8_SA(0, 0), ca0, k2);
            PG8_WAIT_V(8); PG8_WAIT_L(0); PG8_BAR; PG8_MMA(1, 0, At, B0); PG8_MMA(1, 1, At, B1); PG8_BAR; PG8_SCHED;
            PG8_LDB(B0, 1, 0); PG8_LDB(B1, 1, 1); PG8_SCHED; PG8_LDA(At, 1, 0); PG8_STAGEA(PG8_SA(0, 1), ca1, k2);
            PG8_WAIT_V(8); PG8_WAIT_L(0); PG8_BAR; PG8_MMA(0, 0, At, B0); PG8_MMA(0, 1, At, B1); PG8_BAR; PG8_SCHED;
            PG8_LDA(At, 1, 1); PG8_STAGE(PG8_SB(1, 0), b3, voffB); PG8_STAGE(PG8_SB(1, 1), b3 + hstep, voffB); PG8_STAGEA(PG8_SA(1, 0), ca0, k3);
            PG8_WAIT_V(8); PG8_WAIT_L(0); PG8_BAR; PG8_MMA(1, 0, At, B0); PG8_MMA(1, 1, At, B1); PG8_BAR; PG8_SCHED;
        }
        if constexpr (ALIGN_EPI) { if (wr == 0) PG8_BAR; }
        if constexpr (!Epi::AFTER_DRAIN) { E(acc, cur, wr, wc, fr, fq); }
        if (!has_next) break;
#pragma unroll
        for (int a = 0; a < 2; ++a)
#pragma unroll
            for (int b = 0; b < 2; ++b)
#pragma unroll
                for (int m = 0; m < 4; ++m)
#pragma unroll
                    for (int n = 0; n < 2; ++n) acc[a][b][m][n] = (f32x4){0.f, 0.f, 0.f, 0.f};
        cur = nxt; cB = nB; ++ui;
        if constexpr (ALIGN_EPI) { if (wr == 1) PG8_BAR; }
    }
    PG8_WAIT_V(0);
    if constexpr (!ALIGN_EPI) { if (wr == 0) PG8_BAR; }
    PG8_BAR;
    if constexpr (Epi::AFTER_DRAIN) { E.fused(acc, cur, wr, wc, fr, fq, lds, wid, lane); }
#undef PG8_SA
#undef PG8_SB
#undef PG8_STAGE
#undef PG8_STAGEA
#undef PG8_LDA
#undef PG8_LDB
#undef PG8_MMA
#undef PG8_WAIT_V
#undef PG8_WAIT_L
#undef PG8_BAR
#undef PG8_SCHED
}
}
namespace attn_body {
using bf16=__hip_bfloat16;
using bf16x8=__attribute__((ext_vector_type(8)))short;
using s16x4=__attribute__((ext_vector_type(4)))short;
using f32x16=__attribute__((ext_vector_type(16)))float;
using u32x4=__attribute__((ext_vector_type(4)))unsigned;
using u32x2=__attribute__((ext_vector_type(2)))unsigned;
constexpr int SEQ=2048,D=64,DM=512;
constexpr int NW=8,QBLK=32,QB=QBLK*NW,KVBLK=64;
__device__ __forceinline__ int crow(int r,int hi){return (r&3)+8*(r>>2)+4*hi;}
#define SBAR() __builtin_amdgcn_sched_barrier(0)
constexpr float NEGB=-1000.0f;
constexpr int NSLOT=3, SLOTB=8192;
constexpr int LDS_K=0, LDS_V=NSLOT*SLOTB, LDS_WS=2*NSLOT*SLOTB, LDS_BIAS=LDS_WS+NW*64*4, LDS_X=LDS_BIAS+2048, LDS_OST=LDS_X, LDS_BYTES=LDS_X+65536;
constexpr float C2=0.125f*1.4426950408889634f;
__device__ __forceinline__ void glds16(const void*gsrc,unsigned lds_dst){unsigned keep;
  asm volatile("s_mov_b32 %0, m0\n\ts_mov_b32 m0, %2\n\ts_nop 0\n\tglobal_load_lds_dwordx4 %1, off\n\ts_mov_b32 m0, %0":"=&s"(keep):"v"(gsrc),"s"(lds_dst):"memory");}
__device__ __forceinline__ float max3f(float a,float b,float c){float r;asm("v_max3_f32 %0, %1, %2, %3":"=v"(r):"v"(a),"v"(b),"v"(c));return r;}
__device__ __forceinline__ float max2f(float a,float b){float r;asm("v_max_f32_e32 %0, %1, %2":"=v"(r):"v"(a),"v"(b));return r;}
__device__ __forceinline__ float fadd_s(float a,float b){float r;asm("v_add_f32_e32 %0, %1, %2":"=v"(r):"v"(a),"v"(b));return r;}
__device__ __forceinline__ float fsub_s(float a,float b){float r;asm("v_sub_f32_e32 %0, %1, %2":"=v"(r):"v"(a),"v"(b));return r;}
typedef float f32x2_t __attribute__((ext_vector_type(2))); typedef __bf16 bf16x2_t __attribute__((ext_vector_type(2)));
__device__ __forceinline__ unsigned cvtpk_s(float lo,float hi){f32x2_t v={lo,hi};bf16x2_t b=__builtin_convertvector(v,bf16x2_t);return __builtin_bit_cast(unsigned,b);}
#define WAIT_BAR(N) asm volatile("s_waitcnt vmcnt(" #N ") lgkmcnt(0)\n\ts_barrier":::"memory")

__device__ __forceinline__ void qkt(f32x16&p0,f32x16&p1,const char*Kslot,const bf16x8*qr,const f32x16&negm,int r32,int hi){
  const char*kb=Kslot+hi*1024+r32*16;
  #pragma unroll
  for(int d0=0;d0<4;++d0){
    const bf16x8 b0=*reinterpret_cast<const bf16x8*>(kb+d0*2048);
    const bf16x8 b1=*reinterpret_cast<const bf16x8*>(kb+d0*2048+512);
    if(d0==0){p0=__builtin_amdgcn_mfma_f32_32x32x16_bf16(b0,qr[0],negm,0,0,0);p1=__builtin_amdgcn_mfma_f32_32x32x16_bf16(b1,qr[0],negm,0,0,0);}
    else{p0=__builtin_amdgcn_mfma_f32_32x32x16_bf16(b0,qr[d0],p0,0,0,0);p1=__builtin_amdgcn_mfma_f32_32x32x16_bf16(b1,qr[d0],p1,0,0,0);}}
}
typedef __attribute__((address_space(3))) const char* lds_cptr;
typedef __attribute__((address_space(3))) char* lds_ptr;
typedef short v4i16_t __attribute__((ext_vector_type(4)));
__device__ __forceinline__ void kload8(bf16x8*kf,lds_cptr kp){
  kf[0]=*(const __attribute__((address_space(3))) bf16x8*)(kp);      kf[1]=*(const __attribute__((address_space(3))) bf16x8*)(kp+512);
  kf[2]=*(const __attribute__((address_space(3))) bf16x8*)(kp+2048); kf[3]=*(const __attribute__((address_space(3))) bf16x8*)(kp+2560);
  kf[4]=*(const __attribute__((address_space(3))) bf16x8*)(kp+4096); kf[5]=*(const __attribute__((address_space(3))) bf16x8*)(kp+4608);
  kf[6]=*(const __attribute__((address_space(3))) bf16x8*)(kp+6144); kf[7]=*(const __attribute__((address_space(3))) bf16x8*)(kp+6656);
}
__device__ __forceinline__ void kload2(bf16x8*kf,lds_cptr kp,int j){ kf[2*j]=*(const __attribute__((address_space(3))) bf16x8*)(kp+j*2048); kf[2*j+1]=*(const __attribute__((address_space(3))) bf16x8*)(kp+j*2048+512); }
__device__ __forceinline__ s16x4 vtr(lds_cptr p){ return __builtin_bit_cast(s16x4,__builtin_amdgcn_ds_read_tr16_b64_v4i16((__attribute__((address_space(3))) v4i16_t*)p)); }
__device__ __forceinline__ float rowmax(const f32x16&p0,const f32x16&p1){
  float a=max3f(p0[0],p0[1],p1[0]),b=max3f(p0[2],p0[3],p1[1]);a=max3f(a,p1[2],p1[3]);
  #pragma unroll
  for(int r=4;r<16;r+=4){a=max3f(a,p0[r],p0[r+1]);b=max3f(b,p0[r+2],p0[r+3]);a=max3f(a,p1[r],p1[r+1]);b=max3f(b,p1[r+2],p1[r+3]);}
  const float m=max2f(a,b);
  auto rr=__builtin_amdgcn_permlane32_swap(__float_as_uint(m),__float_as_uint(m),false,false);
  return max2f(__uint_as_float(rr[0]),__uint_as_float(rr[1]));
}
__device__ __forceinline__ void pv(f32x16*o,int vb,bf16x8 pa0,bf16x8 pa1,bf16x8 pa2,bf16x8 pa3){
  #pragma unroll
  for(int d0=0;d0<2;++d0){s16x4 lo[4],hi[4];
    #pragma unroll
    for(int ks=0;ks<4;++ks){
      asm volatile("ds_read_b64_tr_b16 %0,%1 offset:%c2":"=&v"(lo[ks]):"v"(vb),"i"(d0*4096+ks*1024):"memory");
      asm volatile("ds_read_b64_tr_b16 %0,%1 offset:%c2":"=&v"(hi[ks]):"v"(vb),"i"(d0*4096+ks*1024+512):"memory");}
    asm volatile("s_waitcnt lgkmcnt(0)":::"memory");SBAR();
    #define PK(k) (bf16x8){lo[k][0],lo[k][1],lo[k][2],lo[k][3],hi[k][0],hi[k][1],hi[k][2],hi[k][3]}
    o[d0]=__builtin_amdgcn_mfma_f32_32x32x16_bf16(pa0,PK(0),o[d0],0,0,0);
    o[d0]=__builtin_amdgcn_mfma_f32_32x32x16_bf16(pa1,PK(1),o[d0],0,0,0);
    o[d0]=__builtin_amdgcn_mfma_f32_32x32x16_bf16(pa2,PK(2),o[d0],0,0,0);
    o[d0]=__builtin_amdgcn_mfma_f32_32x32x16_bf16(pa3,PK(3),o[d0],0,0,0);
    #undef PK
  }
}

template<int MODE,int THRL> __device__ __forceinline__ void attn_unit(int b,int h,int qb,const bf16*Q,const bf16*__restrict__ K,const bf16*__restrict__ V,bf16*O,const void*extra,char*shm){
  int tid_=threadIdx.x; asm volatile("":"+v"(tid_));
  const int tid=tid_,lane=tid&63,r32=lane&31,hi=lane>>5; const int wid=__builtin_amdgcn_readfirstlane(tid>>6);
  const long rowbase=(long)b*SEQ; const int q0=qb*QB;
  const int jt0=(MODE==0)?((4*qb-8)>0?(4*qb-8):0):0;
  const int NT=4*qb+4-jt0;
  const bf16*Qw=Q+(rowbase+q0+wid*QBLK)*DM+h*D;
  const bf16*Kh=K+(rowbase+(long)jt0*KVBLK)*DM+h*D,*Vh=V+(rowbase+(long)jt0*KVBLK)*DM+h*D;
  const unsigned lds0=(unsigned)(uintptr_t)shm;
  __attribute__((address_space(3))) float*wsf=(__attribute__((address_space(3))) float*)((lds_ptr)shm+LDS_WS)+wid*64;
  const lds_cptr shm3=(lds_cptr)shm;
  if(MODE==1){ const unsigned long long*selg=(const unsigned long long*)extra+(size_t)(rowbase+q0)*32; int row=tid>>1,par=tid&1; asm volatile("":"+v"(row),"+v"(par)); lds_ptr xm=(lds_ptr)shm+LDS_X;
    _Pragma("unroll 1") for(int cc=par;cc<NT/2;cc+=2){ const u32x4 v=*(const u32x4*)(selg+(size_t)row*32+2*cc);
      *(__attribute__((address_space(3))) u32x2*)(xm+((2*cc)*256+row)*8)=(u32x2){v.x,v.y}; *(__attribute__((address_space(3))) u32x2*)(xm+((2*cc+1)*256+row)*8)=(u32x2){v.z,v.w}; } }
  else { int tb_=tid; asm volatile("":"+v"(tb_)); if(tb_<257){ const float bv=((const float*)extra)[h*257+tb_]*1.4426950408889634f; *(__attribute__((address_space(3))) float*)((lds_ptr)shm+LDS_BIAS+tb_*4)=bv; } }
  const __attribute__((address_space(3))) float* biasl=(const __attribute__((address_space(3))) float*)(shm3+LDS_BIAS);
  const lds_cptr xmr=shm3+LDS_X+(wid*32+r32)*8;
  const bf16*ksrc=Kh+(long)lane*DM+wid*8;
  const bf16*vsrc=Vh+(long)(16*(wid&3)+(lane>>2))*DM+(wid>>2)*32+(lane&3)*8;
  const unsigned kdst=lds0+LDS_K+wid*1024, vdst=lds0+LDS_V+wid*1024;
  #define DMA_K(t,slot) glds16(ksrc+(long)(t)*KVBLK*DM,(unsigned)__builtin_amdgcn_readfirstlane(kdst+(slot)))
  #define DMA_V(t,slot) glds16(vsrc+(long)(t)*KVBLK*DM,(unsigned)__builtin_amdgcn_readfirstlane(vdst+(slot)))
  const char*Kbase=shm+LDS_K; bf16x8 kf[8];
  const lds_cptr kp0=shm3+LDS_K+hi*1024+r32*16; const lds_cptr vp0=shm3+LDS_V+((lane>>4)&1)*32+(lane&3)*8+(4*hi+((lane&15)>>2))*64;
  DMA_K(0,0);DMA_V(0,0);DMA_K(1,SLOTB);
  bf16x8 qr[4];
  #pragma unroll
  for(int d0=0;d0<4;++d0)qr[d0]=*reinterpret_cast<const bf16x8*>(&Qw[(long)r32*DM+d0*16+hi*8]);
  float mhat=0.f,l_reg=0.f;f32x16 o[2];o[0]=f32x16{};o[1]=f32x16{};const f32x16 negm=f32x16{};
  const int qpos=q0+wid*QBLK+r32;
  const int cw=4*qb+(wid>>1);
  #define MASKT(P0,P1,t) do{ \
    if(MODE==1){ const u32x2 mw_=*(const __attribute__((address_space(3))) u32x2*)(xmr+(t)*2048); const unsigned m0_=mw_.x>>(4*hi), m1_=mw_.y>>(4*hi); \
      _Pragma("unroll") for(int r=0;r<16;++r){ const int bit_=(r&3)+8*(r>>2); P0[r]=((m0_>>bit_)&1u)?P0[r]:NEGB; P1[r]=((m1_>>bit_)&1u)?P1[r]:NEGB; } } \
    else { const int jc_=jt0+(t); \
      if(jc_>cw||jc_+8<cw){ _Pragma("unroll") for(int r=0;r<16;++r){P0[r]=NEGB;P1[r]=NEGB;} } \
      else if((q0+wid*QBLK)-(64*jc_+63)>=128){ const float bc_=biasl[256]; _Pragma("unroll") for(int r=0;r<16;++r){P0[r]+=bc_;P1[r]+=bc_;} } \
      else { const int rb_=qpos-(64*jc_+4*hi); \
        _Pragma("unroll") for(int r=0;r<16;++r){ const int rel_=rb_-((r&3)+8*(r>>2)); int i0_=rel_<128?rel_:128; int i1_=(rel_-32)<128?(rel_-32):128; i0_=i0_<-128?-128:i0_; i1_=i1_<-128?-128:i1_; \
          P0[r]+=biasl[i0_+128]; P1[r]+=biasl[i1_+128]; } } } \
  }while(0)
  bool resc=false;
  #define START(P0,P1) do{ const float rm=rowmax(P0,P1); resc=false; \
    { const float dl=rm; mhat=fadd_s(mhat,dl); \
      _Pragma("unroll") for(int r=0;r<16;++r){P0[r]=fsub_s(P0[r],dl);P1[r]=fsub_s(P1[r],dl);} \
      } \
    _Pragma("unroll") for(int r=0;r<16;++r)P0[r]=__builtin_amdgcn_exp2f(P0[r]); }while(0)
  #define RESC() do{ if(resc){ asm volatile("s_waitcnt lgkmcnt(0)":::"memory"); \
      _Pragma("unroll") for(int d_=0;d_<2;++d_) _Pragma("unroll") for(int r=0;r<16;++r)o[d_][r]*=wsf[crow(r,hi)]; } }while(0)
  f32x16 pA0,pA1,pB0,pB1;
  int sl_prev=0,sl_cur=0,sl_next=SLOTB;
  #define ROT() do{sl_prev=sl_cur;sl_cur=sl_next;sl_next=(sl_next==(NSLOT-1)*SLOTB)?0:sl_next+SLOTB;}while(0)
  DMA_K(2,2*SLOTB);
  WAIT_BAR(3);
  qkt(pA0,pA1,Kbase,qr,negm,r32,hi);asm volatile("s_nop 15\n\ts_nop 7":"+v"(pA0),"+v"(pA1));MASKT(pA0,pA1,0);
  START(pA0,pA1);
  _Pragma("unroll") for(int r=0;r<16;++r)pA1[r]=__builtin_amdgcn_exp2f(pA1[r]);
  WAIT_BAR(0);
  DMA_K(3,0);DMA_V(1,SLOTB);
  ROT();
  kload8(kf,kp0+sl_cur);
  WAIT_BAR(2);
  s16x4 vlo[8],vhi[8]; u32x4 pw0,pw1,pw2,pw3;
  #define PKW(P,B) cvtpk_s(P[B],P[B+1])
  #define PAF(k) __builtin_bit_cast(bf16x8,pw##k)
  #define VFR(i) (bf16x8){vlo[i][0],vlo[i][1],vlo[i][2],vlo[i][3],vhi[i][0],vhi[i][1],vhi[i][2],vhi[i][3]}
  #define PIN(x) asm volatile("":"+v"(x))
  #define MX3(a,b,c) __builtin_fmaxf(__builtin_fmaxf((a),(b)),(c))
  #define GAPA(MF,A0,A1,A2,A3,W0,W1,PW) do{ MF; sacc+=A0; sacc+=A1; sacc+=A2; sacc+=A3; PIN(sacc); W0; W1; PIN(PW); SBAR(); }while(0)
  #define EX(v) __builtin_amdgcn_exp2f(v)
  #define GAPB(MF,X,B) do{ MF; X[B]=EX(X[B]); X[B+1]=EX(X[B+1]); X[B+2]=EX(X[B+2]); X[B+3]=EX(X[B+3]); PIN(X); SBAR(); }while(0)
  #define VRD(i) do{ vlo[i]=vtr(vp_+(((i)>>2)*4096+((i)&3)*1024)); vhi[i]=vtr(vp_+(((i)>>2)*4096+((i)&3)*1024+512)); }while(0)
  #define KRD(G,j) do{ if(G){ kload2(kf,kp0+sl_next,j); SBAR(); } }while(0)
  #define STEP(C0,C1,P0,P1,t,GK,GV,GL) do{ SBAR(); \
    const lds_cptr vp_=vp0+sl_prev; \
    VRD(0); SBAR(); float sacc=(P0[0]+P0[1]); \
    GAPA(C0=__builtin_amdgcn_mfma_f32_32x32x16_bf16(kf[0],qr[0],negm,0,0,0), P0[2],P0[3],P0[4],P0[5],     pw0[0]=PKW(P0,0), pw0[1]=PKW(P0,2), pw0); \
    VRD(4); SBAR(); GAPA(C1=__builtin_amdgcn_mfma_f32_32x32x16_bf16(kf[1],qr[0],negm,0,0,0), P0[6],P0[7],P0[8],P0[9],     pw0[2]=PKW(P0,4), pw0[3]=PKW(P0,6), pw0); \
    VRD(1); SBAR(); GAPA(C0=__builtin_amdgcn_mfma_f32_32x32x16_bf16(kf[2],qr[1],C0,0,0,0),   P0[10],P0[11],P0[12],P0[13], pw1[0]=PKW(P0,8), pw1[1]=PKW(P0,10), pw1); \
    VRD(5); SBAR(); GAPA(C1=__builtin_amdgcn_mfma_f32_32x32x16_bf16(kf[3],qr[1],C1,0,0,0),   P0[14],P0[15],P1[0],P1[1],   pw1[2]=PKW(P0,12),pw1[3]=PKW(P0,14), pw1); \
    VRD(2); SBAR(); GAPA(C0=__builtin_amdgcn_mfma_f32_32x32x16_bf16(kf[4],qr[2],C0,0,0,0),   P1[2],P1[3],P1[4],P1[5],     pw2[0]=PKW(P1,0), pw2[1]=PKW(P1,2), pw2); \
    VRD(6); SBAR(); GAPA(C1=__builtin_amdgcn_mfma_f32_32x32x16_bf16(kf[5],qr[2],C1,0,0,0),   P1[6],P1[7],P1[8],P1[9],     pw2[2]=PKW(P1,4), pw2[3]=PKW(P1,6), pw2); \
    VRD(3); SBAR(); GAPA(C0=__builtin_amdgcn_mfma_f32_32x32x16_bf16(kf[6],qr[3],C0,0,0,0),   P1[10],P1[11],P1[12],P1[13], pw3[0]=PKW(P1,8), pw3[1]=PKW(P1,10), pw3); \
    VRD(7); SBAR(); GAPA(C1=__builtin_amdgcn_mfma_f32_32x32x16_bf16(kf[7],qr[3],C1,0,0,0),   P1[14],P1[15],0.f,0.f,       pw3[2]=PKW(P1,12),pw3[3]=PKW(P1,14), pw3); \
    l_reg+=sacc; \
    if(GK){DMA_K((t)+3,sl_cur);} if(GV){DMA_V((t)+1,sl_next);} \
    _Pragma("unroll") for(int r=0;r<16;++r){C0[r]-=mhat;C1[r]-=mhat;} \
    MASKT(C0,C1,t); \
    { float a=MX3(C0[0],C0[1],C1[0]),b=MX3(C0[2],C0[3],C1[1]); a=MX3(a,C1[2],C1[3]); \
      _Pragma("unroll") for(int r=4;r<16;r+=4){a=MX3(a,C0[r],C0[r+1]);b=MX3(b,C0[r+2],C0[r+3]);a=MX3(a,C1[r],C1[r+1]);b=MX3(b,C1[r+2],C1[r+3]);} \
      float rm=__builtin_fmaxf(a,b); { auto rr=__builtin_amdgcn_permlane32_swap(__float_as_uint(rm),__float_as_uint(rm),false,false); rm=__builtin_fmaxf(__uint_as_float(rr[0]),__uint_as_float(rr[1])); } \
      resc=false; \
      if(__builtin_expect(__any(rm>(float)THRL),0)){ const float dl=__builtin_fmaxf(rm,0.f); mhat+=dl; \
        _Pragma("unroll") for(int r=0;r<16;++r){C0[r]-=dl;C1[r]-=dl;} \
        const float f=__builtin_amdgcn_exp2f(-dl); l_reg*=f; if(hi==0)wsf[r32]=f; resc=true; } } \
    SBAR(); \
    GAPB(o[0]=__builtin_amdgcn_mfma_f32_32x32x16_bf16(PAF(0),VFR(0),o[0],0,0,0), C0,0); \
    GAPB(o[1]=__builtin_amdgcn_mfma_f32_32x32x16_bf16(PAF(0),VFR(4),o[1],0,0,0), C0,4); \
    KRD(GL,0); GAPB(o[0]=__builtin_amdgcn_mfma_f32_32x32x16_bf16(PAF(1),VFR(1),o[0],0,0,0), C0,8); \
    KRD(GL,1); GAPB(o[1]=__builtin_amdgcn_mfma_f32_32x32x16_bf16(PAF(1),VFR(5),o[1],0,0,0), C0,12); \
    KRD(GL,2); GAPB(o[0]=__builtin_amdgcn_mfma_f32_32x32x16_bf16(PAF(2),VFR(2),o[0],0,0,0), C1,0); \
    KRD(GL,3); GAPB(o[1]=__builtin_amdgcn_mfma_f32_32x32x16_bf16(PAF(2),VFR(6),o[1],0,0,0), C1,4); \
    GAPB(o[0]=__builtin_amdgcn_mfma_f32_32x32x16_bf16(PAF(3),VFR(3),o[0],0,0,0), C1,8); \
    GAPB(o[1]=__builtin_amdgcn_mfma_f32_32x32x16_bf16(PAF(3),VFR(7),o[1],0,0,0), C1,12); \
    }while(0)
  int t=1;
  for(;t+5<NT;t+=2){
    STEP(pB0,pB1,pA0,pA1,t,true,true,true);     WAIT_BAR(2); RESC(); ROT();
    STEP(pA0,pA1,pB0,pB1,t+1,true,true,true);   WAIT_BAR(2); RESC(); ROT();
  }
  #define ENDW(tt) do{ if((tt)+3<NT){WAIT_BAR(2);} else if((tt)+2<NT){WAIT_BAR(1);} else {WAIT_BAR(0);} }while(0)
  for(;t+1<NT;t+=2){
    STEP(pB0,pB1,pA0,pA1,t,(t+3<NT),(t+1<NT),(t+1<NT));       ENDW(t);   RESC(); ROT();
    STEP(pA0,pA1,pB0,pB1,t+1,(t+4<NT),(t+2<NT),(t+2<NT));     ENDW(t+1); RESC(); ROT();
  }
  STEP(pB0,pB1,pA0,pA1,NT-1,false,false,false); RESC();
  { float sacc=pB0[0]+pB0[1]; _Pragma("unroll") for(int r=2;r<16;++r)sacc+=pB0[r]; _Pragma("unroll") for(int r=0;r<16;++r)sacc+=pB1[r]; l_reg+=sacc;
    pw0=(u32x4){PKW(pB0,0),PKW(pB0,2),PKW(pB0,4),PKW(pB0,6)};pw1=(u32x4){PKW(pB0,8),PKW(pB0,10),PKW(pB0,12),PKW(pB0,14)};pw2=(u32x4){PKW(pB1,0),PKW(pB1,2),PKW(pB1,4),PKW(pB1,6)};pw3=(u32x4){PKW(pB1,8),PKW(pB1,10),PKW(pB1,12),PKW(pB1,14)};
    const int vb0=(int)(lds0+LDS_V)+((lane>>4)&1)*32+(lane&3)*8+(4*hi+((lane&15)>>2))*64;
    SBAR(); pv(o,vb0+sl_cur,PAF(0),PAF(1),PAF(2),PAF(3)); }
  #undef PKW
  #undef PAF
  #undef VFR
  #undef PIN
  #undef MX3
  #undef GAPA
  #undef GAPB
  #undef EX
  #undef VRD
  #undef KRD
  #undef STEP
  #undef ENDW
  {auto rr=__builtin_amdgcn_permlane32_swap(__float_as_uint(l_reg),__float_as_uint(l_reg),false,false);l_reg=__uint_as_float(rr[0])+__uint_as_float(rr[1]);}
  if(hi==0)wsf[32+r32]=l_reg;
  asm volatile("s_waitcnt lgkmcnt(0)\n\ts_barrier":::"memory");
  float rli[16];
  #pragma unroll
  for(int r=0;r<16;++r)rli[r]=__builtin_amdgcn_rcpf(wsf[32+crow(r,hi)]);
  bf16*Ow=O+(rowbase+q0+wid*QBLK)*DM+h*D;
  { bf16*stg=(bf16*)(shm+LDS_OST)+wid*2048;
    #pragma unroll
    for(int r=0;r<16;++r){const int orow=crow(r,hi);
      #pragma unroll
      for(int d0=0;d0<2;++d0)stg[orow*64+d0*32+r32]=__float2bfloat16(o[d0][r]*rli[r]);}
    asm volatile("s_waitcnt lgkmcnt(0)":::"memory");
    #pragma unroll
    for(int i=0;i<4;++i){const int row=i*8+(lane>>3),ch=lane&7; const u32x4 v=*(const u32x4*)(stg+row*64+ch*8); *(u32x4*)(Ow+(long)row*DM+ch*8)=v;} }
  asm volatile("s_waitcnt lgkmcnt(0)\n\ts_barrier":::"memory");
  #undef DMA_K
  #undef DMA_V
  #undef MASKT
  #undef START
  #undef RESC
  #undef ROT
}
constexpr int ATTN_LDS_BYTES=LDS_BYTES;
#undef SBAR
#undef WAIT_BAR
}
constexpr int NB = 8, SEQ = 2048, T = NB * SEQ, D = 1024;
constexpr int DIN = 5704, DINP = 5888;
constexpr int NEXP = 64, DEXP = 256, TOPK = 8;
constexpr int NCHUNK = 2, CHTOK = T / NCHUNK, CHROWS = CHTOK * TOPK;
constexpr float LN_EPS = 1e-5f;
constexpr float DN_ALPHA = 1.189207115002721f;
constexpr float LOG2E = 1.4426950408889634f;
constexpr int NWAVES = 8;
constexpr int NPHASE = 15;

constexpr size_t MiB = 1u << 20;
constexpr size_t WS_CTL = 0, CTL_ZERO_BYTES = 1 * MiB;
constexpr size_t WS_MOD = 1 * MiB, WS_STATS = 1 * MiB + 256 * 1024, WS_ROPE = 2 * MiB, WS_XCH = 3 * MiB;
constexpr size_t WS_EGU = 4 * MiB, WS_ED = 68 * MiB, WS_SHGU = 100 * MiB, WS_SHD = 101 * MiB;
constexpr size_t WS_WA = 102 * MiB, WS_WB = 103 * MiB, WS_WOUT = 104 * MiB, WS_WIN = 106 * MiB;
constexpr size_t WS_XN = 118 * MiB;
constexpr size_t WS_QA = 150 * MiB, WS_QB = 166 * MiB, WS_KA = 182 * MiB, WS_VA = 198 * MiB, WS_KB = 214 * MiB, WS_VB = 230 * MiB;
constexpr size_t WS_QI = 246 * MiB, WS_KIW = 262 * MiB, WS_KI = 270 * MiB, WS_WI = 272 * MiB, WS_SEL = 273 * MiB;
constexpr size_t WS_TMP = 182 * MiB, WS_MERGED = 246 * MiB;
constexpr size_t WS_NVO = 277 * MiB;
constexpr size_t WS_HSH = 102 * MiB, WS_TAB = 110 * MiB, WS_HEXP = 150 * MiB, WS_YEXP = 182 * MiB, WS_END = 310 * MiB;
constexpr size_t TAB_ER = 0, TAB_W = 512 * 1024, TAB_LIST = 1 * MiB;
constexpr int CW_TMO = 0, CW_CODE = 1, CW_BAR = 4096, CW_SEAM = 16384, SEAM_BANK = 128 * 64, CW_CNT = 40960;

constexpr int RING_OFF = 0, RING_BYTES = 131072;
constexpr int LDSCTL_OFF = RING_BYTES, MISC_OFF = LDSCTL_OFF + 320;
constexpr int XTAB_OFF = MISC_OFF + 128;
constexpr int LDS_BYTES = 147456;
static_assert(XTAB_OFF + 1024 <= LDS_BYTES, "LDS map");

#define GAS __attribute__((address_space(1)))
#define LAS __attribute__((address_space(3)))
typedef unsigned short bf16;
typedef unsigned v4u __attribute__((ext_vector_type(4)));
typedef unsigned v2u __attribute__((ext_vector_type(2)));
typedef float f32x4 __attribute__((ext_vector_type(4)));
typedef float f32x2 __attribute__((ext_vector_type(2)));
typedef short bf16x8 __attribute__((ext_vector_type(8)));
typedef float f32x16 __attribute__((ext_vector_type(16)));
typedef GAS unsigned gu32;
#define RLX_AGENT __ATOMIC_RELAXED, __HIP_MEMORY_SCOPE_AGENT
#define LDS_WAIT() asm volatile("s_waitcnt lgkmcnt(0)" ::: "memory")
#define VM_WAIT() asm volatile("s_waitcnt vmcnt(0)" ::: "memory")
__device__ __forceinline__ unsigned f2bf(float f) { unsigned u = __builtin_bit_cast(unsigned, f); return (u + 0x7fffu + ((u >> 16) & 1u)) >> 16; }
__device__ __forceinline__ unsigned pk2(float lo, float hi) { return f2bf(lo) | (f2bf(hi) << 16); }
__device__ __forceinline__ float bf2f(unsigned short h) { return __uint_as_float((unsigned)h << 16); }
__device__ __forceinline__ float bflo(unsigned w) { return __uint_as_float(w << 16); }
__device__ __forceinline__ float bfhi(unsigned w) { return __uint_as_float(w & 0xffff0000u); }
__device__ __forceinline__ float sigmoidf_(float v) { return __builtin_amdgcn_rcpf(1.0f + __builtin_amdgcn_exp2f(-v * LOG2E)); }

#define XB_TMO      128
#define XB_XCNT(j)  (256  + 64 * (j))
#define XB_XSUB(j)  (1280 + 64 * (j))
#define XB_XGEN(j)  (2304 + 64 * (j))
#define XB_TOP      3328
#define XB_TOPGEN   3392
#define XCD_BAR_WORDS 3456
#define XB_SPIN_CAP (1u << 18)
__device__ __forceinline__ unsigned xb_ld(unsigned* p)              { return __hip_atomic_load(p, __ATOMIC_RELAXED, __HIP_MEMORY_SCOPE_AGENT); }
__device__ __forceinline__ unsigned xb_add(unsigned* p, unsigned v) { return __hip_atomic_fetch_add(p, v, __ATOMIC_RELAXED, __HIP_MEMORY_SCOPE_AGENT); }
__device__ __forceinline__ unsigned xb_xcc_id() { return (unsigned)__builtin_amdgcn_s_getreg((3 << 11) | 20) & 0xFu; }
#define XB_SPIN(cond, bar) do { unsigned _sp = 0; while (cond) { __builtin_amdgcn_s_sleep(1); \
    if ((++_sp & 255u) == 0u) { if (xb_ld(&(bar)[XB_TMO])) break; if (_sp > XB_SPIN_CAP) { atomicAdd(&(bar)[XB_TMO], 1u); break; } } } } while (0)
struct XcdBarrier { unsigned* bar; unsigned x; volatile LAS unsigned* st; };
__device__ __forceinline__ XcdBarrier xcd_barrier_post(unsigned* bar, volatile LAS unsigned* st) {
    XcdBarrier b; b.bar = bar; b.x = xb_xcc_id(); b.st = st;
    if (threadIdx.x == 0) (void)xb_add(&bar[XB_XCNT(b.x)], 1u);
    return b;
}
__device__ __forceinline__ void xcd_barrier_complete(unsigned* bar, unsigned x, unsigned& nloc, unsigned& nx) {
    const unsigned G = gridDim.x * gridDim.y * gridDim.z;
    unsigned sum, cnt, mine, sp = 0u;
    for (;;) {
        sum = 0u; cnt = 0u; mine = 0u;
#pragma unroll
        for (unsigned j = 0; j < 16; ++j) { const unsigned c = xb_ld(&bar[XB_XCNT(j)]); sum += c; cnt += (c > 0u) ? 1u : 0u; mine = (j == x) ? c : mine; }
        if (sum == G) break;
        __builtin_amdgcn_s_sleep(1);
        if ((++sp & 255u) == 0u) { if (xb_ld(&bar[XB_TMO])) break; if (sp > XB_SPIN_CAP) { atomicAdd(&bar[XB_TMO], 1u); break; } }
    }
    nloc = mine > 0u ? mine : 1u; nx = cnt > 0u ? cnt : 1u;
}
__device__ __forceinline__ void xcd_barrier(const XcdBarrier& b) {
    asm volatile("s_waitcnt vmcnt(0)" ::: "memory");
    __syncthreads();
    if (threadIdx.x == 0) {
        unsigned* bar = b.bar;
        __builtin_amdgcn_s_waitcnt(0);
        unsigned nloc = b.st[0], nx = b.st[1];
        if (nloc == 0u) { xcd_barrier_complete(bar, b.x, nloc, nx); b.st[0] = nloc; b.st[1] = nx; }
        const unsigned old = xb_add(&bar[XB_XSUB(b.x)], 1u);
        const unsigned gen = old / nloc;
        if (old + 1u == (gen + 1u) * nloc) {
            __builtin_amdgcn_fence(__ATOMIC_RELEASE, "agent");
            asm volatile("s_waitcnt vmcnt(0)" ::: "memory");
            const unsigned og = xb_add(&bar[XB_TOP], 1u);
            const unsigned tg = og / nx;
            if (og + 1u == (tg + 1u) * nx) xb_add(&bar[XB_TOPGEN], 1u);
            else XB_SPIN(xb_ld(&bar[XB_TOPGEN]) == tg, bar);
            __builtin_amdgcn_fence(__ATOMIC_ACQUIRE, "agent");
            xb_add(&bar[XB_XGEN(b.x)], 1u);
            asm volatile("s_waitcnt vmcnt(0)" ::: "memory");
        } else {
            XB_SPIN(xb_ld(&bar[XB_XGEN(b.x)]) == gen, bar);
            __builtin_amdgcn_fence(__ATOMIC_ACQUIRE, "agent");
            asm volatile("s_waitcnt vmcnt(0)" ::: "memory");
        }
    }
    __syncthreads();
}

__device__ __forceinline__ float wave_sum(float v) {
#pragma unroll
    for (int o = 1; o < 64; o <<= 1) v += __shfl_xor(v, o);
    return v;
}

struct Args {
    const float* x; const float* c; const int* positions; const float* w_ada; const float* b_ada; const float* w_in; const float* rel_bias;
    const float* ikn_g; const float* ikn_b; const float* w_branch_a; const float* w_branch_b; const float* w_out; const float* ln1_g; const float* ln1_b;
    const float* w_router; const float* router_bias; const float* w_exp_gate; const float* w_exp_up; const float* w_exp_down;
    const float* w_sh_gate; const float* w_sh_up; const float* w_sh_down; const float* ln2_g; const float* ln2_b;
    float* out; unsigned char* ws;
    double inv_freq_rev[8];
    int ph_lo, ph_hi, li, flags;
};
using pg8::Unit; using pg8::cvt_pk_bf16;
__device__ __forceinline__ v4u pack8(const f32x4& v0, const f32x4& v1) { v4u w; w.x = cvt_pk_bf16(v0[0], v0[1]); w.y = cvt_pk_bf16(v0[2], v0[3]); w.z = cvt_pk_bf16(v1[0], v1[1]); w.w = cvt_pk_bf16(v1[2], v1[3]); return w; }

struct EpiInProj {
    static constexpr bool PERM = true, AFTER_DRAIN = false;
    unsigned char* ws; bf16* gates; const float* cosT; const float* sinT;
    __device__ __forceinline__ void operator()(const f32x4 (&acc)[2][2][4][2], const Unit& u, int wr, int wc, int fr, int fq) const {
        const int pn = u.pn, row0 = u.pm * 256 + wr * 64 + fr, ct = wc * 32 + 8 * fq;
        if (pn < 14) {
            size_t off; float sc = 1.f; bool rope = false; int colbase = (pn & 1) * 256;
            if (pn < 12) { const int seg = pn >> 1;
                off = seg == 0 ? WS_QA : seg == 1 ? WS_KA : seg == 2 ? WS_VA : seg == 3 ? WS_QB : seg == 4 ? WS_KB : WS_VB;
                sc = (seg == 0 || seg == 3) ? attn_body::C2 : 1.f; rope = (seg == 3 || seg == 4); }
            else { off = WS_QI; rope = true; }
            bf16* base = (bf16*)(ws + off);
            const bool dor = rope && ((wc & 1) == 0) && (fq < 2);
#pragma unroll
            for (int ai = 0; ai < 2; ++ai)
#pragma unroll
                for (int m = 0; m < 4; ++m) { const int row = row0 + ai * 128 + m * 16;
                    f32x4 c4 = (f32x4){1.f, 1.f, 1.f, 1.f}, s4 = (f32x4){0.f, 0.f, 0.f, 0.f};
                    if (dor) { c4 = *(const f32x4*)(cosT + (size_t)row * 8 + 4 * fq); s4 = *(const f32x4*)(sinT + (size_t)row * 8 + 4 * fq); }
#pragma unroll
                    for (int bj = 0; bj < 2; ++bj) { f32x4 v0 = acc[ai][bj][m][0], v1 = acc[ai][bj][m][1];
                        { f32x4 r0, r1;
                          r0[0] = v0[0] * c4[0] - v0[1] * s4[0]; r0[1] = v0[1] * c4[0] + v0[0] * s4[0]; r0[2] = v0[2] * c4[1] - v0[3] * s4[1]; r0[3] = v0[3] * c4[1] + v0[2] * s4[1];
                          r1[0] = v1[0] * c4[2] - v1[1] * s4[2]; r1[1] = v1[1] * c4[2] + v1[0] * s4[2]; r1[2] = v1[2] * c4[3] - v1[3] * s4[3]; r1[3] = v1[3] * c4[3] + v1[2] * s4[3];
                          v0 = r0 * sc; v1 = r1 * sc; }
                        *(v4u*)(base + (size_t)row * 512 + colbase + bj * 128 + ct) = pack8(v0, v1); } }
        } else if (pn == 14) {
            float* kiw = (float*)(ws + WS_KIW);
#pragma unroll
            for (int ai = 0; ai < 2; ++ai)
#pragma unroll
                for (int m = 0; m < 4; ++m) { const int row = row0 + ai * 128 + m * 16;
                    *(f32x4*)(kiw + (size_t)row * 128 + ct) = acc[ai][0][m][0]; *(f32x4*)(kiw + (size_t)row * 128 + ct + 4) = acc[ai][0][m][1]; }
        } else {
            const int colbase = (pn - 15) * 256;
#pragma unroll
            for (int ai = 0; ai < 2; ++ai)
#pragma unroll
                for (int m = 0; m < 4; ++m) { const int row = row0 + ai * 128 + m * 16;
#pragma unroll
                    for (int bj = 0; bj < 2; ++bj) { f32x4 v0 = acc[ai][bj][m][0], v1 = acc[ai][bj][m][1];
#pragma unroll
                        for (int i = 0; i < 4; ++i) { v0[i] = sigmoidf_(v0[i]); v1[i] = sigmoidf_(v1[i]); }
                        *(v4u*)(gates + (size_t)row * 2048 + colbase + bj * 128 + ct) = pack8(v0, v1); } }
        }
    }
};

template <int PASS> struct EpiGate {
    static constexpr bool PERM = true, AFTER_DRAIN = false;
    const bf16* gates; float* tmp; bf16* merged;
    __device__ __forceinline__ void operator()(const f32x4 (&acc)[2][2][4][2], const Unit& u, int wr, int wc, int fr, int fq) const {
        const int row0 = u.pm * 256 + wr * 64 + fr, c0 = u.pn * 256 + wc * 32 + 8 * fq;
#pragma unroll
        for (int ai = 0; ai < 2; ++ai)
#pragma unroll
            for (int m = 0; m < 4; ++m) { const int row = row0 + ai * 128 + m * 16;
#pragma unroll
                for (int bj = 0; bj < 2; ++bj) { const int c = c0 + bj * 128;
                    const v4u g = *(const v4u*)(gates + (size_t)row * 2048 + (PASS == 1 ? 0 : 1024) + c);
                    f32x4 v0 = acc[ai][bj][m][0], v1 = acc[ai][bj][m][1];
                    v0[0] *= bflo(g.x); v0[1] *= bfhi(g.x); v0[2] *= bflo(g.y); v0[3] *= bfhi(g.y); v1[0] *= bflo(g.z); v1[1] *= bfhi(g.z); v1[2] *= bflo(g.w); v1[3] *= bfhi(g.w);
                    float* tp = tmp + (size_t)row * 1024 + c;
                    if (PASS == 1) { *(f32x4*)tp = v0; *(f32x4*)(tp + 4) = v1; }
                    else { v0 += *(const f32x4*)tp; v1 += *(const f32x4*)(tp + 4); *(v4u*)(merged + (size_t)row * 1024 + c) = pack8(v0, v1); } } }
    }
};

__device__ __forceinline__ float silu_mul(float g, float u) { return g * sigmoidf_(g) * u; }
struct EpiSilu {
    static constexpr bool PERM = true, AFTER_DRAIN = false;
    bf16* H;
    __device__ __forceinline__ void operator()(const f32x4 (&acc)[2][2][4][2], const Unit& u, int wr, int wc, int fr, int fq) const {
        const int row0 = u.pm * 256 + wr * 64 + fr, c0 = (u.pn * 256 + wc * 32 + 8 * fq) >> 1;
#pragma unroll
        for (int ai = 0; ai < 2; ++ai)
#pragma unroll
            for (int m = 0; m < 4; ++m) { const int row = row0 + ai * 128 + m * 16;
#pragma unroll
                for (int bj = 0; bj < 2; ++bj) { const f32x4 v0 = acc[ai][bj][m][0], v1 = acc[ai][bj][m][1];
                    v2u w; w.x = cvt_pk_bf16(silu_mul(v0[0], v0[1]), silu_mul(v0[2], v0[3])); w.y = cvt_pk_bf16(silu_mul(v1[0], v1[1]), silu_mul(v1[2], v1[3]));
                    *(v2u*)(H + (size_t)row * 256 + c0 + bj * 64) = w; } }
    }
};
struct EpiExpGU {
    static constexpr bool PERM = true, AFTER_DRAIN = false;
    bf16* H; const LAS int* xt; const unsigned short* list; const float* rw; int chunk;
    __device__ __forceinline__ void operator()(const f32x4 (&acc)[2][2][4][2], const Unit& u, int wr, int wc, int fr, int fq) const {
        const int r0 = wr * 64 + fr, c0 = (u.pn * 256 + wc * 32 + 8 * fq) >> 1; const int pos0 = __builtin_amdgcn_readfirstlane(xt[144 + u.e]) + u.pm * 256;
#pragma unroll
        for (int ai = 0; ai < 2; ++ai)
#pragma unroll
            for (int m = 0; m < 4; ++m) { const int r = r0 + ai * 128 + m * 16;
                if (r < u.nrows) { const unsigned ent = list[(size_t)u.e * 8192 + u.pm * 256 + r]; const float w = rw[(size_t)(chunk * CHTOK + (int)(ent >> 3)) * 8 + (ent & 7u)];
#pragma unroll
                    for (int bj = 0; bj < 2; ++bj) { const f32x4 v0 = acc[ai][bj][m][0], v1 = acc[ai][bj][m][1];
                        v2u pk; pk.x = cvt_pk_bf16(w * silu_mul(v0[0], v0[1]), w * silu_mul(v0[2], v0[3])); pk.y = cvt_pk_bf16(w * silu_mul(v1[0], v1[1]), w * silu_mul(v1[2], v1[3]));
                        *(v2u*)(H + (size_t)(pos0 + r) * 256 + c0 + bj * 64) = pk; } } }
    }
};
struct EpiExpD {
    static constexpr bool PERM = true, AFTER_DRAIN = false;
    bf16* Y; const LAS int* xt;
    __device__ __forceinline__ void operator()(const f32x4 (&acc)[2][2][4][2], const Unit& u, int wr, int wc, int fr, int fq) const {
        const int r0 = wr * 64 + fr, c0 = u.pn * 256 + wc * 32 + 8 * fq; const int pos0 = __builtin_amdgcn_readfirstlane(xt[144 + u.e]) + u.pm * 256;
#pragma unroll
        for (int ai = 0; ai < 2; ++ai)
#pragma unroll
            for (int m = 0; m < 4; ++m) { const int r = r0 + ai * 128 + m * 16;
                if (r < u.nrows) {
#pragma unroll
                    for (int bj = 0; bj < 2; ++bj) *(v4u*)(Y + (size_t)(pos0 + r) * 1024 + c0 + bj * 128) = pack8(acc[ai][bj][m][0], acc[ai][bj][m][1]); } }
    }
};
struct EpiShD {
    static constexpr bool PERM = true, AFTER_DRAIN = false;
    float* z; const float* mod;
    __device__ __forceinline__ void operator()(const f32x4 (&acc)[2][2][4][2], const Unit& u, int wr, int wc, int fr, int fq) const {
        const int row0 = u.pm * 256 + wr * 64 + fr, c0 = u.pn * 256 + wc * 32 + 8 * fq; const float* g2 = mod + (size_t)(u.pm >> 3) * 6144 + 5120;
#pragma unroll
        for (int bj = 0; bj < 2; ++bj) { const int c = c0 + bj * 128; const f32x4 ga = *(const f32x4*)(g2 + c), gb = *(const f32x4*)(g2 + c + 4);
#pragma unroll
            for (int ai = 0; ai < 2; ++ai)
#pragma unroll
                for (int m = 0; m < 4; ++m) { float* p = z + (size_t)(row0 + ai * 128 + m * 16) * 1024 + c;
                    const f32x4 a = *(const f32x4*)p, b = *(const f32x4*)(p + 4);
                    *(f32x4*)p = a * DN_ALPHA + ga * acc[ai][bj][m][0]; *(f32x4*)(p + 4) = b * DN_ALPHA + gb * acc[ai][bj][m][1]; } }
    }
};
struct EpiResid {
    static constexpr bool PERM = true, AFTER_DRAIN = false;
    const float* x; float* v; const float* mod;
    __device__ __forceinline__ void operator()(const f32x4 (&acc)[2][2][4][2], const Unit& u, int wr, int wc, int fr, int fq) const {
        const int row0 = u.pm * 256 + wr * 64 + fr, c0 = u.pn * 256 + wc * 32 + 8 * fq; const float* g1 = mod + (size_t)(u.pm >> 3) * 6144 + 2048;
#pragma unroll
        for (int bj = 0; bj < 2; ++bj) { const int c = c0 + bj * 128; const f32x4 ga = *(const f32x4*)(g1 + c), gb = *(const f32x4*)(g1 + c + 4);
#pragma unroll
            for (int ai = 0; ai < 2; ++ai)
#pragma unroll
                for (int m = 0; m < 4; ++m) { const size_t o = (size_t)(row0 + ai * 128 + m * 16) * 1024 + c;
                    const f32x4 a = *(const f32x4*)(x + o), b = *(const f32x4*)(x + o + 4);
                    *(f32x4*)(v + o) = a * DN_ALPHA + ga * acc[ai][bj][m][0]; *(f32x4*)(v + o + 4) = b * DN_ALPHA + gb * acc[ai][bj][m][1]; } }
    }
};

template <int MODE> struct ExpertOrder {
    const LAS int* xt; int nN, G, c, total, chunk; const unsigned short* list; const char* W; size_t wexp, btile;
    __device__ __forceinline__ bool next(int i, Unit& u) const {
        const long L = (long)i * G + c; if (L >= (long)total * nN) return false;
        const int lt = (int)(L / nN); u.pn = (int)(L - (long)lt * nN);
        int e = 0;
#pragma unroll
        for (int s = 32; s >= 1; s >>= 1) { const int v = __builtin_amdgcn_readfirstlane(xt[e + s]); if (v <= lt) e += s; }
        u.e = e; u.pm = lt - __builtin_amdgcn_readfirstlane(xt[e]); const int rem = __builtin_amdgcn_readfirstlane(xt[80 + e]) - u.pm * 256; u.nrows = rem < 256 ? rem : 256; return true;
    }
    __device__ __forceinline__ unsigned a_off(const Unit& u, int row) const {
        if (MODE == 0) { int idx = u.pm * 256 + row; const int last = __builtin_amdgcn_readfirstlane(xt[80 + u.e]) - 1; idx = idx < last ? idx : last;
            const unsigned ent = list[(size_t)u.e * 8192 + idx]; return (unsigned)(chunk * CHTOK + (int)(ent >> 3)) * 2048u; }
        int p = __builtin_amdgcn_readfirstlane(xt[144 + u.e]) + u.pm * 256 + row; p = p < CHROWS - 1 ? p : CHROWS - 1; return (unsigned)p * 512u;
    }
    __device__ __forceinline__ const char* b_ptr(const Unit& u) const { return W + (size_t)u.e * wexp + (size_t)u.pn * btile; }
};
__device__ __forceinline__ void build_xtab(LAS int* xt, const unsigned* ctl, int chunk) {
    int tid = threadIdx.x; asm volatile("" : "+v"(tid));
    if (tid < 64) xt[80 + tid] = (int)__hip_atomic_load(ctl + CW_CNT + (chunk * 64 + tid) * 16, RLX_AGENT);
    LDS_WAIT(); __syncthreads();
    if (tid == 0) { int ts = 0, of = 0; for (int e = 0; e < 64; ++e) { const int c = xt[80 + e]; xt[e] = ts; xt[144 + e] = of; ts += (c + 255) >> 8; of += c; } xt[64] = ts; }
    LDS_WAIT(); __syncthreads();
}
struct Ctx { LAS unsigned char* lds; int tid, lane, wave, vcu, G; };

struct MapId { int base; __device__ __forceinline__ int operator()(int s) const { return base + s; } };
struct MapIl { int base, par; __device__ __forceinline__ int operator()(int s) const { return base + 2 * s + par; } };
__device__ __forceinline__ int dperm_inv(int d) { return d < 8 ? 2 * d : (d < 16 ? 2 * (d - 8) + 1 : d); }
struct MapIn { __device__ __forceinline__ int operator()(int s) const {
    if (s < 1536) return s;
    if (s < 3072) { const int q = s - 1536, seg = q >> 9, hh = (q >> 6) & 7, d = q & 63; return 1536 + seg * 512 + hh * 64 + (seg < 2 ? dperm_inv(d) : d); }
    if (s < 3584) { const int q = s - 3072, hh = q >> 6, d = q & 63; return 3072 + hh * 64 + dperm_inv(d); }
    if (s < 3656) return s;
    return 3840 + (s - 3656); } };
template <class Map> __device__ __forceinline__ void xpose_item(const float* W, int N, int K, int item, bf16* WT, const Map& map, LAS float* scr, int lane) {
    const int nblk = (N + 31) / 32, kb = item / nblk, nb = item % nblk, k0 = 64 * kb, n0 = 32 * nb;
    const bool cin = (n0 + (lane & 31)) < N;
#pragma unroll 8
    for (int i = 0; i < 32; ++i) { const int kk = 2 * i + (lane >> 5); scr[kk * 33 + (lane & 31)] = cin ? W[(size_t)(k0 + kk) * N + n0 + (lane & 31)] : 0.f; }
    LDS_WAIT(); asm volatile("" ::: "memory");
    const int c = lane & 7;
#pragma unroll
    for (int j = 0; j < 4; ++j) { const int n = (lane >> 3) + 8 * j; const LAS float* s = scr + (8 * c) * 33 + n;
        v4u o; o.x = pk2(s[0 * 33], s[1 * 33]); o.y = pk2(s[2 * 33], s[3 * 33]); o.z = pk2(s[4 * 33], s[5 * 33]); o.w = pk2(s[6 * 33], s[7 * 33]);
        if (n0 + n < N) *(GAS v4u*)(WT + (size_t)map(n0 + n) * K + k0 + 8 * c) = o; }
    LDS_WAIT(); asm volatile("" ::: "memory");
}

__device__ __forceinline__ void p0_prologue(const Args& a, const Ctx& F) {
    unsigned char* ws = a.ws;
    {
        LAS float* cact = (LAS float*)(F.lds);
        LAS float* red = (LAS float*)(F.lds + 32768);
        for (int i = F.tid; i < 8 * 1024; i += 512) { const float v = a.c[i]; cact[i] = v * sigmoidf_(v); }
        LDS_WAIT(); __syncthreads();
        float* mod = (float*)(ws + WS_MOD);
        for (int item = F.vcu; item < 6144 / 32; item += F.G) {
            const int n0 = item * 32, kk = F.tid >> 5, col = F.tid & 31; float acc[8];
#pragma unroll
            for (int b = 0; b < 8; ++b) acc[b] = 0.f;
#pragma unroll 4
            for (int k = kk; k < 1024; k += 16) { const float w = a.w_ada[(size_t)k * 6144 + n0 + col];
#pragma unroll
                for (int b = 0; b < 8; ++b) acc[b] += cact[b * 1024 + k] * w; }
#pragma unroll
            for (int b = 0; b < 8; ++b) red[(kk * 8 + b) * 32 + col] = acc[b];
            LDS_WAIT(); __syncthreads();
            if (F.tid < 256) { const int b = F.tid >> 5; float s = 0.f;
#pragma unroll
                for (int q = 0; q < 16; ++q) s += red[(q * 8 + b) * 32 + col];
                mod[(size_t)b * 6144 + n0 + col] = s + a.b_ada[n0 + col]; }
            LDS_WAIT(); __syncthreads();
        }
        LDS_WAIT(); __syncthreads();
    }
    const int gw = F.vcu * NWAVES + F.wave, NGW = F.G * NWAVES;
    {
        float* cosT = (float*)(ws + WS_ROPE); float* sinT = cosT + (size_t)T * 8;
        for (int i = gw * 64 + F.lane; i < T * 8; i += NGW * 64) { const int t = i >> 3, j = i & 7;
            const double rev = (double)a.positions[t] * a.inv_freq_rev[j]; const float fr = (float)(rev - __builtin_floor(rev));
            cosT[i] = __builtin_amdgcn_cosf(fr); sinT[i] = __builtin_amdgcn_sinf(fr); }
    }
    {
        v4u* z = (v4u*)((bf16*)(ws + WS_WIN) + (size_t)3656 * 1024); const int n16 = 184 * 1024 * 2 / 16;
        for (int i = gw * 64 + F.lane; i < n16; i += NGW * 64) z[i] = (v4u){0u, 0u, 0u, 0u};
    }
    LAS float* scr = (LAS float*)(F.lds + F.wave * 16384);
    constexpr int I_IN = 16 * 179, I_BR = 8 * 32, I_OUT = 16 * 32, I_SG = 16 * 8, I_SD = 4 * 32, I_EG = 64 * 16 * 8, I_EDN = 64 * 4 * 32;
    constexpr int NITEMS = I_IN + 2 * I_BR + I_OUT + 2 * I_SG + I_SD + 2 * I_EG + I_EDN;
    for (int it = gw; it < NITEMS; it += NGW) {
        int r = it;
        if (r < I_IN) { xpose_item(a.w_in, DIN, 1024, r, (bf16*)(ws + WS_WIN), MapIn{}, scr, F.lane); continue; } r -= I_IN;
        if (r < I_BR) { xpose_item(a.w_branch_a, 1024, 512, r, (bf16*)(ws + WS_WA), MapId{0}, scr, F.lane); continue; } r -= I_BR;
        if (r < I_BR) { xpose_item(a.w_branch_b, 1024, 512, r, (bf16*)(ws + WS_WB), MapId{0}, scr, F.lane); continue; } r -= I_BR;
        if (r < I_OUT) { xpose_item(a.w_out, 1024, 1024, r, (bf16*)(ws + WS_WOUT), MapId{0}, scr, F.lane); continue; } r -= I_OUT;
        if (r < I_SG) { xpose_item(a.w_sh_gate, 256, 1024, r, (bf16*)(ws + WS_SHGU), MapIl{0, 0}, scr, F.lane); continue; } r -= I_SG;
        if (r < I_SG) { xpose_item(a.w_sh_up, 256, 1024, r, (bf16*)(ws + WS_SHGU), MapIl{0, 1}, scr, F.lane); continue; } r -= I_SG;
        if (r < I_SD) { xpose_item(a.w_sh_down, 1024, 256, r, (bf16*)(ws + WS_SHD), MapId{0}, scr, F.lane); continue; } r -= I_SD;
        if (r < I_EG) { const int e = r >> 7; xpose_item(a.w_exp_gate + (size_t)e * 1024 * 256, 256, 1024, r & 127, (bf16*)(ws + WS_EGU) + (size_t)e * 512 * 1024, MapIl{0, 0}, scr, F.lane); continue; } r -= I_EG;
        if (r < I_EG) { const int e = r >> 7; xpose_item(a.w_exp_up + (size_t)e * 1024 * 256, 256, 1024, r & 127, (bf16*)(ws + WS_EGU) + (size_t)e * 512 * 1024, MapIl{0, 1}, scr, F.lane); continue; } r -= I_EG;
        { const int e = r >> 7; xpose_item(a.w_exp_down + (size_t)e * 256 * 1024, 1024, 256, r & 127, (bf16*)(ws + WS_ED) + (size_t)e * 1024 * 256, MapId{0}, scr, F.lane); }
    }
}

__device__ __forceinline__ void ln_stats(const f32x4 (&v)[4], float& mean, float& rstd) {
    float s = 0.f;
#pragma unroll
    for (int j = 0; j < 4; ++j) s += (v[j].x + v[j].y) + (v[j].z + v[j].w);
    mean = wave_sum(s) * (1.f / D); float s2 = 0.f;
#pragma unroll
    for (int j = 0; j < 4; ++j) { const f32x4 d = v[j] - mean; s2 += (d.x * d.x + d.y * d.y) + (d.z * d.z + d.w * d.w); }
    rstd = 1.f / sqrtf(wave_sum(s2) * (1.f / D) + LN_EPS);
}
__device__ __forceinline__ void p1_ln_mod(const Args& a, const Ctx& F) {
    const int gw = F.vcu * NWAVES + F.wave, NGW = F.G * NWAVES; const float* mod = (const float*)(a.ws + WS_MOD); bf16* XN = (bf16*)(a.ws + WS_XN);
    for (int m = gw; m < T; m += NGW) {
        const GAS f32x4* xr = (const GAS f32x4*)(a.x + (size_t)m * D) + F.lane; const float* mb = mod + (size_t)(m >> 11) * 6144;
        f32x4 v[4];
#pragma unroll
        for (int j = 0; j < 4; ++j) v[j] = xr[64 * j];
        float mean, rstd; ln_stats(v, mean, rstd);
        GAS unsigned long long* o8 = (GAS unsigned long long*)(XN + (size_t)m * D) + F.lane;
#pragma unroll
        for (int j = 0; j < 4; ++j) { const f32x4 sc = *(const f32x4*)(mb + 1024 + 4 * F.lane + 256 * j), sh = *(const f32x4*)(mb + 4 * F.lane + 256 * j);
            const f32x4 u = (v[j] - mean) * rstd * (sc + 1.0f) + sh;
            o8[64 * j] = (unsigned long long)pk2(u.x, u.y) | ((unsigned long long)pk2(u.z, u.w) << 32); }
    }
}
__device__ __forceinline__ void p_ln1_rows(const Args& a, const Ctx& F) {
    const int gw = F.vcu * NWAVES + F.wave, NGW = F.G * NWAVES; const float* mod = (const float*)(a.ws + WS_MOD); bf16* XN = (bf16*)(a.ws + WS_XN); float* stats = (float*)(a.ws + WS_STATS);
    for (int m = gw; m < T; m += NGW) {
        GAS f32x4* vr = (GAS f32x4*)(a.out + (size_t)m * D) + F.lane; const float* mb = mod + (size_t)(m >> 11) * 6144;
        f32x4 v[4];
#pragma unroll
        for (int j = 0; j < 4; ++j) v[j] = vr[64 * j];
        float mean, rstd; ln_stats(v, mean, rstd);
#pragma unroll
        for (int j = 0; j < 4; ++j) { const f32x4 lg = *(const f32x4*)(a.ln1_g + 4 * F.lane + 256 * j), lb = *(const f32x4*)(a.ln1_b + 4 * F.lane + 256 * j); v[j] = (v[j] - mean) * rstd * lg + lb; vr[64 * j] = v[j]; }
        ln_stats(v, mean, rstd);
        if (F.lane == 0) { stats[(size_t)m * 2] = mean; stats[(size_t)m * 2 + 1] = rstd; }
        GAS unsigned long long* o8 = (GAS unsigned long long*)(XN + (size_t)m * D) + F.lane;
#pragma unroll
        for (int j = 0; j < 4; ++j) { const f32x4 sc = *(const f32x4*)(mb + 4096 + 4 * F.lane + 256 * j), sh = *(const f32x4*)(mb + 3072 + 4 * F.lane + 256 * j);
            const f32x4 u = (v[j] - mean) * rstd * (sc + 1.0f) + sh;
            o8[64 * j] = (unsigned long long)pk2(u.x, u.y) | ((unsigned long long)pk2(u.z, u.w) << 32); }
    }
}
__device__ __forceinline__ void p3_kidx(const Args& a, const Ctx& F) {
    const float* kiw = (const float*)(a.ws + WS_KIW); bf16* KI = (bf16*)(a.ws + WS_KI); float* WI = (float*)(a.ws + WS_WI);
    const float* cosT = (const float*)(a.ws + WS_ROPE); const float* sinT = cosT + (size_t)T * 8;
    for (int t = F.vcu * 512 + F.tid; t < T; t += F.G * 512) {
        float v[64]; const f32x4* src = (const f32x4*)(kiw + (size_t)t * 128);
#pragma unroll
        for (int i = 0; i < 16; ++i) { const f32x4 q = src[i]; v[4 * i] = q.x; v[4 * i + 1] = q.y; v[4 * i + 2] = q.z; v[4 * i + 3] = q.w; }
        float s = 0.f;
#pragma unroll
        for (int i = 0; i < 64; ++i) s += v[i];
        const float mean = s * (1.f / 64.f); float s2 = 0.f;
#pragma unroll
        for (int i = 0; i < 64; ++i) { const float d = v[i] - mean; s2 += d * d; }
        const float rstd = 1.f / sqrtf(s2 * (1.f / 64.f) + LN_EPS);
#pragma unroll
        for (int i = 0; i < 64; ++i) v[i] = (v[i] - mean) * rstd * a.ikn_g[i] + a.ikn_b[i];
        float o[64];
#pragma unroll
        for (int j = 0; j < 8; ++j) { const float c = cosT[(size_t)t * 8 + j], sn = sinT[(size_t)t * 8 + j]; o[2 * j] = v[j] * c - v[j + 8] * sn; o[2 * j + 1] = v[j + 8] * c + v[j] * sn; }
#pragma unroll
        for (int i = 16; i < 64; ++i) o[i] = v[i];
        v4u* dst = (v4u*)(KI + (size_t)t * 64);
#pragma unroll
        for (int i = 0; i < 8; ++i) { v4u w; w.x = pk2(o[8 * i], o[8 * i + 1]); w.y = pk2(o[8 * i + 2], o[8 * i + 3]); w.z = pk2(o[8 * i + 4], o[8 * i + 5]); w.w = pk2(o[8 * i + 6], o[8 * i + 7]); dst[i] = w; }
        const f32x4 w0 = src[16], w1 = src[17]; const float ws_ = 0.35355339059327373f * 0.125f;
        *(f32x4*)(WI + (size_t)t * 8) = w0 * ws_; *(f32x4*)(WI + (size_t)t * 8 + 4) = w1 * ws_;
    }
}

__device__ __forceinline__ unsigned fkey(float v) { unsigned u = __float_as_uint(v); if (v == 0.f) u = 0u; return (u & 0x80000000u) ? ~u : (u | 0x80000000u); }
__device__ __forceinline__ void idx_unit(const Args& a, const Ctx& F, int b, int c, int sub) {
    const bf16* QI = (const bf16*)(a.ws + WS_QI); const bf16* KI = (const bf16*)(a.ws + WS_KI); const float* WI = (const float*)(a.ws + WS_WI);
    unsigned long long* SEL = (unsigned long long*)(a.ws + WS_SEL);
    const int t0 = b * SEQ + c * 64 + sub * 16, L = 64 * (c + 1), lane = F.lane, wid = F.wave;
    if (c < 4) {
        if (F.tid < 16 * 32) { const int r = F.tid >> 5, w = F.tid & 31; const int lo = 64 * w; unsigned long long m = 0ull;
            if (lo + 64 <= L) m = ~0ull; SEL[(size_t)(t0 + r) * 32 + w] = m; }
        return;
    }
    LAS float* Ssc = (LAS float*)F.lds;
    const int r32 = lane & 31, hi = lane >> 5;
    bf16x8 af[4][4]; float wv[4][16];
#pragma unroll
    for (int rb = 0; rb < 4; ++rb) { const int tl = r32 >> 3, h = r32 & 7; const bf16* qrow = QI + (size_t)(t0 + 4 * rb + tl) * 512 + h * 64 + hi * 8;
#pragma unroll
        for (int s = 0; s < 4; ++s) af[rb][s] = *(const bf16x8*)(qrow + 16 * s);
#pragma unroll
        for (int i = 0; i < 16; ++i) wv[rb][i] = WI[(size_t)(t0 + 4 * rb + (i >> 2)) * 8 + 4 * hi + (i & 3)]; }
    const int nkt = L >> 5;
    for (int kt = wid; kt < nkt; kt += 8) {
        const bf16* krow = KI + (size_t)(b * SEQ + 32 * kt + r32) * 64 + hi * 8; bf16x8 bfr[4];
#pragma unroll
        for (int s = 0; s < 4; ++s) bfr[s] = *(const bf16x8*)(krow + 16 * s);
#pragma unroll
        for (int rb = 0; rb < 4; ++rb) { f32x16 acc = f32x16{};
#pragma unroll
            for (int s = 0; s < 4; ++s) acc = __builtin_amdgcn_mfma_f32_32x32x16_bf16(af[rb][s], bfr[s], acc, 0, 0, 0);
            float p[4];
#pragma unroll
            for (int g = 0; g < 4; ++g) { float q = 0.f;
#pragma unroll
                for (int i = 0; i < 4; ++i) q += wv[rb][4 * g + i] * __builtin_fmaxf(acc[4 * g + i], 0.f);
                p[g] = q; }
#pragma unroll
            for (int g = 0; g < 4; ++g) { auto rr = __builtin_amdgcn_permlane32_swap(__float_as_uint(p[g]), __float_as_uint(p[g]), false, false); p[g] = __uint_as_float(rr[0]) + __uint_as_float(rr[1]); }
            const float s0 = hi ? p[2] : p[0], s1 = hi ? p[3] : p[1];
            Ssc[(4 * rb + 2 * hi) * 2048 + 32 * kt + r32] = s0; Ssc[(4 * rb + 2 * hi + 1) * 2048 + 32 * kt + r32] = s1; }
    }
    LDS_WAIT(); __syncthreads();
    const int n = L >> 6;
    for (int rr_ = 0; rr_ < 2; ++rr_) { const int row = 2 * wid + rr_;
        unsigned key[32];
#pragma unroll
        for (int i = 0; i < 32; ++i) key[i] = (i < n) ? fkey(Ssc[row * 2048 + 64 * i + lane]) : 0u;
        unsigned Tk = 0u;
        for (int bit = 31; bit >= 0; --bit) { const unsigned cand = Tk | (1u << bit); int cnt = 0;
#pragma unroll
            for (int i = 0; i < 32; ++i) cnt += __builtin_popcountll(__ballot(key[i] >= cand));
            if (cnt >= 256) Tk = cand; }
        int cgt = 0;
#pragma unroll
        for (int i = 0; i < 32; ++i) cgt += __builtin_popcountll(__ballot(key[i] > Tk));
        const int need = 256 - cgt; int taken = 0; unsigned long long myw = 0ull;
#pragma unroll
        for (int i = 0; i < 32; ++i) { const bool eq = key[i] == Tk; const unsigned long long em = __ballot(eq);
            const int rank = (int)__builtin_amdgcn_mbcnt_hi((unsigned)(em >> 32), __builtin_amdgcn_mbcnt_lo((unsigned)em, 0u));
            const bool s = (key[i] > Tk) || (eq && (taken + rank < need)); const unsigned long long w = __ballot(s);
            taken += __builtin_popcountll(em); if (lane == i) myw = w; }
        if (lane < 32) SEL[(size_t)(t0 + row) * 32 + lane] = myw;
    }
    LDS_WAIT(); __syncthreads();
}

__device__ __forceinline__ void router_unit(const Args& a, const Ctx& F, int tb) {
    const float* X1 = a.out; const float* stats = (const float*)(a.ws + WS_STATS); const float* mod = (const float*)(a.ws + WS_MOD);
    unsigned* ctl = (unsigned*)(a.ws + WS_CTL); unsigned* ER = (unsigned*)(a.ws + WS_TAB + TAB_ER); float* RW = (float*)(a.ws + WS_TAB + TAB_W); unsigned short* LIST = (unsigned short*)(a.ws + WS_TAB + TAB_LIST);
    const int t0 = tb * 64, b = t0 >> 11, lane = F.lane, wid = F.wave, tid = F.tid;
    LAS float* U = (LAS float*)F.lds;
    LAS float* Wc = (LAS float*)(F.lds + 33792);
    LAS float* Lg = (LAS float*)(F.lds + 33792 + 32768);
    const float* mb = mod + (size_t)b * 6144;
    const int rh = wid & 1, eh = (wid >> 1) & 1, kh = wid >> 2, r32 = lane & 31, kk = lane >> 5;
    f32x16 acc = f32x16{};
    const int urow = tid >> 3, ucol = (tid & 7) * 16; const f32x2 st = *(const f32x2*)(stats + (size_t)(t0 + urow) * 2);
    for (int kc = 0; kc < 8; ++kc) {
        const int k0 = kc * 128;
#pragma unroll
        for (int q = 0; q < 4; ++q) { const int k = k0 + ucol + 4 * q; const f32x4 xv = *(const f32x4*)(X1 + (size_t)(t0 + urow) * 1024 + k);
            const f32x4 sc = *(const f32x4*)(mb + 4096 + k), sh = *(const f32x4*)(mb + 3072 + k); const f32x4 u = (xv - st.x) * st.y * (sc + 1.0f) + sh;
            LAS float* d = U + urow * 129 + ucol + 4 * q; d[0] = u.x; d[1] = u.y; d[2] = u.z; d[3] = u.w; }
#pragma unroll
        for (int q = 0; q < 4; ++q) { const int idx = tid * 16 + 4 * q; *(LAS f32x4*)(Wc + idx) = *(const f32x4*)(a.w_router + (size_t)k0 * 64 + idx); }
        LDS_WAIT(); __syncthreads();
#pragma unroll 8
        for (int s = 0; s < 32; ++s) { const int k = kh * 64 + 2 * s + kk;
            acc = __builtin_amdgcn_mfma_f32_32x32x2f32(U[(rh * 32 + r32) * 129 + k], Wc[k * 64 + eh * 32 + r32], acc, 0, 0, 0); }
        LDS_WAIT(); __syncthreads();
    }
#pragma unroll
    for (int i = 0; i < 16; ++i) { const int row = (i & 3) + 8 * (i >> 2) + 4 * kk; Lg[(kh * 64 + rh * 32 + row) * 65 + eh * 32 + r32] = acc[i]; }
    LDS_WAIT(); __syncthreads();
    for (int j = 0; j < 8; ++j) { const int tl = wid * 8 + j, t = t0 + tl; const int e = lane;
        const float logit = Lg[tl * 65 + e] + Lg[(64 + tl) * 65 + e];
        const float aff = 1.0f / (1.0f + __expf(-logit)); const float bsd = aff + a.router_bias[e];
        float m1 = bsd; m1 = __builtin_fmaxf(m1, __shfl_xor(m1, 1)); m1 = __builtin_fmaxf(m1, __shfl_xor(m1, 2)); m1 = __builtin_fmaxf(m1, __shfl_xor(m1, 4));
        const unsigned long long em = __ballot(bsd == m1); const int g = e >> 3; const unsigned gm = (unsigned)(em >> (8 * g)) & 0xffu; const int first = 8 * g + __builtin_ctz(gm);
        float m2 = (e == first) ? -INFINITY : bsd; m2 = __builtin_fmaxf(m2, __shfl_xor(m2, 1)); m2 = __builtin_fmaxf(m2, __shfl_xor(m2, 2)); m2 = __builtin_fmaxf(m2, __shfl_xor(m2, 4));
        const float gs = m1 + m2; int grank = 0;
#pragma unroll
        for (int g2 = 0; g2 < 8; ++g2) { const float s2 = __uint_as_float(__builtin_amdgcn_readlane(__float_as_uint(gs), 8 * g2)); grank += (s2 > gs || (s2 == gs && g2 < g)) ? 1 : 0; }
        const bool gsel = grank < 4; const float mv = gsel ? bsd : -INFINITY; int rk = 0;
#pragma unroll
        for (int e2 = 0; e2 < 64; ++e2) { const float v = __uint_as_float(__builtin_amdgcn_readlane(__float_as_uint(mv), e2)); rk += (v > mv || (v == mv && e2 < e)) ? 1 : 0; }
        const bool sel = gsel && rk < 8; const float sa = wave_sum(sel ? aff : 0.f);
        if (sel) { const int chunk = t / CHTOK, tk = t - chunk * CHTOK;
            const unsigned r = __hip_atomic_fetch_add(ctl + CW_CNT + (chunk * 64 + e) * 16, 1u, RLX_AGENT);
            ER[(size_t)t * 8 + rk] = ((unsigned)e << 16) | r; RW[(size_t)t * 8 + rk] = aff / sa;
            LIST[((size_t)chunk * 64 + e) * 8192 + r] = (unsigned short)((tk << 3) | rk); }
    }
    LDS_WAIT(); __syncthreads();
}

__device__ __forceinline__ void combine_rows(const Args& a, const Ctx& F, int chunk, const LAS int* xt) {
    const int gw = F.vcu * NWAVES + F.wave, NGW = F.G * NWAVES; const float* mod = (const float*)(a.ws + WS_MOD); const bf16* Y = (const bf16*)(a.ws + WS_YEXP);
    const unsigned* ER = (const unsigned*)(a.ws + WS_TAB + TAB_ER);
    for (int m = chunk * CHTOK + gw; m < (chunk + 1) * CHTOK; m += NGW) {
        GAS f32x4* zr = (GAS f32x4*)(a.out + (size_t)m * D) + F.lane; const float* g2 = mod + (size_t)(m >> 11) * 6144 + 5120;
        f32x4 y[4];
#pragma unroll
        for (int j = 0; j < 4; ++j) y[j] = (f32x4){0.f, 0.f, 0.f, 0.f};
#pragma unroll
        for (int s = 0; s < 8; ++s) { const unsigned er = ER[(size_t)m * 8 + s]; const int pos = xt[144 + (int)(er >> 16)] + (int)(er & 0xffffu);
            const v2u* yr = (const v2u*)(Y + (size_t)pos * 1024) + F.lane;
#pragma unroll
            for (int j = 0; j < 4; ++j) { const v2u w = yr[64 * j]; y[j].x += bflo(w.x); y[j].y += bfhi(w.x); y[j].z += bflo(w.y); y[j].w += bfhi(w.y); } }
        f32x4 v[4];
#pragma unroll
        for (int j = 0; j < 4; ++j) { const f32x4 g = *(const f32x4*)(g2 + 4 * F.lane + 256 * j); v[j] = zr[64 * j] + g * y[j]; }
        float mean, rstd; ln_stats(v, mean, rstd);
#pragma unroll
        for (int j = 0; j < 4; ++j) { const f32x4 lg = *(const f32x4*)(a.ln2_g + 4 * F.lane + 256 * j), lb = *(const f32x4*)(a.ln2_b + 4 * F.lane + 256 * j);
            zr[64 * j] = (v[j] - mean) * rstd * lg + lb; }
    }
}
#ifndef MK_N_LAUNCHES
#define MK_N_LAUNCHES 1
#endif
__global__ void __launch_bounds__(NWAVES * 64, 2) mk_fwd(Args a) {
    extern __shared__ __attribute__((aligned(16))) unsigned char lds[];
    Ctx F; F.lds = (LAS unsigned char*)lds; F.tid = threadIdx.x; F.lane = F.tid & 63; F.wave = __builtin_amdgcn_readfirstlane(F.tid >> 6);
    F.G = gridDim.x; { const int bx = blockIdx.x; F.vcu = (F.G % 8 == 0) ? (bx % 8) * (F.G / 8) + bx / 8 : bx; }
    volatile LAS unsigned* MISC = (volatile LAS unsigned*)(F.lds + MISC_OFF);
    LAS int* xt = (LAS int*)(F.lds + XTAB_OFF);
    unsigned char* ws = a.ws; unsigned* ctl = (unsigned*)(ws + WS_CTL);
    for (int u = F.tid; u < (LDS_BYTES - LDSCTL_OFF) / 4; u += NWAVES * 64) ((LAS unsigned*)(F.lds + LDSCTL_OFF))[u] = 0u;
    __syncthreads();
    const int lo = a.ph_lo, hi = a.ph_hi;
    XcdBarrier bar; bar.bar = ctl + CW_BAR; bar.x = 0; bar.st = nullptr;
    if (hi - lo > 1) bar = xcd_barrier_post(ctl + CW_BAR, MISC + 8);
#ifndef PHM
#define PHM 0xffff
#endif
#define IN(k) (((PHM >> (k)) & 1) && lo <= (k) && (k) < hi)
#define SEAM(k) do { if (IN(k) && IN((k) + 1)) xcd_barrier(bar); { int t_ = threadIdx.x; asm volatile("" : "+v"(t_)); F.tid = t_; F.lane = t_ & 63; F.wave = __builtin_amdgcn_readfirstlane(t_ >> 6); } } while (0)
    const float* mod = (const float*)(ws + WS_MOD);
    bf16* XN = (bf16*)(ws + WS_XN);

    if (IN(0)) { p0_prologue(a, F); } SEAM(0);
    if (IN(1)) { p1_ln_mod(a, F); } SEAM(1);
    if (IN(2)) {
        pg8::Gemm g{XN, 1024}; pg8::DenseOrder S; S.init(T, DINP, 1024, ws + WS_WIN, F.G, (int)blockIdx.x);
        EpiInProj E{ws, (bf16*)a.out, (const float*)(ws + WS_ROPE), (const float*)(ws + WS_ROPE) + (size_t)T * 8};
        pg8::gemm_phase<EpiInProj, pg8::DenseOrder, true>(F.lds + RING_OFF, g, S, E);
    } SEAM(2);
    if (IN(3)) { p3_kidx(a, F); } SEAM(3);
    if (IN(4)) {
        if (!(a.flags & 1)) for (int uix = F.vcu; uix < 1024; uix += F.G) { const int r = uix >> 8, w = uix & 255, b = w >> 5, i = w & 31; idx_unit(a, F, b, r < 2 ? i : 31 - i, r); }
        __syncthreads();
        if (!(a.flags & 2)) for (int uix = F.vcu; uix < 512; uix += F.G) { const int r = uix >> 8, w = uix & 255, bh = w >> 2, s = w & 3; const int qb = s == 0 ? (r ? 2 : 0) : s == 1 ? (r ? 3 : 1) : s == 2 ? (r ? 5 : 4) : (r ? 7 : 6);
            attn_body::attn_unit<0, 8>(bh >> 3, bh & 7, qb, (const attn_body::bf16*)(ws + WS_QA), (const attn_body::bf16*)(ws + WS_KA), (const attn_body::bf16*)(ws + WS_VA), (attn_body::bf16*)(ws + WS_QA), a.rel_bias, (char*)lds + RING_OFF); }
    } SEAM(4);
    if (IN(5)) {
        for (int uix = F.vcu; uix < 512; uix += F.G) { const int r = uix >> 8, w = uix & 255, bh = w >> 2, s = w & 3; const int qb = r ? 7 - s : s;
            attn_body::attn_unit<1, 8>(bh >> 3, bh & 7, qb, (const attn_body::bf16*)(ws + WS_QB), (const attn_body::bf16*)(ws + WS_KB), (const attn_body::bf16*)(ws + WS_VB), (attn_body::bf16*)(ws + WS_QB), ws + WS_SEL, (char*)lds + RING_OFF); }
    } SEAM(5);
    if (IN(6)) {
        { pg8::Gemm g{(const bf16*)(ws + WS_QA), 512}; pg8::DenseOrder S; S.init(T, 1024, 512, ws + WS_WA, F.G, (int)blockIdx.x);
          EpiGate<1> E{(const bf16*)a.out, (float*)(ws + WS_TMP), (bf16*)(ws + WS_MERGED)}; pg8::gemm_phase<EpiGate<1>, pg8::DenseOrder, true>(F.lds + RING_OFF, g, S, E); }
        VM_WAIT(); __syncthreads();
        { pg8::Gemm g{(const bf16*)(ws + WS_QB), 512}; pg8::DenseOrder S; S.init(T, 1024, 512, ws + WS_WB, F.G, (int)blockIdx.x);
          EpiGate<2> E{(const bf16*)a.out, (float*)(ws + WS_TMP), (bf16*)(ws + WS_MERGED)}; pg8::gemm_phase<EpiGate<2>, pg8::DenseOrder, true>(F.lds + RING_OFF, g, S, E); }
    } SEAM(6);
    if (IN(7)) {
        pg8::Gemm g{(const bf16*)(ws + WS_MERGED), 1024}; pg8::DenseOrder S; S.init(T, 1024, 1024, ws + WS_WOUT, F.G, (int)blockIdx.x);
        EpiResid E{a.x, a.out, mod}; pg8::gemm_phase<EpiResid, pg8::DenseOrder, true>(F.lds + RING_OFF, g, S, E);
    } SEAM(7);
    if (IN(8)) { p_ln1_rows(a, F); } SEAM(8);
    if (IN(9)) {
        for (int tb = F.vcu; tb < T / 64; tb += F.G) router_unit(a, F, tb);
        __syncthreads();
        pg8::Gemm g{XN, 1024}; pg8::DenseOrder S; S.init(T, 512, 1024, ws + WS_SHGU, F.G, (int)blockIdx.x);
        EpiSilu E{(bf16*)(ws + WS_HSH)}; pg8::gemm_phase<EpiSilu, pg8::DenseOrder, true>(F.lds + RING_OFF, g, S, E);
    } SEAM(9);
#pragma unroll 1
    for (int ch = 0; ch < NCHUNK; ++ch) {
        const int pgu = 10 + 2 * ch, pd = 11 + 2 * ch;
        if (IN(pgu)) {
            if (ch > 0) { build_xtab(xt, ctl, ch - 1); combine_rows(a, F, ch - 1, xt); __syncthreads(); }
            build_xtab(xt, ctl, ch);
            { pg8::Gemm g{XN, 1024}; ExpertOrder<0> S{xt, 2, F.G, F.vcu, __builtin_amdgcn_readfirstlane(xt[64]), ch, (const unsigned short*)(ws + WS_TAB + TAB_LIST) + (size_t)ch * 64 * 8192, (const char*)(ws + WS_EGU), (size_t)512 * 1024 * 2, (size_t)256 * 1024 * 2};
              EpiExpGU E{(bf16*)(ws + WS_HEXP), xt, (const unsigned short*)(ws + WS_TAB + TAB_LIST) + (size_t)ch * 64 * 8192, (const float*)(ws + WS_TAB + TAB_W), ch};
              pg8::gemm_phase<EpiExpGU, ExpertOrder<0>, true>(F.lds + RING_OFF, g, S, E); }
            if (ch == 0) { VM_WAIT(); __syncthreads();
              pg8::Gemm g{(const bf16*)(ws + WS_HSH), 256}; pg8::DenseOrder S; S.init(T, 1024, 256, ws + WS_SHD, F.G, (int)blockIdx.x);
              EpiShD E{a.out, mod}; pg8::gemm_phase<EpiShD, pg8::DenseOrder, true>(F.lds + RING_OFF, g, S, E); }
        } SEAM(pgu);
        if (IN(pd)) {
            build_xtab(xt, ctl, ch);
            pg8::Gemm g{(const bf16*)(ws + WS_HEXP), 256}; ExpertOrder<1> S{xt, 4, F.G, F.vcu, __builtin_amdgcn_readfirstlane(xt[64]), ch, nullptr, (const char*)(ws + WS_ED), (size_t)1024 * 256 * 2, (size_t)256 * 256 * 2};
            EpiExpD E{(bf16*)(ws + WS_YEXP), xt}; pg8::gemm_phase<EpiExpD, ExpertOrder<1>, true>(F.lds + RING_OFF, g, S, E);
        } SEAM(pd);
    }
    if (IN(14)) { build_xtab(xt, ctl, NCHUNK - 1); combine_rows(a, F, NCHUNK - 1, xt); }
#undef IN
#undef SEAM
}
#if MK_NAIVE_MASK
__device__ __forceinline__ float dot_bf16(const bf16* a, const bf16* b, int K) {
    float s = 0.f;
    for (int k = 0; k < K; k += 8) { const v4u x = *(const v4u*)(a + k), y = *(const v4u*)(b + k);
        s += bflo(x.x) * bflo(y.x) + bfhi(x.x) * bfhi(y.x) + bflo(x.y) * bflo(y.y) + bfhi(x.y) * bfhi(y.y) + bflo(x.z) * bflo(y.z) + bfhi(x.z) * bfhi(y.z) + bflo(x.w) * bflo(y.w) + bfhi(x.w) * bfhi(y.w); }
    return s;
}
__device__ __forceinline__ void st2bf(bf16* p, float a, float b) { *(unsigned*)p = pk2(a, b); }
__global__ void __launch_bounds__(256) nv_inproj(Args a) {
    unsigned char* ws = a.ws; const int row = blockIdx.y, col = 2 * (blockIdx.x * 256 + threadIdx.x); if (col >= DINP) return;
    const bf16* xr = (const bf16*)(ws + WS_XN) + (size_t)row * 1024; const bf16* w = (const bf16*)(ws + WS_WIN) + (size_t)col * 1024;
    float v0 = dot_bf16(xr, w, 1024), v1 = dot_bf16(xr, w + 1024, 1024);
    const float* cosT = (const float*)(ws + WS_ROPE); const float* sinT = cosT + (size_t)T * 8;
    if (col < 3584) { const int seg = col >> 9, cc = col & 511; size_t off; float sc = 1.f; bool rope = false;
        if (seg < 6) { off = seg == 0 ? WS_QA : seg == 1 ? WS_KA : seg == 2 ? WS_VA : seg == 3 ? WS_QB : seg == 4 ? WS_KB : WS_VB; sc = (seg == 0 || seg == 3) ? attn_body::C2 : 1.f; rope = (seg == 3 || seg == 4); }
        else { off = WS_QI; rope = true; }
        const int p = cc & 63;
        if (rope && p < 16) { const float c = cosT[(size_t)row * 8 + (p >> 1)], s = sinT[(size_t)row * 8 + (p >> 1)]; const float o0 = v0 * c - v1 * s, o1 = v1 * c + v0 * s; v0 = o0; v1 = o1; }
        st2bf((bf16*)(ws + off) + (size_t)row * 512 + cc, v0 * sc, v1 * sc);
    } else if (col < 3840) { float* kiw = (float*)(ws + WS_KIW); const int cc = col - 3584; if (cc < 128) { kiw[(size_t)row * 128 + cc] = v0; kiw[(size_t)row * 128 + cc + 1] = v1; } }
    else { st2bf((bf16*)a.out + (size_t)row * 2048 + (col - 3840), sigmoidf_(v0), sigmoidf_(v1)); }
}
__global__ void __launch_bounds__(256) nv_index(Args a) {
    __shared__ float sc[2048]; __shared__ float q[512]; __shared__ float w8[8];
    unsigned char* ws = a.ws; const int t = blockIdx.x, b = t >> 11, tq = t & 2047, L = ((tq >> 6) + 1) * 64, tid = threadIdx.x;
    const bf16* QI = (const bf16*)(ws + WS_QI) + (size_t)t * 512; const bf16* KI = (const bf16*)(ws + WS_KI) + (size_t)b * SEQ * 64; const float* WI = (const float*)(ws + WS_WI) + (size_t)t * 8;
    unsigned long long* SEL = (unsigned long long*)(ws + WS_SEL) + (size_t)t * 32;
    q[tid] = bf2f(QI[tid]); q[tid + 256] = bf2f(QI[tid + 256]); if (tid < 8) w8[tid] = WI[tid];
    __syncthreads();
    for (int s = tid; s < L; s += 256) { const bf16* kr = KI + (size_t)s * 64; float kf[64];
#pragma unroll
        for (int d = 0; d < 64; ++d) kf[d] = bf2f(kr[d]);
        float tot = 0.f;
#pragma unroll
        for (int h = 0; h < 8; ++h) { float dsum = 0.f;
#pragma unroll
            for (int d = 0; d < 64; ++d) dsum += q[h * 64 + d] * kf[d];
            tot += w8[h] * fmaxf(dsum, 0.f); }
        sc[s] = tot; }
    __syncthreads();
    for (int s0 = 0; s0 < 2048; s0 += 256) { const int s = s0 + tid; bool sel = false;
        if (s < L) { if (L <= 256) sel = true; else { const float v = sc[s]; int rank = 0; for (int s2 = 0; s2 < L; ++s2) { const float v2 = sc[s2]; rank += (v2 > v || (v2 == v && s2 < s)) ? 1 : 0; } sel = rank < 256; } }
        const unsigned long long m = __ballot(sel); if ((tid & 63) == 0) SEL[s >> 6] = m; }
}
template <int MODE> __global__ void __launch_bounds__(256) nv_attn(Args a) {
    unsigned char* ws = a.ws; const int gw = blockIdx.x * 4 + (threadIdx.x >> 6), lane = threadIdx.x & 63; const int t = gw >> 3, h = gw & 7, b = t >> 11, tq = t & 2047, c = tq >> 6;
    const bf16* Q = (const bf16*)(ws + (MODE == 0 ? WS_QA : WS_QB)) + (size_t)t * 512 + h * 64;
    const bf16* K = (const bf16*)(ws + (MODE == 0 ? WS_KA : WS_KB)) + (size_t)b * SEQ * 512 + h * 64; const bf16* V = (const bf16*)(ws + (MODE == 0 ? WS_VA : WS_VB)) + (size_t)b * SEQ * 512 + h * 64;
    bf16* O = (bf16*)(ws + WS_NVO) + (size_t)(MODE == 0 ? 0 : (size_t)T * 512) + (size_t)t * 512 + h * 64;
    const unsigned long long* SEL = (const unsigned long long*)(ws + WS_SEL) + (size_t)t * 32;
    float qf[64];
#pragma unroll
    for (int d = 0; d < 64; ++d) qf[d] = bf2f(Q[d]);
    float m = -INFINITY, l = 0.f, o = 0.f;
    const int j0 = (MODE == 0) ? (c - 8 > 0 ? c - 8 : 0) : 0;
    for (int j = j0; j <= c; ++j) { const int s = 64 * j + lane; const bf16* kr = K + (size_t)s * 512; float sc = 0.f;
#pragma unroll
        for (int d = 0; d < 64; ++d) sc += qf[d] * bf2f(kr[d]);
        bool ok = true;
        if (MODE == 0) { int rel = tq - s; rel = rel > 128 ? 128 : (rel < -128 ? -128 : rel); sc += a.rel_bias[h * 257 + rel + 128] * LOG2E; }
        else ok = (SEL[j] >> lane) & 1ull;
        if (!ok) sc = -INFINITY;
        float tm = sc;
#pragma unroll
        for (int x = 1; x < 64; x <<= 1) tm = fmaxf(tm, __shfl_xor(tm, x));
        if (tm == -INFINITY) continue;
        const float mn = fmaxf(m, tm), f = exp2f(m - mn), p = exp2f(sc - mn);
        l = l * f + wave_sum(p); o *= f;
        for (int k2 = 0; k2 < 64; ++k2) { const float pk = __shfl(p, k2); o += pk * bf2f(V[(size_t)(64 * j + k2) * 512 + lane]); }
        m = mn; }
    O[lane] = (bf16)f2bf(o / l);
}
__global__ void __launch_bounds__(256) nv_copy_o(Args a, int which) {
    unsigned char* ws = a.ws; const size_t i = (size_t)blockIdx.x * 256 + threadIdx.x; const v4u* src = (const v4u*)(ws + WS_NVO);
    if (i < (size_t)T * 512 * 2 / 16) { if (which == 0) ((v4u*)(ws + WS_QA))[i] = src[i]; else ((v4u*)(ws + WS_QB))[i] = src[i + (size_t)T * 512 * 2 / 16]; }
}
__global__ void __launch_bounds__(256) nv_merge(Args a) {
    unsigned char* ws = a.ws; const int row = blockIdx.y, col = 2 * (blockIdx.x * 256 + threadIdx.x);
    const bf16* oa = (const bf16*)(ws + WS_QA) + (size_t)row * 512; const bf16* ob = (const bf16*)(ws + WS_QB) + (size_t)row * 512;
    const bf16* wa = (const bf16*)(ws + WS_WA) + (size_t)col * 512; const bf16* wb = (const bf16*)(ws + WS_WB) + (size_t)col * 512; const bf16* g = (const bf16*)a.out + (size_t)row * 2048;
    const float m0 = bf2f(g[col]) * dot_bf16(oa, wa, 512) + bf2f(g[1024 + col]) * dot_bf16(ob, wb, 512), m1 = bf2f(g[col + 1]) * dot_bf16(oa, wa + 512, 512) + bf2f(g[1024 + col + 1]) * dot_bf16(ob, wb + 512, 512);
    st2bf((bf16*)(ws + WS_MERGED) + (size_t)row * 1024 + col, m0, m1);
}
__global__ void __launch_bounds__(256) nv_outproj(Args a) {
    unsigned char* ws = a.ws; const int row = blockIdx.y, col = 2 * (blockIdx.x * 256 + threadIdx.x);
    const bf16* mr = (const bf16*)(ws + WS_MERGED) + (size_t)row * 1024; const bf16* w = (const bf16*)(ws + WS_WOUT) + (size_t)col * 1024; float* tmp = (float*)(ws + WS_TMP) + (size_t)row * 1024;
    tmp[col] = dot_bf16(mr, w, 1024); tmp[col + 1] = dot_bf16(mr, w + 1024, 1024);
}
__global__ void __launch_bounds__(256) nv_ln1(Args a) {
    unsigned char* ws = a.ws; const int m = blockIdx.x * 4 + (threadIdx.x >> 6), lane = threadIdx.x & 63; const float* mb = (const float*)(ws + WS_MOD) + (size_t)(m >> 11) * 6144;
    const f32x4* xr = (const f32x4*)(a.x + (size_t)m * D) + lane; const f32x4* tr = (const f32x4*)((const float*)(ws + WS_TMP) + (size_t)m * D) + lane; f32x4 v[4];
#pragma unroll
    for (int j = 0; j < 4; ++j) { const f32x4 g1 = *(const f32x4*)(mb + 2048 + 4 * lane + 256 * j); v[j] = xr[64 * j] * DN_ALPHA + g1 * tr[64 * j]; }
    float mean, rstd; ln_stats(v, mean, rstd);
#pragma unroll
    for (int j = 0; j < 4; ++j) { const f32x4 lg = *(const f32x4*)(a.ln1_g + 4 * lane + 256 * j), lb = *(const f32x4*)(a.ln1_b + 4 * lane + 256 * j); v[j] = (v[j] - mean) * rstd * lg + lb; ((f32x4*)(a.out + (size_t)m * D) + lane)[64 * j] = v[j]; }
    ln_stats(v, mean, rstd); if (lane == 0) { float* st = (float*)(ws + WS_STATS) + (size_t)m * 2; st[0] = mean; st[1] = rstd; }
    unsigned long long* o8 = (unsigned long long*)((bf16*)(ws + WS_XN) + (size_t)m * D) + lane;
#pragma unroll
    for (int j = 0; j < 4; ++j) { const f32x4 sc = *(const f32x4*)(mb + 4096 + 4 * lane + 256 * j), sh = *(const f32x4*)(mb + 3072 + 4 * lane + 256 * j); const f32x4 u = (v[j] - mean) * rstd * (sc + 1.0f) + sh;
        o8[64 * j] = (unsigned long long)pk2(u.x, u.y) | ((unsigned long long)pk2(u.z, u.w) << 32); }
}
__global__ void __launch_bounds__(256) nv_shgu(Args a) {
    unsigned char* ws = a.ws; const int row = blockIdx.y, j = threadIdx.x; const bf16* xr = (const bf16*)(ws + WS_XN) + (size_t)row * 1024; const bf16* w = (const bf16*)(ws + WS_SHGU) + (size_t)(2 * j) * 1024;
    ((bf16*)(ws + WS_HSH))[(size_t)row * 256 + j] = (bf16)f2bf(silu_mul(dot_bf16(xr, w, 1024), dot_bf16(xr, w + 1024, 1024)));
}
__global__ void __launch_bounds__(256) nv_expgu(Args a) {
    unsigned char* ws = a.ws; const int rs = blockIdx.x, t = rs >> 3, j = threadIdx.x; const unsigned er = ((const unsigned*)(ws + WS_TAB + TAB_ER))[rs]; const int e = er >> 16; const float wgt = ((const float*)(ws + WS_TAB + TAB_W))[rs];
    const bf16* xr = (const bf16*)(ws + WS_XN) + (size_t)t * 1024; const bf16* w = (const bf16*)(ws + WS_EGU) + ((size_t)e * 512 + 2 * j) * 1024;
    ((bf16*)(ws + WS_YEXP))[(size_t)rs * 256 + j] = (bf16)f2bf(wgt * silu_mul(dot_bf16(xr, w, 1024), dot_bf16(xr, w + 1024, 1024)));
}
__global__ void __launch_bounds__(256) nv_down(Args a) {
    unsigned char* ws = a.ws; const int t = blockIdx.y, col = blockIdx.x * 256 + threadIdx.x; const float* mb = (const float*)(ws + WS_MOD) + (size_t)(t >> 11) * 6144;
    float y = dot_bf16((const bf16*)(ws + WS_HSH) + (size_t)t * 256, (const bf16*)(ws + WS_SHD) + (size_t)col * 256, 256);
    for (int s = 0; s < 8; ++s) { const int e = ((const unsigned*)(ws + WS_TAB + TAB_ER))[t * 8 + s] >> 16;
        y += dot_bf16((const bf16*)(ws + WS_YEXP) + (size_t)(t * 8 + s) * 256, (const bf16*)(ws + WS_ED) + ((size_t)e * 1024 + col) * 256, 256); }
    float* z = a.out + (size_t)t * 1024 + col; *z = *z * DN_ALPHA + mb[5120 + col] * y;
}
__global__ void __launch_bounds__(256) nv_ln2(Args a) {
    const int m = blockIdx.x * 4 + (threadIdx.x >> 6), lane = threadIdx.x & 63; f32x4* zr = (f32x4*)(a.out + (size_t)m * D) + lane; f32x4 v[4];
#pragma unroll
    for (int j = 0; j < 4; ++j) v[j] = zr[64 * j];
    float mean, rstd; ln_stats(v, mean, rstd);
#pragma unroll
    for (int j = 0; j < 4; ++j) { const f32x4 lg = *(const f32x4*)(a.ln2_g + 4 * lane + 256 * j), lb = *(const f32x4*)(a.ln2_b + 4 * lane + 256 * j); zr[64 * j] = (v[j] - mean) * rstd * lg + lb; }
}
#endif
extern "C" void kernel_launch(void* const* d_in, const int* in_sizes, int n_in, void* d_out, int out_size, void* d_ws, size_t ws_size, hipStream_t stream) {
    static int grid = 0;
    if (grid == 0) {
        if (n_in != 24 || in_sizes[0] != T * D || out_size != T * D || ws_size < WS_END) { fprintf(stderr, "kernel_launch: unexpected shapes (n_in %d, in0 %d, out %d, ws %zu, need %zu); nothing launched\n", n_in, n_in > 0 ? in_sizes[0] : -1, out_size, ws_size, (size_t)WS_END); grid = -1; return; }
        int dev = 0, cus = 0, per_cu = 0;
        if (hipGetDevice(&dev) != hipSuccess || hipDeviceGetAttribute(&cus, hipDeviceAttributeMultiprocessorCount, dev) != hipSuccess) { grid = -1; return; }
        if (hipFuncSetAttribute((const void*)mk_fwd, hipFuncAttributeMaxDynamicSharedMemorySize, LDS_BYTES) != hipSuccess) { fprintf(stderr, "kernel_launch: hipFuncSetAttribute failed\n"); grid = -1; return; }
        if (hipOccupancyMaxActiveBlocksPerMultiprocessor(&per_cu, (const void*)mk_fwd, NWAVES * 64, LDS_BYTES) != hipSuccess || per_cu < 1) { fprintf(stderr, "kernel_launch: occupancy query reports %d\n", per_cu); per_cu = 1; }
        (void)hipGetLastError();
        grid = cus * 1;
        if (grid != 256) fprintf(stderr, "kernel_launch: %d CUs; this kernel is built for 256\n", grid);
    }
    if (grid < 0) return;
    (void)hipMemsetAsync((char*)d_ws + WS_CTL, 0, CTL_ZERO_BYTES, stream);
    Args a{};
    a.x = (const float*)d_in[0]; a.c = (const float*)d_in[1]; a.positions = (const int*)d_in[2]; a.w_ada = (const float*)d_in[3]; a.b_ada = (const float*)d_in[4]; a.w_in = (const float*)d_in[5];
    a.rel_bias = (const float*)d_in[6]; a.ikn_g = (const float*)d_in[7]; a.ikn_b = (const float*)d_in[8]; a.w_branch_a = (const float*)d_in[9]; a.w_branch_b = (const float*)d_in[10]; a.w_out = (const float*)d_in[11];
    a.ln1_g = (const float*)d_in[12]; a.ln1_b = (const float*)d_in[13]; a.w_router = (const float*)d_in[14]; a.router_bias = (const float*)d_in[15]; a.w_exp_gate = (const float*)d_in[16]; a.w_exp_up = (const float*)d_in[17];
    a.w_exp_down = (const float*)d_in[18]; a.w_sh_gate = (const float*)d_in[19]; a.w_sh_up = (const float*)d_in[20]; a.w_sh_down = (const float*)d_in[21]; a.ln2_g = (const float*)d_in[22]; a.ln2_b = (const float*)d_in[23];
    a.out = (float*)d_out; a.ws = (unsigned char*)d_ws;
    for (int j = 0; j < 8; ++j) { const float inv = (float)std::pow(500000.0, -(double)(2 * j) / 16.0); a.inv_freq_rev[j] = (double)inv / 6.283185307179586476925286766559; }
    auto run = [&](int lo, int hi, int flags) { a.ph_lo = lo; a.ph_hi = hi; a.li = 0; a.flags = flags; hipLaunchKernelGGL(mk_fwd, dim3(grid), dim3(NWAVES * 64), LDS_BYTES, stream, a); };
#if MK_NAIVE_MASK == 0 && MK_N_LAUNCHES == 1
    run(0, NPHASE, 0);
#elif MK_NAIVE_MASK == 0
    for (int k = 0; k < NPHASE; ++k) run(k, k + 1, 0);
#else
    constexpr int mask = MK_NAIVE_MASK;
    a.flags = 0;
    run(0, 1, 0); run(1, 2, 0);
    if (mask & 1) hipLaunchKernelGGL(nv_inproj, dim3(12, T), dim3(256), 0, stream, a); else run(2, 3, 0);
    run(3, 4, 0);
    run(4, 5, ((mask & 2) ? 1 : 0) | ((mask & 4) ? 2 : 0));
    if (mask & 2) hipLaunchKernelGGL(nv_index, dim3(T), dim3(256), 0, stream, a);
    if (mask & 4) { hipLaunchKernelGGL(nv_attn<0>, dim3(T * 8 / 4), dim3(256), 0, stream, a); hipLaunchKernelGGL(nv_copy_o, dim3(T * 512 * 2 / 16 / 256), dim3(256), 0, stream, a, 0); }
    if (mask & 8) { hipLaunchKernelGGL(nv_attn<1>, dim3(T * 8 / 4), dim3(256), 0, stream, a); hipLaunchKernelGGL(nv_copy_o, dim3(T * 512 * 2 / 16 / 256), dim3(256), 0, stream, a, 1); } else run(5, 6, 0);
    if (mask & 16) hipLaunchKernelGGL(nv_merge, dim3(2, T), dim3(256), 0, stream, a); else run(6, 7, 0);
    if (mask & 32) { hipLaunchKernelGGL(nv_outproj, dim3(2, T), dim3(256), 0, stream, a); hipLaunchKernelGGL(nv_ln1, dim3(T / 4), dim3(256), 0, stream, a); } else { run(7, 8, 0); run(8, 9, 0); }
    run(9, 10, 0);
    if (mask & 64) hipLaunchKernelGGL(nv_shgu, dim3(1, T), dim3(256), 0, stream, a);
    if (mask & 128) { hipLaunchKernelGGL(nv_expgu, dim3(T * 8), dim3(256), 0, stream, a); hipLaunchKernelGGL(nv_down, dim3(4, T), dim3(256), 0, stream, a); hipLaunchKernelGGL(nv_ln2, dim3(T / 4), dim3(256), 0, stream, a); }
    else { for (int k = 10; k < NPHASE; ++k) run(k, k + 1, 0); }
#endif
}
```

```cpp
#include <hip/hip_runtime.h>
#include <hip/hip_bf16.h>
#include <cstdio>
#include <cstdint>
#include <cmath>
#ifndef MK_NAIVE_MASK
#define MK_NAIVE_MASK 0
#endif
namespace pg8 {
#define PG8_LAS __attribute__((address_space(3)))
typedef unsigned short bf16_t;
typedef short bf16x8 __attribute__((ext_vector_type(8)));
typedef float f32x4 __attribute__((ext_vector_type(4)));
typedef float f32x2 __attribute__((ext_vector_type(2)));
typedef unsigned u32x4 __attribute__((ext_vector_type(4)));
typedef unsigned u32x2 __attribute__((ext_vector_type(2)));
constexpr int BM = 256, BK = 64, HALF = 128, HTB = HALF * BK * 2  , STAGE_BYTES = 8 * HTB, NXCD = 8, WGM = 8;

__host__ __device__ __forceinline__ int lds_byte(int r, int c) { const int st = (r >> 4) * 2 + (c >> 5), rr = r & 15, cc = c & 31, ob = rr * 64 + cc * 2; return st * 1024 + (ob ^ (((ob >> 9) & 1) << 5)); }
__host__ __device__ __forceinline__ void stage_rc(int b, int& R, int& C) { const int st = b / 1024, sb = b % 1024, swz = sb ^ (((sb >> 9) & 1) << 5); R = (st >> 1) * 16 + swz / 64; C = (st & 1) * 32 + (swz % 64) / 2; }
__host__ __device__ __forceinline__ int perm32(int rho) { const int n = rho >> 4, i = rho & 15; return 8 * (i >> 2) + 4 * n + (i & 3); }

struct Unit { int pm, pn, e, nrows; };

struct DenseOrder {
    int nM, nN, nwg, G, c; unsigned arow; const char* Bt; size_t btile;
    __device__ void init(int M, int N, int K, const void* Bt_, int G_, int c_) { nM = M / BM; nN = N / BM; nwg = nM * nN; G = G_; c = c_; arow = (unsigned)K * 2u; Bt = (const char*)Bt_; btile = (size_t)BM * K * 2; }
    __device__ __forceinline__ bool next(int i, Unit& u) const {
        const long L = (long)i * G + c; if (L >= nwg) return false;
        int wgid = (int)L; { const int q = nwg / NXCD, r = nwg % NXCD, xcd = wgid % NXCD, off = wgid / NXCD; wgid = (xcd < r ? xcd * (q + 1) : r * (q + 1) + (xcd - r) * q) + off; }
        const int nig = WGM * nN, gid = wgid / nig, fm = gid * WGM, gsz = (nM - fm) < WGM ? (nM - fm) : WGM;
        u.pm = fm + ((wgid % nig) % gsz); u.pn = (wgid % nig) / gsz; u.e = 0; u.nrows = 256; return true;
    }
    __device__ __forceinline__ unsigned a_off(const Unit& u, int row) const { return (unsigned)(u.pm * BM + row) * arow; }
    __device__ __forceinline__ const char* b_ptr(const Unit& u) const { return Bt + (size_t)u.pn * btile; }
};

__device__ __forceinline__ unsigned cvt_pk_bf16(float lo, float hi) { unsigned r; asm volatile("v_cvt_pk_bf16_f32 %0, %1, %2" : "=v"(r) : "v"(lo), "v"(hi)); return r; }

struct PanelStats {
    unsigned* xbuf;
    unsigned* cnt;
    unsigned* tmo;
    int ntn; float eps;
    unsigned code;
    __device__ __forceinline__ bool run(const f32x4 (&v)[2][2][4][2], const Unit& u, int wr, int wc, int fr, int fq, PG8_LAS unsigned char* lds, int wid, int lane) const {
        typedef float f32x2v __attribute__((ext_vector_type(2)));
        PG8_LAS f32x2v* P = (PG8_LAS f32x2v*)lds;
        PG8_LAS f32x2v* S = (PG8_LAS f32x2v*)(lds + 8192);
        PG8_LAS unsigned* flag = (PG8_LAS unsigned*)(lds + 8192 + 2048);
#pragma unroll
        for (int ai = 0; ai < 2; ++ai)
#pragma unroll
            for (int m = 0; m < 4; ++m) {
                float s = 0.f;
#pragma unroll
                for (int bj = 0; bj < 2; ++bj)
#pragma unroll
                    for (int n = 0; n < 2; ++n) { const f32x4 x = v[ai][bj][m][n]; s += (x[0] + x[1]) + (x[2] + x[3]); }
                s += __shfl_xor(s, 16); s += __shfl_xor(s, 32);
                const float mw = s * (1.0f / 64.0f); float q = 0.f;
#pragma unroll
                for (int bj = 0; bj < 2; ++bj)
#pragma unroll
                    for (int n = 0; n < 2; ++n) { const f32x4 d = v[ai][bj][m][n] - mw; q += (d[0] * d[0] + d[1] * d[1]) + (d[2] * d[2] + d[3] * d[3]); }
                q += __shfl_xor(q, 16); q += __shfl_xor(q, 32);
                if (fq == 0) P[(ai * HALF + wr * 64 + m * 16 + fr) * 4 + wc] = (f32x2v){mw, q};
            }
        asm volatile("s_waitcnt lgkmcnt(0)" ::: "memory"); __builtin_amdgcn_s_barrier(); asm volatile("" ::: "memory");
        const int row = wid * 32 + (lane & 31);
        if (lane < 32) {
            const f32x2v a = P[row * 4 + 0], b = P[row * 4 + 1], c = P[row * 4 + 2], d = P[row * 4 + 3];
            const float mt = (a.x + b.x + c.x + d.x) * 0.25f;
            const float da = a.x - mt, db = b.x - mt, dc = c.x - mt, dd = d.x - mt;
            const float m2 = (a.y + b.y) + (c.y + d.y) + 64.0f * ((da * da + db * db) + (dc * dc + dd * dd));
            unsigned long long* slot = (unsigned long long*)xbuf + ((size_t)(u.pm * BM + row) * 4 + u.pn);
            __hip_atomic_store(slot, ((unsigned long long)__float_as_uint(m2) << 32) | __float_as_uint(mt), __ATOMIC_RELAXED, __HIP_MEMORY_SCOPE_AGENT);
        }
        asm volatile("s_waitcnt vmcnt(0)" ::: "memory");
        if (lane == 0) __hip_atomic_fetch_add(cnt + 64 * u.pm, 1u, __ATOMIC_RELAXED, __HIP_MEMORY_SCOPE_AGENT);
        if (wid == 0) {
            bool dead = false; const unsigned long long t0 = __builtin_amdgcn_s_memrealtime(); const unsigned want = 8u * (unsigned)ntn;
            for (;;) {
                if ((unsigned)__builtin_amdgcn_readfirstlane(__hip_atomic_load(cnt + 64 * u.pm, __ATOMIC_RELAXED, __HIP_MEMORY_SCOPE_AGENT)) >= want) break;
                if (__builtin_amdgcn_s_memrealtime() - t0 > 2000000ull) {
                    if (lane == 0) { unsigned expect = 0u; __hip_atomic_compare_exchange_strong(tmo + 1, &expect, code | (unsigned)(u.pm & 0xff), __ATOMIC_RELAXED, __ATOMIC_RELAXED, __HIP_MEMORY_SCOPE_AGENT);
                                     __hip_atomic_store(tmo, 1u, __ATOMIC_RELAXED, __HIP_MEMORY_SCOPE_AGENT); }
                    dead = true; break; }
                __builtin_amdgcn_s_sleep(2);
            }
            __builtin_amdgcn_fence(__ATOMIC_ACQUIRE, "agent");
            if (lane == 0) flag[0] = dead ? 1u : 0u;
        }
        asm volatile("s_waitcnt vmcnt(0) lgkmcnt(0)" ::: "memory"); __builtin_amdgcn_s_barrier(); asm volatile("" ::: "memory");
        const bool bad = flag[0] != 0u;
        if (lane < 32) {
            const unsigned long long* slot = (const unsigned long long*)xbuf + (size_t)(u.pm * BM + row) * 4; float mt[4], m2[4]; float ms = 0.f;
#pragma unroll
            for (int t = 0; t < 4; ++t) { if (t < ntn) { const unsigned long long w = __hip_atomic_load(slot + t, __ATOMIC_RELAXED, __HIP_MEMORY_SCOPE_AGENT); mt[t] = __uint_as_float((unsigned)w); m2[t] = __uint_as_float((unsigned)(w >> 32)); } else { mt[t] = 0.f; m2[t] = 0.f; } ms += mt[t]; }
            const float mean = ms / (float)ntn; float q = 0.f;
#pragma unroll
            for (int t = 0; t < 4; ++t) if (t < ntn) { const float dm = mt[t] - mean; q += m2[t] + 256.0f * dm * dm; }
            S[row] = (f32x2v){mean, 1.0f / sqrtf(q / (256.0f * (float)ntn) + eps)};
        }
        asm volatile("s_waitcnt lgkmcnt(0)" ::: "memory"); __builtin_amdgcn_s_barrier(); asm volatile("" ::: "memory");
        return bad;
    }
};

struct Gemm { const bf16_t* A; int K; };

template <class Epi, class Sched, bool ALIGN_EPI = false>
__device__ __forceinline__ void gemm_phase(PG8_LAS unsigned char* lds, const Gemm g, const Sched& S, const Epi& E) {
    int tid_ = threadIdx.x; asm volatile("" : "+v"(tid_));
    const int tid = tid_, wid = __builtin_amdgcn_readfirstlane(tid >> 6), lane = tid & 63, wr = wid >> 2, wc = wid & 3, fr = lane & 15, fq = lane >> 4;
    const int K = g.K, nt = K / BK;
    int RA[2], CA2[2]; unsigned voffB[2];
#pragma unroll
    for (int i = 0; i < 2; ++i) { int R, C; stage_rc(tid * 16 + i * 8192, R, C); const int Rb = Epi::PERM ? ((R & ~31) + perm32(R & 31)) : R;
        RA[i] = R; CA2[i] = C * 2; voffB[i] = (unsigned)(Rb * K + C) * 2u; }
    const size_t kstep = (size_t)(BK * 2);
    const size_t hstep = (size_t)HALF * K * 2;
    const unsigned ldsw = (unsigned)wid * 1024u;
    const int aoff = lds_byte(wr * 64 + fr, fq * 8), boff = lds_byte(wc * 32 + fr, fq * 8);
    const char* Abase = (const char*)g.A;
#define PG8_SA(b, h) (((b) * 2 + (h)) * HTB)
#define PG8_SB(b, h) ((4 + (b) * 2 + (h)) * HTB)
#define PG8_STAGE(bufoff, gbase, voff) do { _Pragma("unroll") for (int _i = 0; _i < 2; ++_i) \
        __builtin_amdgcn_global_load_lds((const unsigned*)((const char*)(gbase) + (voff)[_i]), (PG8_LAS unsigned*)(lds + (bufoff) + ldsw + _i * 8192), 16, 0, 0); } while (0)
#define PG8_STAGEA(bufoff, offs, koff) do { _Pragma("unroll") for (int _i = 0; _i < 2; ++_i) \
        __builtin_amdgcn_global_load_lds((const unsigned*)((Abase + (size_t)(koff)) + (size_t)(offs)[_i]), (PG8_LAS unsigned*)(lds + (bufoff) + ldsw + _i * 8192), 16, 0, 0); } while (0)
#define PG8_LDA(dst, b, h) do { _Pragma("unroll") for (int m = 0; m < 4; ++m) _Pragma("unroll") for (int k = 0; k < 2; ++k) dst[m][k] = *(const PG8_LAS bf16x8*)(lds + PG8_SA(b, h) + aoff + m * 2048 + k * 1024); } while (0)
#define PG8_LDB(dst, b, h) do { _Pragma("unroll") for (int n = 0; n < 2; ++n) _Pragma("unroll") for (int k = 0; k < 2; ++k) dst[n][k] = *(const PG8_LAS bf16x8*)(lds + PG8_SB(b, h) + boff + n * 2048 + k * 1024); } while (0)
#define PG8_MMA(ai, bj, At, Bt) do { __builtin_amdgcn_s_setprio(1); _Pragma("unroll") for (int m = 0; m < 4; ++m) _Pragma("unroll") for (int n = 0; n < 2; ++n) _Pragma("unroll") for (int k = 0; k < 2; ++k) \
        acc[ai][bj][m][n] = __builtin_amdgcn_mfma_f32_16x16x32_bf16(Bt[n][k], At[m][k], acc[ai][bj][m][n], 0, 0, 0); __builtin_amdgcn_s_setprio(0); } while (0)
#define PG8_WAIT_V(n) asm volatile("s_waitcnt vmcnt(" #n ")" ::: "memory")
#define PG8_WAIT_L(n) asm volatile("s_waitcnt lgkmcnt(" #n ")" ::: "memory")
#define PG8_BAR __builtin_amdgcn_s_barrier()
#define PG8_SCHED __builtin_amdgcn_sched_barrier(0)
    Unit cur, nxt; int ui = 0;
    if (!S.next(0, cur)) return;
    f32x4 acc[2][2][4][2];
#pragma unroll
    for (int a = 0; a < 2; ++a)
#pragma unroll
        for (int b = 0; b < 2; ++b)
#pragma unroll
            for (int m = 0; m < 4; ++m)
#pragma unroll
                for (int n = 0; n < 2; ++n) acc[a][b][m][n] = (f32x4){0.f, 0.f, 0.f, 0.f};
    bf16x8 At[4][2], B0[2][2], B1[2][2];
    unsigned ca0[2], ca1[2], na0[2], na1[2];
#pragma unroll
    for (int i = 0; i < 2; ++i) { ca0[i] = S.a_off(cur, RA[i]) + (unsigned)CA2[i]; ca1[i] = S.a_off(cur, HALF + RA[i]) + (unsigned)CA2[i]; }
    const char* cB = S.b_ptr(cur);
    {
        PG8_STAGE(PG8_SB(0, 0), cB, voffB); PG8_STAGE(PG8_SB(0, 1), cB + hstep, voffB); PG8_STAGEA(PG8_SA(0, 0), ca0, 0); PG8_STAGEA(PG8_SA(0, 1), ca1, 0);
        if (wr == 1) PG8_BAR;
        PG8_WAIT_V(2); PG8_BAR;
        PG8_STAGE(PG8_SB(1, 0), cB + kstep, voffB); PG8_STAGEA(PG8_SA(1, 0), ca0, kstep); PG8_STAGE(PG8_SB(1, 1), cB + hstep + kstep, voffB);
        PG8_WAIT_V(6); PG8_BAR;
    }
    for (;;) {
        const bool has_next = S.next(ui + 1, nxt);
        const char* nB = cB;
#pragma unroll
        for (int i = 0; i < 2; ++i) { na0[i] = ca0[i]; na1[i] = ca1[i]; }
        if (has_next) { nB = S.b_ptr(nxt);
#pragma unroll
            for (int i = 0; i < 2; ++i) { int R, C; stage_rc(tid * 16 + i * 8192, R, C); na0[i] = S.a_off(nxt, R) + (unsigned)(C * 2); na1[i] = S.a_off(nxt, HALF + R) + (unsigned)(C * 2); } }
#pragma unroll 1
        for (int t = 0; t < nt; t += 2) {
            const bool last = (t == nt - 2);
            const size_t k1 = (size_t)(t + 1) * kstep;
            const size_t k2 = last ? (size_t)0 : (size_t)(t + 2) * kstep, k3 = k2 + kstep;
            const char* b2 = (last ? nB : cB) + k2; const char* b3 = b2 + kstep;
            PG8_LDB(B0, 0, 0); PG8_LDB(B1, 0, 1); PG8_SCHED; PG8_LDA(At, 0, 0); PG8_STAGEA(PG8_SA(1, 1), ca1, k1);
            if (last) {
#pragma unroll
                for (int i = 0; i < 2; ++i) { ca0[i] = na0[i]; ca1[i] = na1[i]; } }
            PG8_WAIT_V(8); PG8_WAIT_L(0); PG8_BAR; PG8_MMA(0, 0, At, B0); PG8_MMA(0, 1, At, B1); PG8_BAR; PG8_SCHED;
            PG8_LDA(At, 0, 1); PG8_STAGE(PG8_SB(0, 0), b2, voffB); PG8_STAGE(PG8_SB(0, 1), b2 + hstep, voffB); PG8_STAGEA(PG8_SA(0, 0), ca0, k2);
            PG8_WAIT_V(8); PG8_WAIT_L(0); PG8_BAR; PG8_MMA(1, 0, At, B0); PG8_MMA(1, 1, At, B1); PG8_BAR; PG8_SCHED;
            PG8_LDB(B0, 1, 0); PG8_LDB(B1, 1, 1); PG8_SCHED; PG8_LDA(At, 1, 0); PG8_STAGEA(PG8_SA(0, 1), ca1, k2);
            PG8_WAIT_V(8); PG8_WAIT_L(0); PG8_BAR; PG8_MMA(0, 0, At, B0); PG8_MMA(0, 1, At, B1); PG8_BAR; PG8_SCHED;
            PG8_LDA(At, 1, 1); PG8_STAGE(PG8_SB(1, 0), b3, voffB); PG8_STAGE(PG8_SB(1, 1), b3 + hstep, voffB); PG8_STAGEA(PG8_SA(1, 0), ca0, k3);
            PG8_WAIT_V(8); PG8_WAIT_L(0); PG8_BAR; PG8_MMA(1, 0, At, B0); PG8_MMA(1, 1, At, B1); PG8_BAR; PG8_SCHED;
        }
        if constexpr (ALIGN_EPI) { if (wr == 0) PG8_BAR; }
        if constexpr (!Epi::AFTER_DRAIN) { E(acc, cur, wr, wc, fr, fq); }
        if (!has_next) break;
#pragma unroll
        for (int a = 0; a < 2; ++a)
#pragma unroll
            for (int b = 0; b < 2; ++b)
#pragma unroll
                for (int m = 0; m < 4; ++m)
#pragma unroll
                    for (int n = 0; n < 2; ++n) acc[a][b][m][n] = (f32x4){0.f, 0.f, 0.f, 0.f};
        cur = nxt; cB = nB; ++ui;
        if constexpr (ALIGN_EPI) { if (wr == 1) PG8_BAR; }
    }
    PG8_WAIT_V(0);
    if constexpr (!ALIGN_EPI) { if (wr == 0) PG8_BAR; }
    PG8_BAR;
    if constexpr (Epi::AFTER_DRAIN) { E.fused(acc, cur, wr, wc, fr, fq, lds, wid, lane); }
#undef PG8_SA
#undef PG8_SB
#undef PG8_STAGE
#undef PG8_STAGEA
#undef PG8_LDA
#undef PG8_LDB
#undef PG8_MMA
#undef PG8_WAIT_V
#undef PG8_WAIT_L
#undef PG8_BAR
#undef PG8_SCHED
}
}
namespace attn_body {
using bf16=__hip_bfloat16;
using bf16x8=__attribute__((ext_vector_type(8)))short;
using s16x4=__attribute__((ext_vector_type(4)))short;
using f32x16=__attribute__((ext_vector_type(16)))float;
using u32x4=__attribute__((ext_vector_type(4)))unsigned;
using u32x2=__attribute__((ext_vector_type(2)))unsigned;
constexpr int SEQ=2048,D=64,DM=512;
constexpr int NW=8,QBLK=32,QB=QBLK*NW,KVBLK=64;
__device__ __forceinline__ int crow(int r,int hi){return (r&3)+8*(r>>2)+4*hi;}
#define SBAR() __builtin_amdgcn_sched_barrier(0)
constexpr float NEGB=-1000.0f;
constexpr int NSLOT=3, SLOTB=8192;
constexpr int LDS_K=0, LDS_V=NSLOT*SLOTB, LDS_WS=2*NSLOT*SLOTB, LDS_BIAS=LDS_WS+NW*64*4, LDS_X=LDS_BIAS+2048, LDS_OST=LDS_X, LDS_BYTES=LDS_X+65536;
constexpr float C2=0.125f*1.4426950408889634f;
__device__ __forceinline__ void glds16(const void*gsrc,unsigned lds_dst){unsigned keep;
  asm volatile("s_mov_b32 %0, m0\n\ts_mov_b32 m0, %2\n\ts_nop 0\n\tglobal_load_lds_dwordx4 %1, off\n\ts_mov_b32 m0, %0":"=&s"(keep):"v"(gsrc),"s"(lds_dst):"memory");}
__device__ __forceinline__ float max3f(float a,float b,float c){float r;asm("v_max3_f32 %0, %1, %2, %3":"=v"(r):"v"(a),"v"(b),"v"(c));return r;}
__device__ __forceinline__ float max2f(float a,float b){float r;asm("v_max_f32_e32 %0, %1, %2":"=v"(r):"v"(a),"v"(b));return r;}
__device__ __forceinline__ float fadd_s(float a,float b){float r;asm("v_add_f32_e32 %0, %1, %2":"=v"(r):"v"(a),"v"(b));return r;}
__device__ __forceinline__ float fsub_s(float a,float b){float r;asm("v_sub_f32_e32 %0, %1, %2":"=v"(r):"v"(a),"v"(b));return r;}
typedef float f32x2_t __attribute__((ext_vector_type(2))); typedef __bf16 bf16x2_t __attribute__((ext_vector_type(2)));
__device__ __forceinline__ unsigned cvtpk_s(float lo,float hi){f32x2_t v={lo,hi};bf16x2_t b=__builtin_convertvector(v,bf16x2_t);return __builtin_bit_cast(unsigned,b);}
#define WAIT_BAR(N) asm volatile("s_waitcnt vmcnt(" #N ") lgkmcnt(0)\n\ts_barrier":::"memory")

__device__ __forceinline__ void qkt(f32x16&p0,f32x16&p1,const char*Kslot,const bf16x8*qr,const f32x16&negm,int r32,int hi){
  const char*kb=Kslot+hi*1024+r32*16;
  #pragma unroll
  for(int d0=0;d0<4;++d0){
    const bf16x8 b0=*reinterpret_cast<const bf16x8*>(kb+d0*2048);
    const bf16x8 b1=*reinterpret_cast<const bf16x8*>(kb+d0*2048+512);
    if(d0==0){p0=__builtin_amdgcn_mfma_f32_32x32x16_bf16(b0,qr[0],negm,0,0,0);p1=__builtin_amdgcn_mfma_f32_32x32x16_bf16(b1,qr[0],negm,0,0,0);}
    else{p0=__builtin_amdgcn_mfma_f32_32x32x16_bf16(b0,qr[d0],p0,0,0,0);p1=__builtin_amdgcn_mfma_f32_32x32x16_bf16(b1,qr[d0],p1,0,0,0);}}
}
typedef __attribute__((address_space(3))) const char* lds_cptr;
typedef __attribute__((address_space(3))) char* lds_ptr;
typedef short v4i16_t __attribute__((ext_vector_type(4)));
__device__ __forceinline__ void kload8(bf16x8*kf,lds_cptr kp){
  kf[0]=*(const __attribute__((address_space(3))) bf16x8*)(kp);      kf[1]=*(const __attribute__((address_space(3))) bf16x8*)(kp+512);
  kf[2]=*(const __attribute__((address_space(3))) bf16x8*)(kp+2048); kf[3]=*(const __attribute__((address_space(3))) bf16x8*)(kp+2560);
  kf[4]=*(const __attribute__((address_space(3))) bf16x8*)(kp+4096); kf[5]=*(const __attribute__((address_space(3))) bf16x8*)(kp+4608);
  kf[6]=*(const __attribute__((address_space(3))) bf16x8*)(kp+6144); kf[7]=*(const __attribute__((address_space(3))) bf16x8*)(kp+6656);
}
__device__ __forceinline__ void kload2(bf16x8*kf,lds_cptr kp,int j){ kf[2*j]=*(const __attribute__((address_space(3))) bf16x8*)(kp+j*2048); kf[2*j+1]=*(const __attribute__((address_space(3))) bf16x8*)(kp+j*2048+512); }
__device__ __forceinline__ s16x4 vtr(lds_cptr p){ return __builtin_bit_cast(s16x4,__builtin_amdgcn_ds_read_tr16_b64_v4i16((__attribute__((address_space(3))) v4i16_t*)p)); }
__device__ __forceinline__ float rowmax(const f32x16&p0,const f32x16&p1){
  float a=max3f(p0[0],p0[1],p1[0]),b=max3f(p0[2],p0[3],p1[1]);a=max3f(a,p1[2],p1[3]);
  #pragma unroll
  for(int r=4;r<16;r+=4){a=max3f(a,p0[r],p0[r+1]);b=max3f(b,p0[r+2],p0[r+3]);a=max3f(a,p1[r],p1[r+1]);b=max3f(b,p1[r+2],p1[r+3]);}
  const float m=max2f(a,b);
  auto rr=__builtin_amdgcn_permlane32_swap(__float_as_uint(m),__float_as_uint(m),false,false);
  return max2f(__uint_as_float(rr[0]),__uint_as_float(rr[1]));
}
__device__ __forceinline__ void pv(f32x16*o,int vb,bf16x8 pa0,bf16x8 pa1,bf16x8 pa2,bf16x8 pa3){
  #pragma unroll
  for(int d0=0;d0<2;++d0){s16x4 lo[4],hi[4];
    #pragma unroll
    for(int ks=0;ks<4;++ks){
      asm volatile("ds_read_b64_tr_b16 %0,%1 offset:%c2":"=&v"(lo[ks]):"v"(vb),"i"(d0*4096+ks*1024):"memory");
      asm volatile("ds_read_b64_tr_b16 %0,%1 offset:%c2":"=&v"(hi[ks]):"v"(vb),"i"(d0*4096+ks*1024+512):"memory");}
    asm volatile("s_waitcnt lgkmcnt(0)":::"memory");SBAR();
    #define PK(k) (bf16x8){lo[k][0],lo[k][1],lo[k][2],lo[k][3],hi[k][0],hi[k][1],hi[k][2],hi[k][3]}
    o[d0]=__builtin_amdgcn_mfma_f32_32x32x16_bf16(pa0,PK(0),o[d0],0,0,0);
    o[d0]=__builtin_amdgcn_mfma_f32_32x32x16_bf16(pa1,PK(1),o[d0],0,0,0);
    o[d0]=__builtin_amdgcn_mfma_f32_32x32x16_bf16(pa2,PK(2),o[d0],0,0,0);
    o[d0]=__builtin_amdgcn_mfma_f32_32x32x16_bf16(pa3,PK(3),o[d0],0,0,0);
    #undef PK
  }
}

template<int MODE,int THRL> __device__ __forceinline__ void attn_unit(int b,int h,int qb,const bf16*Q,const bf16*__restrict__ K,const bf16*__restrict__ V,bf16*O,const void*extra,char*shm){
  int tid_=threadIdx.x; asm volatile("":"+v"(tid_));
  const int tid=tid_,lane=tid&63,r32=lane&31,hi=lane>>5; const int wid=__builtin_amdgcn_readfirstlane(tid>>6);
  const long rowbase=(long)b*SEQ; const int q0=qb*QB;
  const int jt0=(MODE==0)?((4*qb-8)>0?(4*qb-8):0):0;
  const int NT=4*qb+4-jt0;
  const bf16*Qw=Q+(rowbase+q0+wid*QBLK)*DM+h*D;
  const bf16*Kh=K+(rowbase+(long)jt0*KVBLK)*DM+h*D,*Vh=V+(rowbase+(long)jt0*KVBLK)*DM+h*D;
  const unsigned lds0=(unsigned)(uintptr_t)shm;
  __attribute__((address_space(3))) float*wsf=(__attribute__((address_space(3))) float*)((lds_ptr)shm+LDS_WS)+wid*64;
  const lds_cptr shm3=(lds_cptr)shm;
  if(MODE==1){ const unsigned long long*selg=(const unsigned long long*)extra+(size_t)(rowbase+q0)*32; int row=tid>>1,par=tid&1; asm volatile("":"+v"(row),"+v"(par)); lds_ptr xm=(lds_ptr)shm+LDS_X;
    _Pragma("unroll 1") for(int cc=par;cc<NT/2;cc+=2){ const u32x4 v=*(const u32x4*)(selg+(size_t)row*32+2*cc);
      *(__attribute__((address_space(3))) u32x2*)(xm+((2*cc)*256+row)*8)=(u32x2){v.x,v.y}; *(__attribute__((address_space(3))) u32x2*)(xm+((2*cc+1)*256+row)*8)=(u32x2){v.z,v.w}; } }
  else { int tb_=tid; asm volatile("":"+v"(tb_)); if(tb_<257){ const float bv=((const float*)extra)[h*257+tb_]*1.4426950408889634f; *(__attribute__((address_space(3))) float*)((lds_ptr)shm+LDS_BIAS+tb_*4)=bv; } }
  const __attribute__((address_space(3))) float* biasl=(const __attribute__((address_space(3))) float*)(shm3+LDS_BIAS);
  const lds_cptr xmr=shm3+LDS_X+(wid*32+r32)*8;
  const bf16*ksrc=Kh+(long)lane*DM+wid*8;
  const bf16*vsrc=Vh+(long)(16*(wid&3)+(lane>>2))*DM+(wid>>2)*32+(lane&3)*8;
  const unsigned kdst=lds0+LDS_K+wid*1024, vdst=lds0+LDS_V+wid*1024;
  #define DMA_K(t,slot) glds16(ksrc+(long)(t)*KVBLK*DM,(unsigned)__builtin_amdgcn_readfirstlane(kdst+(slot)))
  #define DMA_V(t,slot) glds16(vsrc+(long)(t)*KVBLK*DM,(unsigned)__builtin_amdgcn_readfirstlane(vdst+(slot)))
  const char*Kbase=shm+LDS_K; bf16x8 kf[8];
  const lds_cptr kp0=shm3+LDS_K+hi*1024+r32*16; const lds_cptr vp0=shm3+LDS_V+((lane>>4)&1)*32+(lane&3)*8+(4*hi+((lane&15)>>2))*64;
  DMA_K(0,0);DMA_V(0,0);DMA_K(1,SLOTB);
  bf16x8 qr[4];
  #pragma unroll
  for(int d0=0;d0<4;++d0)qr[d0]=*reinterpret_cast<const bf16x8*>(&Qw[(long)r32*DM+d0*16+hi*8]);
  float mhat=0.f,l_reg=0.f;f32x16 o[2];o[0]=f32x16{};o[1]=f32x16{};const f32x16 negm=f32x16{};
  const int qpos=q0+wid*QBLK+r32;
  const int cw=4*qb+(wid>>1);
  #define MASKT(P0,P1,t) do{ \
    if(MODE==1){ const u32x2 mw_=*(const __attribute__((address_space(3))) u32x2*)(xmr+(t)*2048); const unsigned m0_=mw_.x>>(4*hi), m1_=mw_.y>>(4*hi); \
      _Pragma("unroll") for(int r=0;r<16;++r){ const int bit_=(r&3)+8*(r>>2); P0[r]=((m0_>>bit_)&1u)?P0[r]:NEGB; P1[r]=((m1_>>bit_)&1u)?P1[r]:NEGB; } } \
    else { const int jc_=jt0+(t); \
      if(jc_>cw||jc_+8<cw){ _Pragma("unroll") for(int r=0;r<16;++r){P0[r]=NEGB;P1[r]=NEGB;} } \
      else if((q0+wid*QBLK)-(64*jc_+63)>=128){ const float bc_=biasl[256]; _Pragma("unroll") for(int r=0;r<16;++r){P0[r]+=bc_;P1[r]+=bc_;} } \
      else { const int rb_=qpos-(64*jc_+4*hi); \
        _Pragma("unroll") for(int r=0;r<16;++r){ const int rel_=rb_-((r&3)+8*(r>>2)); int i0_=rel_<128?rel_:128; int i1_=(rel_-32)<128?(rel_-32):128; i0_=i0_<-128?-128:i0_; i1_=i1_<-128?-128:i1_; \
          P0[r]+=biasl[i0_+128]; P1[r]+=biasl[i1_+128]; } } } \
  }while(0)
  bool resc=false;
  #define START(P0,P1) do{ const float rm=rowmax(P0,P1); resc=false; \
    { const float dl=rm; mhat=fadd_s(mhat,dl); \
      _Pragma("unroll") for(int r=0;r<16;++r){P0[r]=fsub_s(P0[r],dl);P1[r]=fsub_s(P1[r],dl);} \
      } \
    _Pragma("unroll") for(int r=0;r<16;++r)P0[r]=__builtin_amdgcn_exp2f(P0[r]); }while(0)
  #define RESC() do{ if(resc){ asm volatile("s_waitcnt lgkmcnt(0)":::"memory"); \
      _Pragma("unroll") for(int d_=0;d_<2;++d_) _Pragma("unroll") for(int r=0;r<16;++r)o[d_][r]*=wsf[crow(r,hi)]; } }while(0)
  f32x16 pA0,pA1,pB0,pB1;
  int sl_prev=0,sl_cur=0,sl_next=SLOTB;
  #define ROT() do{sl_prev=sl_cur;sl_cur=sl_next;sl_next=(sl_next==(NSLOT-1)*SLOTB)?0:sl_next+SLOTB;}while(0)
  DMA_K(2,2*SLOTB);
  WAIT_BAR(3);
  qkt(pA0,pA1,Kbase,qr,negm,r32,hi);asm volatile("s_nop 15\n\ts_nop 7":"+v"(pA0),"+v"(pA1));MASKT(pA0,pA1,0);
  START(pA0,pA1);
  _Pragma("unroll") for(int r=0;r<16;++r)pA1[r]=__builtin_amdgcn_exp2f(pA1[r]);
  WAIT_BAR(0);
  DMA_K(3,0);DMA_V(1,SLOTB);
  ROT();
  kload8(kf,kp0+sl_cur);
  WAIT_BAR(2);
  s16x4 vlo[8],vhi[8]; u32x4 pw0,pw1,pw2,pw3;
  #define PKW(P,B) cvtpk_s(P[B],P[B+1])
  #define PAF(k) __builtin_bit_cast(bf16x8,pw##k)
  #define VFR(i) (bf16x8){vlo[i][0],vlo[i][1],vlo[i][2],vlo[i][3],vhi[i][0],vhi[i][1],vhi[i][2],vhi[i][3]}
  #define PIN(x) asm volatile("":"+v"(x))
  #define MX3(a,b,c) __builtin_fmaxf(__builtin_fmaxf((a),(b)),(c))
  #define GAPA(MF,A0,A1,A2,A3,W0,W1,PW) do{ MF; sacc+=A0; sacc+=A1; sacc+=A2; sacc+=A3; PIN(sacc); W0; W1; PIN(PW); SBAR(); }while(0)
  #define EX(v) __builtin_amdgcn_exp2f(v)
  #define GAPB(MF,X,B) do{ MF; X[B]=EX(X[B]); X[B+1]=EX(X[B+1]); X[B+2]=EX(X[B+2]); X[B+3]=EX(X[B+3]); PIN(X); SBAR(); }while(0)
  #define VRD(i) do{ vlo[i]=vtr(vp_+(((i)>>2)*4096+((i)&3)*1024)); vhi[i]=vtr(vp_+(((i)>>2)*4096+((i)&3)*1024+512)); }while(0)
  #define KRD(G,j) do{ if(G){ kload2(kf,kp0+sl_next,j); SBAR(); } }while(0)
  #define STEP(C0,C1,P0,P1,t,GK,GV,GL) do{ SBAR(); \
    const lds_cptr vp_=vp0+sl_prev; \
    VRD(0); SBAR(); float sacc=(P0[0]+P0[1]); \
    GAPA(C0=__builtin_amdgcn_mfma_f32_32x32x16_bf16(kf[0],qr[0],negm,0,0,0), P0[2],P0[3],P0[4],P0[5],     pw0[0]=PKW(P0,0), pw0[1]=PKW(P0,2), pw0); \
    VRD(4); SBAR(); GAPA(C1=__builtin_amdgcn_mfma_f32_32x32x16_bf16(kf[1],qr[0],negm,0,0,0), P0[6],P0[7],P0[8],P0[9],     pw0[2]=PKW(P0,4), pw0[3]=PKW(P0,6), pw0); \
    VRD(1); SBAR(); GAPA(C0=__builtin_amdgcn_mfma_f32_32x32x16_bf16(kf[2],qr[1],C0,0,0,0),   P0[10],P0[11],P0[12],P0[13], pw1[0]=PKW(P0,8), pw1[1]=PKW(P0,10), pw1); \
    VRD(5); SBAR(); GAPA(C1=__builtin_amdgcn_mfma_f32_32x32x16_bf16(kf[3],qr[1],C1,0,0,0),   P0[14],P0[15],P1[0],P1[1],   pw1[2]=PKW(P0,12),pw1[3]=PKW(P0,14), pw1); \
    VRD(2); SBAR(); GAPA(C0=__builtin_amdgcn_mfma_f32_32x32x16_bf16(kf[4],qr[2],C0,0,0,0),   P1[2],P1[3],P1[4],P1[5],     pw2[0]=PKW(P1,0), pw2[1]=PKW(P1,2), pw2); \
    VRD(6); SBAR(); GAPA(C1=__builtin_amdgcn_mfma_f32_32x32x16_bf16(kf[5],qr[2],C1,0,0,0),   P1[6],P1[7],P1[8],P1[9],     pw2[2]=PKW(P1,4), pw2[3]=PKW(P1,6), pw2); \
    VRD(3); SBAR(); GAPA(C0=__builtin_amdgcn_mfma_f32_32x32x16_bf16(kf[6],qr[3],C0,0,0,0),   P1[10],P1[11],P1[12],P1[13], pw3[0]=PKW(P1,8), pw3[1]=PKW(P1,10), pw3); \
    VRD(7); SBAR(); GAPA(C1=__builtin_amdgcn_mfma_f32_32x32x16_bf16(kf[7],qr[3],C1,0,0,0),   P1[14],P1[15],0.f,0.f,       pw3[2]=PKW(P1,12),pw3[3]=PKW(P1,14), pw3); \
    l_reg+=sacc; \
    if(GK){DMA_K((t)+3,sl_cur);} if(GV){DMA_V((t)+1,sl_next);} \
    _Pragma("unroll") for(int r=0;r<16;++r){C0[r]-=mhat;C1[r]-=mhat;} \
    MASKT(C0,C1,t); \
    { float a=MX3(C0[0],C0[1],C1[0]),b=MX3(C0[2],C0[3],C1[1]); a=MX3(a,C1[2],C1[3]); \
      _Pragma("unroll") for(int r=4;r<16;r+=4){a=MX3(a,C0[r],C0[r+1]);b=MX3(b,C0[r+2],C0[r+3]);a=MX3(a,C1[r],C1[r+1]);b=MX3(b,C1[r+2],C1[r+3]);} \
      float rm=__builtin_fmaxf(a,b); { auto rr=__builtin_amdgcn_permlane32_swap(__float_as_uint(rm),__float_as_uint(rm),false,false); rm=__builtin_fmaxf(__uint_as_float(rr[0]),__uint_as_float(rr[1])); } \
      resc=false; \
      if(__builtin_expect(__any(rm>(float)THRL),0)){ const float dl=__builtin_fmaxf(rm,0.f); mhat+=dl; \
        _Pragma("unroll") for(int r=0;r<16;++r){C0[r]-=dl;C1[r]-=dl;} \
        const float f=__builtin_amdgcn_exp2f(-dl); l_reg*=f; if(hi==0)wsf[r32]=f; resc=true; } } \
    SBAR(); \
    GAPB(o[0]=__builtin_amdgcn_mfma_f32_32x32x16_bf16(PAF(0),VFR(0),o[0],0,0,0), C0,0); \
    GAPB(o[1]=__builtin_amdgcn_mfma_f32_32x32x16_bf16(PAF(0),VFR(4),o[1],0,0,0), C0,4); \
    KRD(GL,0); GAPB(o[0]=__builtin_amdgcn_mfma_f32_32x32x16_bf16(PAF(1),VFR(1),o[0],0,0,0), C0,8); \
    KRD(GL,1); GAPB(o[1]=__builtin_amdgcn_mfma_f32_32x32x16_bf16(PAF(1),VFR(5),o[1],0,0,0), C0,12); \
    KRD(GL,2); GAPB(o[0]=__builtin_amdgcn_mfma_f32_32x32x16_bf16(PAF(2),VFR(2),o[0],0,0,0), C1,0); \
    KRD(GL,3); GAPB(o[1]=__builtin_amdgcn_mfma_f32_32x32x16_bf16(PAF(2),VFR(6),o[1],0,0,0), C1,4); \
    GAPB(o[0]=__builtin_amdgcn_mfma_f32_32x32x16_bf16(PAF(3),VFR(3),o[0],0,0,0), C1,8); \
    GAPB(o[1]=__builtin_amdgcn_mfma_f32_32x32x16_bf16(PAF(3),VFR(7),o[1],0,0,0), C1,12); \
    }while(0)
  int t=1;
  for(;t+5<NT;t+=2){
    STEP(pB0,pB1,pA0,pA1,t,true,true,true);     WAIT_BAR(2); RESC(); ROT();
    STEP(pA0,pA1,pB0,pB1,t+1,true,true,true);   WAIT_BAR(2); RESC(); ROT();
  }
  #define ENDW(tt) do{ if((tt)+3<NT){WAIT_BAR(2);} else if((tt)+2<NT){WAIT_BAR(1);} else {WAIT_BAR(0);} }while(0)
  for(;t+1<NT;t+=2){
    STEP(pB0,pB1,pA0,pA1,t,(t+3<NT),(t+1<NT),(t+1<NT));       ENDW(t);   RESC(); ROT();
    STEP(pA0,pA1,pB0,pB1,t+1,(t+4<NT),(t+2<NT),(t+2<NT));     ENDW(t+1); RESC(); ROT();
  }
  STEP(pB0,pB1,pA0,pA1,NT-1,false,false,false); RESC();
  { float sacc=pB0[0]+pB0[1]; _Pragma("unroll") for(int r=2;r<16;++r)sacc+=pB0[r]; _Pragma("unroll") for(int r=0;r<16;++r)sacc+=pB1[r]; l_reg+=sacc;
    pw0=(u32x4){PKW(pB0,0),PKW(pB0,2),PKW(pB0,4),PKW(pB0,6)};pw1=(u32x4){PKW(pB0,8),PKW(pB0,10),PKW(pB0,12),PKW(pB0,14)};pw2=(u32x4){PKW(pB1,0),PKW(pB1,2),PKW(pB1,4),PKW(pB1,6)};pw3=(u32x4){PKW(pB1,8),PKW(pB1,10),PKW(pB1,12),PKW(pB1,14)};
    const int vb0=(int)(lds0+LDS_V)+((lane>>4)&1)*32+(lane&3)*8+(4*hi+((lane&15)>>2))*64;
    SBAR(); pv(o,vb0+sl_cur,PAF(0),PAF(1),PAF(2),PAF(3)); }
  #undef PKW
  #undef PAF
  #undef VFR
  #undef PIN
  #undef MX3
  #undef GAPA
  #undef GAPB
  #undef EX
  #undef VRD
  #undef KRD
  #undef STEP
  #undef ENDW
  {auto rr=__builtin_amdgcn_permlane32_swap(__float_as_uint(l_reg),__float_as_uint(l_reg),false,false);l_reg=__uint_as_float(rr[0])+__uint_as_float(rr[1]);}
  if(hi==0)wsf[32+r32]=l_reg;
  asm volatile("s_waitcnt lgkmcnt(0)\n\ts_barrier":::"memory");
  float rli[16];
  #pragma unroll
  for(int r=0;r<16;++r)rli[r]=__builtin_amdgcn_rcpf(wsf[32+crow(r,hi)]);
  bf16*Ow=O+(rowbase+q0+wid*QBLK)*DM+h*D;
  { bf16*stg=(bf16*)(shm+LDS_OST)+wid*2048;
    #pragma unroll
    for(int r=0;r<16;++r){const int orow=crow(r,hi);
      #pragma unroll
      for(int d0=0;d0<2;++d0)stg[orow*64+d0*32+r32]=__float2bfloat16(o[d0][r]*rli[r]);}
    asm volatile("s_waitcnt lgkmcnt(0)":::"memory");
    #pragma unroll
    for(int i=0;i<4;++i){const int row=i*8+(lane>>3),ch=lane&7; const u32x4 v=*(const u32x4*)(stg+row*64+ch*8); *(u32x4*)(Ow+(long)row*DM+ch*8)=v;} }
  asm volatile("s_waitcnt lgkmcnt(0)\n\ts_barrier":::"memory");
  #undef DMA_K
  #undef DMA_V
  #undef MASKT
  #undef START
  #undef RESC
  #undef ROT
}
constexpr int ATTN_LDS_BYTES=LDS_BYTES;
#undef SBAR
#undef WAIT_BAR
}
constexpr int NB = 8, SEQ = 2048, T = NB * SEQ, D = 1024;
constexpr int DIN = 5704, DINP = 5888;
constexpr int NEXP = 64, DEXP = 256, TOPK = 8;
constexpr int NCHUNK = 2, CHTOK = T / NCHUNK, CHROWS = CHTOK * TOPK;
constexpr float LN_EPS = 1e-5f;
constexpr float DN_ALPHA = 1.189207115002721f;
constexpr float LOG2E = 1.4426950408889634f;
constexpr int NWAVES = 8;
constexpr int NPHASE = 15;

constexpr size_t MiB = 1u << 20;
constexpr size_t WS_CTL = 0, CTL_ZERO_BYTES = 1 * MiB;
constexpr size_t WS_MOD = 1 * MiB, WS_STATS = 1 * MiB + 256 * 1024, WS_ROPE = 2 * MiB, WS_XCH = 3 * MiB;
constexpr size_t WS_EGU = 4 * MiB, WS_ED = 68 * MiB, WS_SHGU = 100 * MiB, WS_SHD = 101 * MiB;
constexpr size_t WS_WA = 102 * MiB, WS_WB = 103 * MiB, WS_WOUT = 104 * MiB, WS_WIN = 106 * MiB;
constexpr size_t WS_XN = 118 * MiB;
constexpr size_t WS_QA = 150 * MiB, WS_QB = 166 * MiB, WS_KA = 182 * MiB, WS_VA = 198 * MiB, WS_KB = 214 * MiB, WS_VB = 230 * MiB;
constexpr size_t WS_QI = 246 * MiB, WS_KIW = 262 * MiB, WS_KI = 270 * MiB, WS_WI = 272 * MiB, WS_SEL = 273 * MiB;
constexpr size_t WS_TMP = 182 * MiB, WS_MERGED = 246 * MiB;
constexpr size_t WS_NVO = 277 * MiB;
constexpr size_t WS_HSH = 102 * MiB, WS_TAB = 110 * MiB, WS_HEXP = 150 * MiB, WS_YEXP = 182 * MiB, WS_END = 310 * MiB;
constexpr size_t TAB_ER = 0, TAB_W = 512 * 1024, TAB_LIST = 1 * MiB;
constexpr int CW_TMO = 0, CW_CODE = 1, CW_BAR = 4096, CW_SEAM = 16384, SEAM_BANK = 128 * 64, CW_CNT = 40960;

constexpr int RING_OFF = 0, RING_BYTES = 131072;
constexpr int LDSCTL_OFF = RING_BYTES, MISC_OFF = LDSCTL_OFF + 320;
constexpr int XTAB_OFF = MISC_OFF + 128;
constexpr int LDS_BYTES = 147456;
static_assert(XTAB_OFF + 1024 <= LDS_BYTES, "LDS map");

#define GAS __attribute__((address_space(1)))
#define LAS __attribute__((address_space(3)))
typedef unsigned short bf16;
typedef unsigned v4u __attribute__((ext_vector_type(4)));
typedef unsigned v2u __attribute__((ext_vector_type(2)));
typedef float f32x4 __attribute__((ext_vector_type(4)));
typedef float f32x2 __attribute__((ext_vector_type(2)));
typedef short bf16x8 __attribute__((ext_vector_type(8)));
typedef float f32x16 __attribute__((ext_vector_type(16)));
typedef GAS unsigned gu32;
#define RLX_AGENT __ATOMIC_RELAXED, __HIP_MEMORY_SCOPE_AGENT
#define LDS_WAIT() asm volatile("s_waitcnt lgkmcnt(0)" ::: "memory")
#define VM_WAIT() asm volatile("s_waitcnt vmcnt(0)" ::: "memory")
__device__ __forceinline__ unsigned f2bf(float f) { unsigned u = __builtin_bit_cast(unsigned, f); return (u + 0x7fffu + ((u >> 16) & 1u)) >> 16; }
__device__ __forceinline__ unsigned pk2(float lo, float hi) { return f2bf(lo) | (f2bf(hi) << 16); }
__device__ __forceinline__ float bf2f(unsigned short h) { return __uint_as_float((unsigned)h << 16); }
__device__ __forceinline__ float bflo(unsigned w) { return __uint_as_float(w << 16); }
__device__ __forceinline__ float bfhi(unsigned w) { return __uint_as_float(w & 0xffff0000u); }
__device__ __forceinline__ float sigmoidf_(float v) { return __builtin_amdgcn_rcpf(1.0f + __builtin_amdgcn_exp2f(-v * LOG2E)); }

#define XB_TMO      128
#define XB_XCNT(j)  (256  + 64 * (j))
#define XB_XSUB(j)  (1280 + 64 * (j))
#define XB_XGEN(j)  (2304 + 64 * (j))
#define XB_TOP      3328
#define XB_TOPGEN   3392
#define XCD_BAR_WORDS 3456
#define XB_SPIN_CAP (1u << 18)
__device__ __forceinline__ unsigned xb_ld(unsigned* p)              { return __hip_atomic_load(p, __ATOMIC_RELAXED, __HIP_MEMORY_SCOPE_AGENT); }
__device__ __forceinline__ unsigned xb_add(unsigned* p, unsigned v) { return __hip_atomic_fetch_add(p, v, __ATOMIC_RELAXED, __HIP_MEMORY_SCOPE_AGENT); }
__device__ __forceinline__ unsigned xb_xcc_id() { return (unsigned)__builtin_amdgcn_s_getreg((3 << 11) | 20) & 0xFu; }
#define XB_SPIN(cond, bar) do { unsigned _sp = 0; while (cond) { __builtin_amdgcn_s_sleep(1); \
    if ((++_sp & 255u) == 0u) { if (xb_ld(&(bar)[XB_TMO])) break; if (_sp > XB_SPIN_CAP) { atomicAdd(&(bar)[XB_TMO], 1u); break; } } } } while (0)
struct XcdBarrier { unsigned* bar; unsigned x; volatile LAS unsigned* st; };
__device__ __forceinline__ XcdBarrier xcd_barrier_post(unsigned* bar, volatile LAS unsigned* st) {
    XcdBarrier b; b.bar = bar; b.x = xb_xcc_id(); b.st = st;
    if (threadIdx.x == 0) (void)xb_add(&bar[XB_XCNT(b.x)], 1u);
    return b;
}
__device__ __forceinline__ void xcd_barrier_complete(unsigned* bar, unsigned x, unsigned& nloc, unsigned& nx) {
    const unsigned G = gridDim.x * gridDim.y * gridDim.z;
    unsigned sum, cnt, mine, sp = 0u;
    for (;;) {
        sum = 0u; cnt = 0u; mine = 0u;
#pragma unroll
        for (unsigned j = 0; j < 16; ++j) { const unsigned c = xb_ld(&bar[XB_XCNT(j)]); sum += c; cnt += (c > 0u) ? 1u : 0u; mine = (j == x) ? c : mine; }
        if (sum == G) break;
        __builtin_amdgcn_s_sleep(1);
        if ((++sp & 255u) == 0u) { if (xb_ld(&bar[XB_TMO])) break; if (sp > XB_SPIN_CAP) { atomicAdd(&bar[XB_TMO], 1u); break; } }
    }
    nloc = mine > 0u ? mine : 1u; nx = cnt > 0u ? cnt : 1u;
}
__device__ __forceinline__ void xcd_barrier(const XcdBarrier& b) {
    asm volatile("s_waitcnt vmcnt(0)" ::: "memory");
    __syncthreads();
    if (threadIdx.x == 0) {
        unsigned* bar = b.bar;
        __builtin_amdgcn_s_waitcnt(0);
        unsigned nloc = b.st[0], nx = b.st[1];
        if (nloc == 0u) { xcd_barrier_complete(bar, b.x, nloc, nx); b.st[0] = nloc; b.st[1] = nx; }
        const unsigned old = xb_add(&bar[XB_XSUB(b.x)], 1u);
        const unsigned gen = old / nloc;
        if (old + 1u == (gen + 1u) * nloc) {
            __builtin_amdgcn_fence(__ATOMIC_RELEASE, "agent");
            asm volatile("s_waitcnt vmcnt(0)" ::: "memory");
            const unsigned og = xb_add(&bar[XB_TOP], 1u);
            const unsigned tg = og / nx;
            if (og + 1u == (tg + 1u) * nx) xb_add(&bar[XB_TOPGEN], 1u);
            else XB_SPIN(xb_ld(&bar[XB_TOPGEN]) == tg, bar);
            __builtin_amdgcn_fence(__ATOMIC_ACQUIRE, "agent");
            xb_add(&bar[XB_XGEN(b.x)], 1u);
            asm volatile("s_waitcnt vmcnt(0)" ::: "memory");
        } else {
            XB_SPIN(xb_ld(&bar[XB_XGEN(b.x)]) == gen, bar);
            __builtin_amdgcn_fence(__ATOMIC_ACQUIRE, "agent");
            asm volatile("s_waitcnt vmcnt(0)" ::: "memory");
        }
    }
    __syncthreads();
}

__device__ __forceinline__ float wave_sum(float v) {
#pragma unroll
    for (int o = 1; o < 64; o <<= 1) v += __shfl_xor(v, o);
    return v;
}

struct Args {
    const float* x; const float* c; const int* positions; const float* w_ada; const float* b_ada; const float* w_in; const float* rel_bias;
    const float* ikn_g; const float* ikn_b; const float* w_branch_a; const float* w_branch_b; const float* w_out; const float* ln1_g; const float* ln1_b;
    const float* w_router; const float* router_bias; const float* w_exp_gate; const float* w_exp_up; const float* w_exp_down;
    const float* w_sh_gate; const float* w_sh_up; const float* w_sh_down; const float* ln2_g; const float* ln2_b;
    float* out; unsigned char* ws;
    double inv_freq_rev[8];
    int ph_lo, ph_hi, li, flags;
};
using pg8::Unit; using pg8::cvt_pk_bf16;
__device__ __forceinline__ v4u pack8(const f32x4& v0, const f32x4& v1) { v4u w; w.x = cvt_pk_bf16(v0[0], v0[1]); w.y = cvt_pk_bf16(v0[2], v0[3]); w.z = cvt_pk_bf16(v1[0], v1[1]); w.w = cvt_pk_bf16(v1[2], v1[3]); return w; }

struct EpiInProj {
    static constexpr bool PERM = true, AFTER_DRAIN = false;
    unsigned char* ws; bf16* gates; const float* cosT; const float* sinT;
    __device__ __forceinline__ void operator()(const f32x4 (&acc)[2][2][4][2], const Unit& u, int wr, int wc, int fr, int fq) const {
        const int pn = u.pn, row0 = u.pm * 256 + wr * 64 + fr, ct = wc * 32 + 8 * fq;
        if (pn < 14) {
            size_t off; float sc = 1.f; bool rope = false; int colbase = (pn & 1) * 256;
            if (pn < 12) { const int seg = pn >> 1;
                off = seg == 0 ? WS_QA : seg == 1 ? WS_KA : seg == 2 ? WS_VA : seg == 3 ? WS_QB : seg == 4 ? WS_KB : WS_VB;
                sc = (seg == 0 || seg == 3) ? attn_body::C2 : 1.f; rope = (seg == 3 || seg == 4); }
            else { off = WS_QI; rope = true; }
            bf16* base = (bf16*)(ws + off);
            const bool dor = rope && ((wc & 1) == 0) && (fq < 2);
#pragma unroll
            for (int ai = 0; ai < 2; ++ai)
#pragma unroll
                for (int m = 0; m < 4; ++m) { const int row = row0 + ai * 128 + m * 16;
                    f32x4 c4 = (f32x4){1.f, 1.f, 1.f, 1.f}, s4 = (f32x4){0.f, 0.f, 0.f, 0.f};
                    if (dor) { c4 = *(const f32x4*)(cosT + (size_t)row * 8 + 4 * fq); s4 = *(const f32x4*)(sinT + (size_t)row * 8 + 4 * fq); }
#pragma unroll
                    for (int bj = 0; bj < 2; ++bj) { f32x4 v0 = acc[ai][bj][m][0], v1 = acc[ai][bj][m][1];
                        { f32x4 r0, r1;
                          r0[0] = v0[0] * c4[0] - v0[1] * s4[0]; r0[1] = v0[1] * c4[0] + v0[0] * s4[0]; r0[2] = v0[2] * c4[1] - v0[3] * s4[1]; r0[3] = v0[3] * c4[1] + v0[2] * s4[1];
                          r1[0] = v1[0] * c4[2] - v1[1] * s4[2]; r1[1] = v1[1] * c4[2] + v1[0] * s4[2]; r1[2] = v1[2] * c4[3] - v1[3] * s4[3]; r1[3] = v1[3] * c4[3] + v1[2] * s4[3];
                          v0 = r0 * sc; v1 = r1 * sc; }
                        *(v4u*)(base + (size_t)row * 512 + colbase + bj * 128 + ct) = pack8(v0, v1); } }
        } else if (pn == 14) {
            float* kiw = (float*)(ws + WS_KIW);
#pragma unroll
            for (int ai = 0; ai < 2; ++ai)
#pragma unroll
                for (int m = 0; m < 4; ++m) { const int row = row0 + ai * 128 + m * 16;
                    *(f32x4*)(kiw + (size_t)row * 128 + ct) = acc[ai][0][m][0]; *(f32x4*)(kiw + (size_t)row * 128 + ct + 4) = acc[ai][0][m][1]; }
        } else {
            const int colbase = (pn - 15) * 256;
#pragma unroll
            for (int ai = 0; ai < 2; ++ai)
#pragma unroll
                for (int m = 0; m < 4; ++m) { const int row = row0 + ai * 128 + m * 16;
#pragma unroll
                    for (int bj = 0; bj < 2; ++bj) { f32x4 v0 = acc[ai][bj][m][0], v1 = acc[ai][bj][m][1];
#pragma unroll
                        for (int i = 0; i < 4; ++i) { v0[i] = sigmoidf_(v0[i]); v1[i] = sigmoidf_(v1[i]); }
                        *(v4u*)(gates + (size_t)row * 2048 + colbase + bj * 128 + ct) = pack8(v0, v1); } }
        }
    }
};

template <int PASS> struct EpiGate {
    static constexpr bool PERM = true, AFTER_DRAIN = false;
    const bf16* gates; float* tmp; bf16* merged;
    __device__ __forceinline__ void operator()(const f32x4 (&acc)[2][2][4][2], const Unit& u, int wr, int wc, int fr, int fq) const {
        const int row0 = u.pm * 256 + wr * 64 + fr, c0 = u.pn * 256 + wc * 32 + 8 * fq;
#pragma unroll
        for (int ai = 0; ai < 2; ++ai)
#pragma unroll
            for (int m = 0; m < 4; ++m) { const int row = row0 + ai * 128 + m * 16;
#pragma unroll
                for (int bj = 0; bj < 2; ++bj) { const int c = c0 + bj * 128;
                    const v4u g = *(const v4u*)(gates + (size_t)row * 2048 + (PASS == 1 ? 0 : 1024) + c);
                    f32x4 v0 = acc[ai][bj][m][0], v1 = acc[ai][bj][m][1];
                    v0[0] *= bflo(g.x); v0[1] *= bfhi(g.x); v0[2] *= bflo(g.y); v0[3] *= bfhi(g.y); v1[0] *= bflo(g.z); v1[1] *= bfhi(g.z); v1[2] *= bflo(g.w); v1[3] *= bfhi(g.w);
                    float* tp = tmp + (size_t)row * 1024 + c;
                    if (PASS == 1) { *(f32x4*)tp = v0; *(f32x4*)(tp + 4) = v1; }
                    else { v0 += *(const f32x4*)tp; v1 += *(const f32x4*)(tp + 4); *(v4u*)(merged + (size_t)row * 1024 + c) = pack8(v0, v1); } } }
    }
};

__device__ __forceinline__ float silu_mul(float g, float u) { return g * sigmoidf_(g) * u; }
struct EpiSilu {
    static constexpr bool PERM = true, AFTER_DRAIN = false;
    bf16* H;
    __device__ __forceinline__ void operator()(const f32x4 (&acc)[2][2][4][2], const Unit& u, int wr, int wc, int fr, int fq) const {
        const int row0 = u.pm * 256 + wr * 64 + fr, c0 = (u.pn * 256 + wc * 32 + 8 * fq) >> 1;
#pragma unroll
        for (int ai = 0; ai < 2; ++ai)
#pragma unroll
            for (int m = 0; m < 4; ++m) { const int row = row0 + ai * 128 + m * 16;
#pragma unroll
                for (int bj = 0; bj < 2; ++bj) { const f32x4 v0 = acc[ai][bj][m][0], v1 = acc[ai][bj][m][1];
                    v2u w; w.x = cvt_pk_bf16(silu_mul(v0[0], v0[1]), silu_mul(v0[2], v0[3])); w.y = cvt_pk_bf16(silu_mul(v1[0], v1[1]), silu_mul(v1[2], v1[3]));
                    *(v2u*)(H + (size_t)row * 256 + c0 + bj * 64) = w; } }
    }
};
struct EpiExpGU {
    static constexpr bool PERM = true, AFTER_DRAIN = false;
    bf16* H; const LAS int* xt; const unsigned short* list; const float* rw; int chunk;
    __device__ __forceinline__ void operator()(const f32x4 (&acc)[2][2][4][2], const Unit& u, int wr, int wc, int fr, int fq) const {
        const int r0 = wr * 64 + fr, c0 = (u.pn * 256 + wc * 32 + 8 * fq) >> 1; const int pos0 = __builtin_amdgcn_readfirstlane(xt[144 + u.e]) + u.pm * 256;
#pragma unroll
        for (int ai = 0; ai < 2; ++ai)
#pragma unroll
            for (int m = 0; m < 4; ++m) { const int r = r0 + ai * 128 + m * 16;
                if (r < u.nrows) { const unsigned ent = list[(size_t)u.e * 8192 + u.pm * 256 + r]; const float w = rw[(size_t)(chunk * CHTOK + (int)(ent >> 3)) * 8 + (ent & 7u)];
#pragma unroll
                    for (int bj = 0; bj < 2; ++bj) { const f32x4 v0 = acc[ai][bj][m][0], v1 = acc[ai][bj][m][1];
                        v2u pk; pk.x = cvt_pk_bf16(w * silu_mul(v0[0], v0[1]), w * silu_mul(v0[2], v0[3])); pk.y = cvt_pk_bf16(w * silu_mul(v1[0], v1[1]), w * silu_mul(v1[2], v1[3]));
                        *(v2u*)(H + (size_t)(pos0 + r) * 256 + c0 + bj * 64) = pk; } } }
    }
};
struct EpiExpD {
    static constexpr bool PERM = true, AFTER_DRAIN = false;
    bf16* Y; const LAS int* xt;
    __device__ __forceinline__ void operator()(const f32x4 (&acc)[2][2][4][2], const Unit& u, int wr, int wc, int fr, int fq) const {
        const int r0 = wr * 64 + fr, c0 = u.pn * 256 + wc * 32 + 8 * fq; const int pos0 = __builtin_amdgcn_readfirstlane(xt[144 + u.e]) + u.pm * 256;
#pragma unroll
        for (int ai = 0; ai < 2; ++ai)
#pragma unroll
            for (int m = 0; m < 4; ++m) { const int r = r0 + ai * 128 + m * 16;
                if (r < u.nrows) {
#pragma unroll
                    for (int bj = 0; bj < 2; ++bj) *(v4u*)(Y + (size_t)(pos0 + r) * 1024 + c0 + bj * 128) = pack8(acc[ai][bj][m][0], acc[ai][bj][m][1]); } }
    }
};
struct EpiShD {
    static constexpr bool PERM = true, AFTER_DRAIN = false;
    float* z; const float* mod;
    __device__ __forceinline__ void operator()(const f32x4 (&acc)[2][2][4][2], const Unit& u, int wr, int wc, int fr, int fq) const {
        const int row0 = u.pm * 256 + wr * 64 + fr, c0 = u.pn * 256 + wc * 32 + 8 * fq; const float* g2 = mod + (size_t)(u.pm >> 3) * 6144 + 5120;
#pragma unroll
        for (int bj = 0; bj < 2; ++bj) { const int c = c0 + bj * 128; const f32x4 ga = *(const f32x4*)(g2 + c), gb = *(const f32x4*)(g2 + c + 4);
#pragma unroll
            for (int ai = 0; ai < 2; ++ai)
#pragma unroll
                for (int m = 0; m < 4; ++m) { float* p = z + (size_t)(row0 + ai * 128 + m * 16) * 1024 + c;
                    const f32x4 a = *(const f32x4*)p, b = *(const f32x4*)(p + 4);
                    *(f32x4*)p = a * DN_ALPHA + ga * acc[ai][bj][m][0]; *(f32x4*)(p + 4) = b * DN_ALPHA + gb * acc[ai][bj][m][1]; } }
    }
};
struct EpiResid {
    static constexpr bool PERM = true, AFTER_DRAIN = false;
    const float* x; float* v; const float* mod;
    __device__ __forceinline__ void operator()(const f32x4 (&acc)[2][2][4][2], const Unit& u, int wr, int wc, int fr, int fq) const {
        const int row0 = u.pm * 256 + wr * 64 + fr, c0 = u.pn * 256 + wc * 32 + 8 * fq; const float* g1 = mod + (size_t)(u.pm >> 3) * 6144 + 2048;
#pragma unroll
        for (int bj = 0; bj < 2; ++bj) { const int c = c0 + bj * 128; const f32x4 ga = *(const f32x4*)(g1 + c), gb = *(const f32x4*)(g1 + c + 4);
#pragma unroll
            for (int ai = 0; ai < 2; ++ai)
#pragma unroll
                for (int m = 0; m < 4; ++m) { const size_t o = (size_t)(row0 + ai * 128 + m * 16) * 1024 + c;
                    const f32x4 a = *(const f32x4*)(x + o), b = *(const f32x4*)(x + o + 4);
                    *(f32x4*)(v + o) = a * DN_ALPHA + ga * acc[ai][bj][m][0]; *(f32x4*)(v + o + 4) = b * DN_ALPHA + gb * acc[ai][bj][m][1]; } }
    }
};

template <int MODE> struct ExpertOrder {
    const LAS int* xt; int nN, G, c, total, chunk; const unsigned short* list; const char* W; size_t wexp, btile;
    __device__ __forceinline__ bool next(int i, Unit& u) const {
        const long L = (long)i * G + c; if (L >= (long)total * nN) return false;
        const int lt = (int)(L / nN); u.pn = (int)(L - (long)lt * nN);
        int e = 0;
#pragma unroll
        for (int s = 32; s >= 1; s >>= 1) { const int v = __builtin_amdgcn_readfirstlane(xt[e + s]); if (v <= lt) e += s; }
        u.e = e; u.pm = lt - __builtin_amdgcn_readfirstlane(xt[e]); const int rem = __builtin_amdgcn_readfirstlane(xt[80 + e]) - u.pm * 256; u.nrows = rem < 256 ? rem : 256; return true;
    }
    __device__ __forceinline__ unsigned a_off(const Unit& u, int row) const {
        if (MODE == 0) { int idx = u.pm * 256 + row; const int last = __builtin_amdgcn_readfirstlane(xt[80 + u.e]) - 1; idx = idx < last ? idx : last;
            const unsigned ent = list[(size_t)u.e * 8192 + idx]; return (unsigned)(chunk * CHTOK + (int)(ent >> 3)) * 2048u; }
        int p = __builtin_amdgcn_readfirstlane(xt[144 + u.e]) + u.pm * 256 + row; p = p < CHROWS - 1 ? p : CHROWS - 1; return (unsigned)p * 512u;
    }
    __device__ __forceinline__ const char* b_ptr(const Unit& u) const { return W + (size_t)u.e * wexp + (size_t)u.pn * btile; }
};
__device__ __forceinline__ void build_xtab(LAS int* xt, const unsigned* ctl, int chunk) {
    int tid = threadIdx.x; asm volatile("" : "+v"(tid));
    if (tid < 64) xt[80 + tid] = (int)__hip_atomic_load(ctl + CW_CNT + (chunk * 64 + tid) * 16, RLX_AGENT);
    LDS_WAIT(); __syncthreads();
    if (tid == 0) { int ts = 0, of = 0; for (int e = 0; e < 64; ++e) { const int c = xt[80 + e]; xt[e] = ts; xt[144 + e] = of; ts += (c + 255) >> 8; of += c; } xt[64] = ts; }
    LDS_WAIT(); __syncthreads();
}
struct Ctx { LAS unsigned char* lds; int tid, lane, wave, vcu, G; };

struct MapId { int base; __device__ __forceinline__ int operator()(int s) const { return base + s; } };
struct MapIl { int base, par; __device__ __forceinline__ int operator()(int s) const { return base + 2 * s + par; } };
__device__ __forceinline__ int dperm_inv(int d) { return d < 8 ? 2 * d : (d < 16 ? 2 * (d - 8) + 1 : d); }
struct MapIn { __device__ __forceinline__ int operator()(int s) const {
    if (s < 1536) return s;
    if (s < 3072) { const int q = s - 1536, seg = q >> 9, hh = (q >> 6) & 7, d = q & 63; return 1536 + seg * 512 + hh * 64 + (seg < 2 ? dperm_inv(d) : d); }
    if (s < 3584) { const int q = s - 3072, hh = q >> 6, d = q & 63; return 3072 + hh * 64 + dperm_inv(d); }
    if (s < 3656) return s;
    return 3840 + (s - 3656); } };
template <class Map> __device__ __forceinline__ void xpose_item(const float* W, int N, int K, int item, bf16* WT, const Map& map, LAS float* scr, int lane) {
    const int nblk = (N + 31) / 32, kb = item / nblk, nb = item % nblk, k0 = 64 * kb, n0 = 32 * nb;
    const bool cin = (n0 + (lane & 31)) < N;
#pragma unroll 8
    for (int i = 0; i < 32; ++i) { const int kk = 2 * i + (lane >> 5); scr[kk * 33 + (lane & 31)] = cin ? W[(size_t)(k0 + kk) * N + n0 + (lane & 31)] : 0.f; }
    LDS_WAIT(); asm volatile("" ::: "memory");
    const int c = lane & 7;
#pragma unroll
    for (int j = 0; j < 4; ++j) { const int n = (lane >> 3) + 8 * j; const LAS float* s = scr + (8 * c) * 33 + n;
        v4u o; o.x = pk2(s[0 * 33], s[1 * 33]); o.y = pk2(s[2 * 33], s[3 * 33]); o.z = pk2(s[4 * 33], s[5 * 33]); o.w = pk2(s[6 * 33], s[7 * 33]);
        if (n0 + n < N) *(GAS v4u*)(WT + (size_t)map(n0 + n) * K + k0 + 8 * c) = o; }
    LDS_WAIT(); asm volatile("" ::: "memory");
}

__device__ __forceinline__ void p0_prologue(const Args& a, const Ctx& F) {
    unsigned char* ws = a.ws;
    {
        LAS float* cact = (LAS float*)(F.lds);
        LAS float* red = (LAS float*)(F.lds + 32768);
        for (int i = F.tid; i < 8 * 1024; i += 512) { const float v = a.c[i]; cact[i] = v * sigmoidf_(v); }
        LDS_WAIT(); __syncthreads();
        float* mod = (float*)(ws + WS_MOD);
        for (int item = F.vcu; item < 6144 / 32; item += F.G) {
            const int n0 = item * 32, kk = F.tid >> 5, col = F.tid & 31; float acc[8];
#pragma unroll
            for (int b = 0; b < 8; ++b) acc[b] = 0.f;
#pragma unroll 4
            for (int k = kk; k < 1024; k += 16) { const float w = a.w_ada[(size_t)k * 6144 + n0 + col];
#pragma unroll
                for (int b = 0; b < 8; ++b) acc[b] += cact[b * 1024 + k] * w; }
#pragma unroll
            for (int b = 0; b < 8; ++b) red[(kk * 8 + b) * 32 + col] = acc[b];
            LDS_WAIT(); __syncthreads();
            if (F.tid < 256) { const int b = F.tid >> 5; float s = 0.f;
#pragma unroll
                for (int q = 0; q < 16; ++q) s += red[(q * 8 + b) * 32 + col];
                mod[(size_t)b * 6144 + n0 + col] = s + a.b_ada[n0 + col]; }
            LDS_WAIT(); __syncthreads();
        }
        LDS_WAIT(); __syncthreads();
    }
    const int gw = F.vcu * NWAVES + F.wave, NGW = F.G * NWAVES;
    {
        float* cosT = (float*)(ws + WS_ROPE); float* sinT = cosT + (size_t)T * 8;
        for (int i = gw * 64 + F.lane; i < T * 8; i += NGW * 64) { const int t = i >> 3, j = i & 7;
            const double rev = (double)a.positions[t] * a.inv_freq_rev[j]; const float fr = (float)(rev - __builtin_floor(rev));
            cosT[i] = __builtin_amdgcn_cosf(fr); sinT[i] = __builtin_amdgcn_sinf(fr); }
    }
    {
        v4u* z = (v4u*)((bf16*)(ws + WS_WIN) + (size_t)3656 * 1024); const int n16 = 184 * 1024 * 2 / 16;
        for (int i = gw * 64 + F.lane; i < n16; i += NGW * 64) z[i] = (v4u){0u, 0u, 0u, 0u};
    }
    LAS float* scr = (LAS float*)(F.lds + F.wave * 16384);
    constexpr int I_IN = 16 * 179, I_BR = 8 * 32, I_OUT = 16 * 32, I_SG = 16 * 8, I_SD = 4 * 32, I_EG = 64 * 16 * 8, I_EDN = 64 * 4 * 32;
    constexpr int NITEMS = I_IN + 2 * I_BR + I_OUT + 2 * I_SG + I_SD + 2 * I_EG + I_EDN;
    for (int it = gw; it < NITEMS; it += NGW) {
        int r = it;
        if (r < I_IN) { xpose_item(a.w_in, DIN, 1024, r, (bf16*)(ws + WS_WIN), MapIn{}, scr, F.lane); continue; } r -= I_IN;
        if (r < I_BR) { xpose_item(a.w_branch_a, 1024, 512, r, (bf16*)(ws + WS_WA), MapId{0}, scr, F.lane); continue; } r -= I_BR;
        if (r < I_BR) { xpose_item(a.w_branch_b, 1024, 512, r, (bf16*)(ws + WS_WB), MapId{0}, scr, F.lane); continue; } r -= I_BR;
        if (r < I_OUT) { xpose_item(a.w_out, 1024, 1024, r, (bf16*)(ws + WS_WOUT), MapId{0}, scr, F.lane); continue; } r -= I_OUT;
        if (r < I_SG) { xpose_item(a.w_sh_gate, 256, 1024, r, (bf16*)(ws + WS_SHGU), MapIl{0, 0}, scr, F.lane); continue; } r -= I_SG;
        if (r < I_SG) { xpose_item(a.w_sh_up, 256, 1024, r, (bf16*)(ws + WS_SHGU), MapIl{0, 1}, scr, F.lane); continue; } r -= I_SG;
        if (r < I_SD) { xpose_item(a.w_sh_down, 1024, 256, r, (bf16*)(ws + WS_SHD), MapId{0}, scr, F.lane); continue; } r -= I_SD;
        if (r < I_EG) { const int e = r >> 7; xpose_item(a.w_exp_gate + (size_t)e * 1024 * 256, 256, 1024, r & 127, (bf16*)(ws + WS_EGU) + (size_t)e * 512 * 1024, MapIl{0, 0}, scr, F.lane); continue; } r -= I_EG;
        if (r < I_EG) { const int e = r >> 7; xpose_item(a.w_exp_up + (size_t)e * 1024 * 256, 256, 1024, r & 127, (bf16*)(ws + WS_EGU) + (size_t)e * 512 * 1024, MapIl{0, 1}, scr, F.lane); continue; } r -= I_EG;
        { const int e = r >> 7; xpose_item(a.w_exp_down + (size_t)e * 256 * 1024, 1024, 256, r & 127, (bf16*)(ws + WS_ED) + (size_t)e * 1024 * 256, MapId{0}, scr, F.lane); }
    }
}

__device__ __forceinline__ void ln_stats(const f32x4 (&v)[4], float& mean, float& rstd) {
    float s = 0.f;
#pragma unroll
    for (int j = 0; j < 4; ++j) s += (v[j].x + v[j].y) + (v[j].z + v[j].w);
    mean = wave_sum(s) * (1.f / D); float s2 = 0.f;
#pragma unroll
    for (int j = 0; j < 4; ++j) { const f32x4 d = v[j] - mean; s2 += (d.x * d.x + d.y * d.y) + (d.z * d.z + d.w * d.w); }
    rstd = 1.f / sqrtf(wave_sum(s2) * (1.f / D) + LN_EPS);
}
__device__ __forceinline__ void p1_ln_mod(const Args& a, const Ctx& F) {
    const int gw = F.vcu * NWAVES + F.wave, NGW = F.G * NWAVES; const float* mod = (const float*)(a.ws + WS_MOD); bf16* XN = (bf16*)(a.ws + WS_XN);
    for (int m = gw; m < T; m += NGW) {
        const GAS f32x4* xr = (const GAS f32x4*)(a.x + (size_t)m * D) + F.lane; const float* mb = mod + (size_t)(m >> 11) * 6144;
        f32x4 v[4];
#pragma unroll
        for (int j = 0; j < 4; ++j) v[j] = xr[64 * j];
        float mean, rstd; ln_stats(v, mean, rstd);
        GAS unsigned long long* o8 = (GAS unsigned long long*)(XN + (size_t)m * D) + F.lane;
#pragma unroll
        for (int j = 0; j < 4; ++j) { const f32x4 sc = *(const f32x4*)(mb + 1024 + 4 * F.lane + 256 * j), sh = *(const f32x4*)(mb + 4 * F.lane + 256 * j);
            const f32x4 u = (v[j] - mean) * rstd * (sc + 1.0f) + sh;
            o8[64 * j] = (unsigned long long)pk2(u.x, u.y) | ((unsigned long long)pk2(u.z, u.w) << 32); }
    }
}
__device__ __forceinline__ void p_ln1_rows(const Args& a, const Ctx& F) {
    const int gw = F.vcu * NWAVES + F.wave, NGW = F.G * NWAVES; const float* mod = (const float*)(a.ws + WS_MOD); bf16* XN = (bf16*)(a.ws + WS_XN); float* stats = (float*)(a.ws + WS_STATS);
    for (int m = gw; m < T; m += NGW) {
        GAS f32x4* vr = (GAS f32x4*)(a.out + (size_t)m * D) + F.lane; const float* mb = mod + (size_t)(m >> 11) * 6144;
        f32x4 v[4];
#pragma unroll
        for (int j = 0; j < 4; ++j) v[j] = vr[64 * j];
        float mean, rstd; ln_stats(v, mean, rstd);
#pragma unroll
        for (int j = 0; j < 4; ++j) { const f32x4 lg = *(const f32x4*)(a.ln1_g + 4 * F.lane + 256 * j), lb = *(const f32x4*)(a.ln1_b + 4 * F.lane + 256 * j); v[j] = (v[j] - mean) * rstd * lg + lb; vr[64 * j] = v[j]; }
        ln_stats(v, mean, rstd);
        if (F.lane == 0) { stats[(size_t)m * 2] = mean; stats[(size_t)m * 2 + 1] = rstd; }
        GAS unsigned long long* o8 = (GAS unsigned long long*)(XN + (size_t)m * D) + F.lane;
#pragma unroll
        for (int j = 0; j < 4; ++j) { const f32x4 sc = *(const f32x4*)(mb + 4096 + 4 * F.lane + 256 * j), sh = *(const f32x4*)(mb + 3072 + 4 * F.lane + 256 * j);
            const f32x4 u = (v[j] - mean) * rstd * (sc + 1.0f) + sh;
            o8[64 * j] = (unsigned long long)pk2(u.x, u.y) | ((unsigned long long)pk2(u.z, u.w) << 32); }
    }
}
__device__ __forceinline__ void p3_kidx(const Args& a, const Ctx& F) {
    const float* kiw = (const float*)(a.ws + WS_KIW); bf16* KI = (bf16*)(a.ws + WS_KI); float* WI = (float*)(a.ws + WS_WI);
    const float* cosT = (const float*)(a.ws + WS_ROPE); const float* sinT = cosT + (size_t)T * 8;
    for (int t = F.vcu * 512 + F.tid; t < T; t += F.G * 512) {
        float v[64]; const f32x4* src = (const f32x4*)(kiw + (size_t)t * 128);
#pragma unroll
        for (int i = 0; i < 16; ++i) { const f32x4 q = src[i]; v[4 * i] = q.x; v[4 * i + 1] = q.y; v[4 * i + 2] = q.z; v[4 * i + 3] = q.w; }
        float s = 0.f;
#pragma unroll
        for (int i = 0; i < 64; ++i) s += v[i];
        const float mean = s * (1.f / 64.f); float s2 = 0.f;
#pragma unroll
        for (int i = 0; i < 64; ++i) { const float d = v[i] - mean; s2 += d * d; }
        const float rstd = 1.f / sqrtf(s2 * (1.f / 64.f) + LN_EPS);
#pragma unroll
        for (int i = 0; i < 64; ++i) v[i] = (v[i] - mean) * rstd * a.ikn_g[i] + a.ikn_b[i];
        float o[64];
#pragma unroll
        for (int j = 0; j < 8; ++j) { const float c = cosT[(size_t)t * 8 + j], sn = sinT[(size_t)t * 8 + j]; o[2 * j] = v[j] * c - v[j + 8] * sn; o[2 * j + 1] = v[j + 8] * c + v[j] * sn; }
#pragma unroll
        for (int i = 16; i < 64; ++i) o[i] = v[i];
        v4u* dst = (v4u*)(KI + (size_t)t * 64);
#pragma unroll
        for (int i = 0; i < 8; ++i) { v4u w; w.x = pk2(o[8 * i], o[8 * i + 1]); w.y = pk2(o[8 * i + 2], o[8 * i + 3]); w.z = pk2(o[8 * i + 4], o[8 * i + 5]); w.w = pk2(o[8 * i + 6], o[8 * i + 7]); dst[i] = w; }
        const f32x4 w0 = src[16], w1 = src[17]; const float ws_ = 0.35355339059327373f * 0.125f;
        *(f32x4*)(WI + (size_t)t * 8) = w0 * ws_; *(f32x4*)(WI + (size_t)t * 8 + 4) = w1 * ws_;
    }
}

__device__ __forceinline__ unsigned fkey(float v) { unsigned u = __float_as_uint(v); if (v == 0.f) u = 0u; return (u & 0x80000000u) ? ~u : (u | 0x80000000u); }
__device__ __forceinline__ void idx_unit(const Args& a, const Ctx& F, int b, int c, int sub) {
    const bf16* QI = (const bf16*)(a.ws + WS_QI); const bf16* KI = (const bf16*)(a.ws + WS_KI); const float* WI = (const float*)(a.ws + WS_WI);
    unsigned long long* SEL = (unsigned long long*)(a.ws + WS_SEL);
    const int t0 = b * SEQ + c * 64 + sub * 16, L = 64 * (c + 1), lane = F.lane, wid = F.wave;
    if (c < 4) {
        if (F.tid < 16 * 32) { const int r = F.tid >> 5, w = F.tid & 31; const int lo = 64 * w; unsigned long long m = 0ull;
            if (lo + 64 <= L) m = ~0ull; SEL[(size_t)(t0 + r) * 32 + w] = m; }
        return;
    }
    LAS float* Ssc = (LAS float*)F.lds;
    const int r32 = lane & 31, hi = lane >> 5;
    bf16x8 af[4][4]; float wv[4][16];
#pragma unroll
    for (int rb = 0; rb < 4; ++rb) { const int tl = r32 >> 3, h = r32 & 7; const bf16* qrow = QI + (size_t)(t0 + 4 * rb + tl) * 512 + h * 64 + hi * 8;
#pragma unroll
        for (int s = 0; s < 4; ++s) af[rb][s] = *(const bf16x8*)(qrow + 16 * s);
#pragma unroll
        for (int i = 0; i < 16; ++i) wv[rb][i] = WI[(size_t)(t0 + 4 * rb + (i >> 2)) * 8 + 4 * hi + (i & 3)]; }
    const int nkt = L >> 5;
    for (int kt = wid; kt < nkt; kt += 8) {
        const bf16* krow = KI + (size_t)(b * SEQ + 32 * kt + r32) * 64 + hi * 8; bf16x8 bfr[4];
#pragma unroll
        for (int s = 0; s < 4; ++s) bfr[s] = *(const bf16x8*)(krow + 16 * s);
#pragma unroll
        for (int rb = 0; rb < 4; ++rb) { f32x16 acc = f32x16{};
#pragma unroll
            for (int s = 0; s < 4; ++s) acc = __builtin_amdgcn_mfma_f32_32x32x16_bf16(af[rb][s], bfr[s], acc, 0, 0, 0);
            float p[4];
#pragma unroll
            for (int g = 0; g < 4; ++g) { float q = 0.f;
#pragma unroll
                for (int i = 0; i < 4; ++i) q += wv[rb][4 * g + i] * __builtin_fmaxf(acc[4 * g + i], 0.f);
                p[g] = q; }
#pragma unroll
            for (int g = 0; g < 4; ++g) { auto rr = __builtin_amdgcn_permlane32_swap(__float_as_uint(p[g]), __float_as_uint(p[g]), false, false); p[g] = __uint_as_float(rr[0]) + __uint_as_float(rr[1]); }
            const float s0 = hi ? p[2] : p[0], s1 = hi ? p[3] : p[1];
            Ssc[(4 * rb + 2 * hi) * 2048 + 32 * kt + r32] = s0; Ssc[(4 * rb + 2 * hi + 1) * 2048 + 32 * kt + r32] = s1; }
    }
    LDS_WAIT(); __syncthreads();
    const int n = L >> 6;
    for (int rr_ = 0; rr_ < 2; ++rr_) { const int row = 2 * wid + rr_;
        unsigned key[32];
#pragma unroll
        for (int i = 0; i < 32; ++i) key[i] = (i < n) ? fkey(Ssc[row * 2048 + 64 * i + lane]) : 0u;
        unsigned Tk = 0u;
        for (int bit = 31; bit >= 0; --bit) { const unsigned cand = Tk | (1u << bit); int cnt = 0;
#pragma unroll
            for (int i = 0; i < 32; ++i) cnt += __builtin_popcountll(__ballot(key[i] >= cand));
            if (cnt >= 256) Tk = cand; }
        int cgt = 0;
#pragma unroll
        for (int i = 0; i < 32; ++i) cgt += __builtin_popcountll(__ballot(key[i] > Tk));
        const int need = 256 - cgt; int taken = 0; unsigned long long myw = 0ull;
#pragma unroll
        for (int i = 0; i < 32; ++i) { const bool eq = key[i] == Tk; const unsigned long long em = __ballot(eq);
            const int rank = (int)__builtin_amdgcn_mbcnt_hi((unsigned)(em >> 32), __builtin_amdgcn_mbcnt_lo((unsigned)em, 0u));
            const bool s = (key[i] > Tk) || (eq && (taken + rank < need)); const unsigned long long w = __ballot(s);
            taken += __builtin_popcountll(em); if (lane == i) myw = w; }
        if (lane < 32) SEL[(size_t)(t0 + row) * 32 + lane] = myw;
    }
    LDS_WAIT(); __syncthreads();
}

__device__ __forceinline__ void router_unit(const Args& a, const Ctx& F, int tb) {
    const float* X1 = a.out; const float* stats = (const float*)(a.ws + WS_STATS); const float* mod = (const float*)(a.ws + WS_MOD);
    unsigned* ctl = (unsigned*)(a.ws + WS_CTL); unsigned* ER = (unsigned*)(a.ws + WS_TAB + TAB_ER); float* RW = (float*)(a.ws + WS_TAB + TAB_W); unsigned short* LIST = (unsigned short*)(a.ws + WS_TAB + TAB_LIST);
    const int t0 = tb * 64, b = t0 >> 11, lane = F.lane, wid = F.wave, tid = F.tid;
    LAS float* U = (LAS float*)F.lds;
    LAS float* Wc = (LAS float*)(F.lds + 33792);
    LAS float* Lg = (LAS float*)(F.lds + 33792 + 32768);
    const float* mb = mod + (size_t)b * 6144;
    const int rh = wid & 1, eh = (wid >> 1) & 1, kh = wid >> 2, r32 = lane & 31, kk = lane >> 5;
    f32x16 acc = f32x16{};
    const int urow = tid >> 3, ucol = (tid & 7) * 16; const f32x2 st = *(const f32x2*)(stats + (size_t)(t0 + urow) * 2);
    for (int kc = 0; kc < 8; ++kc) {
        const int k0 = kc * 128;
#pragma unroll
        for (int q = 0; q < 4; ++q) { const int k = k0 + ucol + 4 * q; const f32x4 xv = *(const f32x4*)(X1 + (size_t)(t0 + urow) * 1024 + k);
            const f32x4 sc = *(const f32x4*)(mb + 4096 + k), sh = *(const f32x4*)(mb + 3072 + k); const f32x4 u = (xv - st.x) * st.y * (sc + 1.0f) + sh;
            LAS float* d = U + urow * 129 + ucol + 4 * q; d[0] = u.x; d[1] = u.y; d[2] = u.z; d[3] = u.w; }
#pragma unroll
        for (int q = 0; q < 4; ++q) { const int idx = tid * 16 + 4 * q; *(LAS f32x4*)(Wc + idx) = *(const f32x4*)(a.w_router + (size_t)k0 * 64 + idx); }
        LDS_WAIT(); __syncthreads();
#pragma unroll 8
        for (int s = 0; s < 32; ++s) { const int k = kh * 64 + 2 * s + kk;
            acc = __builtin_amdgcn_mfma_f32_32x32x2f32(U[(rh * 32 + r32) * 129 + k], Wc[k * 64 + eh * 32 + r32], acc, 0, 0, 0); }
        LDS_WAIT(); __syncthreads();
    }
#pragma unroll
    for (int i = 0; i < 16; ++i) { const int row = (i & 3) + 8 * (i >> 2) + 4 * kk; Lg[(kh * 64 + rh * 32 + row) * 65 + eh * 32 + r32] = acc[i]; }
    LDS_WAIT(); __syncthreads();
    for (int j = 0; j < 8; ++j) { const int tl = wid * 8 + j, t = t0 + tl; const int e = lane;
        const float logit = Lg[tl * 65 + e] + Lg[(64 + tl) * 65 + e];
        const float aff = 1.0f / (1.0f + __expf(-logit)); const float bsd = aff + a.router_bias[e];
        float m1 = bsd; m1 = __builtin_fmaxf(m1, __shfl_xor(m1, 1)); m1 = __builtin_fmaxf(m1, __shfl_xor(m1, 2)); m1 = __builtin_fmaxf(m1, __shfl_xor(m1, 4));
        const unsigned long long em = __ballot(bsd == m1); const int g = e >> 3; const unsigned gm = (unsigned)(em >> (8 * g)) & 0xffu; const int first = 8 * g + __builtin_ctz(gm);
        float m2 = (e == first) ? -INFINITY : bsd; m2 = __builtin_fmaxf(m2, __shfl_xor(m2, 1)); m2 = __builtin_fmaxf(m2, __shfl_xor(m2, 2)); m2 = __builtin_fmaxf(m2, __shfl_xor(m2, 4));
        const float gs = m1 + m2; int grank = 0;
#pragma unroll
        for (int g2 = 0; g2 < 8; ++g2) { const float s2 = __uint_as_float(__builtin_amdgcn_readlane(__float_as_uint(gs), 8 * g2)); grank += (s2 > gs || (s2 == gs && g2 < g)) ? 1 : 0; }
        const bool gsel = grank < 4; const float mv = gsel ? bsd : -INFINITY; int rk = 0;
#pragma unroll
        for (int e2 = 0; e2 < 64; ++e2) { const float v = __uint_as_float(__builtin_amdgcn_readlane(__float_as_uint(mv), e2)); rk += (v > mv || (v == mv && e2 < e)) ? 1 : 0; }
        const bool sel = gsel && rk < 8; const float sa = wave_sum(sel ? aff : 0.f);
        if (sel) { const int chunk = t / CHTOK, tk = t - chunk * CHTOK;
            const unsigned r = __hip_atomic_fetch_add(ctl + CW_CNT + (chunk * 64 + e) * 16, 1u, RLX_AGENT);
            ER[(size_t)t * 8 + rk] = ((unsigned)e << 16) | r; RW[(size_t)t * 8 + rk] = aff / sa;
            LIST[((size_t)chunk * 64 + e) * 8192 + r] = (unsigned short)((tk << 3) | rk); }
    }
    LDS_WAIT(); __syncthreads();
}

__device__ __forceinline__ void combine_rows(const Args& a, const Ctx& F, int chunk, const LAS int* xt) {
    const int gw = F.vcu * NWAVES + F.wave, NGW = F.G * NWAVES; const float* mod = (const float*)(a.ws + WS_MOD); const bf16* Y = (const bf16*)(a.ws + WS_YEXP);
    const unsigned* ER = (const unsigned*)(a.ws + WS_TAB + TAB_ER);
    for (int m = chunk * CHTOK + gw; m < (chunk + 1) * CHTOK; m += NGW) {
        GAS f32x4* zr = (GAS f32x4*)(a.out + (size_t)m * D) + F.lane; const float* g2 = mod + (size_t)(m >> 11) * 6144 + 5120;
        f32x4 y[4];
#pragma unroll
        for (int j = 0; j < 4; ++j) y[j] = (f32x4){0.f, 0.f, 0.f, 0.f};
#pragma unroll
        for (int s = 0; s < 8; ++s) { const unsigned er = ER[(size_t)m * 8 + s]; const int pos = xt[144 + (int)(er >> 16)] + (int)(er & 0xffffu);
            const v2u* yr = (const v2u*)(Y + (size_t)pos * 1024) + F.lane;
#pragma unroll
            for (int j = 0; j < 4; ++j) { const v2u w = yr[64 * j]; y[j].x += bflo(w.x); y[j].y += bfhi(w.x); y[j].z += bflo(w.y); y[j].w += bfhi(w.y); } }
        f32x4 v[4];
#pragma unroll
        for (int j = 0; j < 4; ++j) { const f32x4 g = *(const f32x4*)(g2 + 4 * F.lane + 256 * j); v[j] = zr[64 * j] + g * y[j]; }
        float mean, rstd; ln_stats(v, mean, rstd);
#pragma unroll
        for (int j = 0; j < 4; ++j) { const f32x4 lg = *(const f32x4*)(a.ln2_g + 4 * F.lane + 256 * j), lb = *(const f32x4*)(a.ln2_b + 4 * F.lane + 256 * j);
            zr[64 * j] = (v[j] - mean) * rstd * lg + lb; }
    }
}
#ifndef MK_N_LAUNCHES
#define MK_N_LAUNCHES 1
#endif
__global__ void __launch_bounds__(NWAVES * 64, 2) mk_fwd(Args a) {
    extern __shared__ __attribute__((aligned(16))) unsigned char lds[];
    Ctx F; F.lds = (LAS unsigned char*)lds; F.tid = threadIdx.x; F.lane = F.tid & 63; F.wave = __builtin_amdgcn_readfirstlane(F.tid >> 6);
    F.G = gridDim.x; { const int bx = blockIdx.x; F.vcu = (F.G % 8 == 0) ? (bx % 8) * (F.G / 8) + bx / 8 : bx; }
    volatile LAS unsigned* MISC = (volatile LAS unsigned*)(F.lds + MISC_OFF);
    LAS int* xt = (LAS int*)(F.lds + XTAB_OFF);
    unsigned char* ws = a.ws; unsigned* ctl = (unsigned*)(ws + WS_CTL);
    for (int u = F.tid; u < (LDS_BYTES - LDSCTL_OFF) / 4; u += NWAVES * 64) ((LAS unsigned*)(F.lds + LDSCTL_OFF))[u] = 0u;
    __syncthreads();
    const int lo = a.ph_lo, hi = a.ph_hi;
    XcdBarrier bar; bar.bar = ctl + CW_BAR; bar.x = 0; bar.st = nullptr;
    if (hi - lo > 1) bar = xcd_barrier_post(ctl + CW_BAR, MISC + 8);
#ifndef PHM
#define PHM 0xffff
#endif
#define IN(k) (((PHM >> (k)) & 1) && lo <= (k) && (k) < hi)
#define SEAM(k) do { if (IN(k) && IN((k) + 1)) xcd_barrier(bar); { int t_ = threadIdx.x; asm volatile("" : "+v"(t_)); F.tid = t_; F.lane = t_ & 63; F.wave = __builtin_amdgcn_readfirstlane(t_ >> 6); } } while (0)
    const float* mod = (const float*)(ws + WS_MOD);
    bf16* XN = (bf16*)(ws + WS_XN);

    if (IN(0)) { p0_prologue(a, F); } SEAM(0);
    if (IN(1)) { p1_ln_mod(a, F); } SEAM(1);
    if (IN(2)) {
        pg8::Gemm g{XN, 1024}; pg8::DenseOrder S; S.init(T, DINP, 1024, ws + WS_WIN, F.G, (int)blockIdx.x);
        EpiInProj E{ws, (bf16*)a.out, (const float*)(ws + WS_ROPE), (const float*)(ws + WS_ROPE) + (size_t)T * 8};
        pg8::gemm_phase<EpiInProj, pg8::DenseOrder, true>(F.lds + RING_OFF, g, S, E);
    } SEAM(2);
    if (IN(3)) { p3_kidx(a, F); } SEAM(3);
    if (IN(4)) {
        if (!(a.flags & 1)) for (int uix = F.vcu; uix < 1024; uix += F.G) { const int r = uix >> 8, w = uix & 255, b = w >> 5, i = w & 31; idx_unit(a, F, b, r < 2 ? i : 31 - i, r); }
        __syncthreads();
        if (!(a.flags & 2)) for (int uix = F.vcu; uix < 512; uix += F.G) { const int r = uix >> 8, w = uix & 255, bh = w >> 2, s = w & 3; const int qb = s == 0 ? (r ? 2 : 0) : s == 1 ? (r ? 3 : 1) : s == 2 ? (r ? 5 : 4) : (r ? 7 : 6);
            attn_body::attn_unit<0, 8>(bh >> 3, bh & 7, qb, (const attn_body::bf16*)(ws + WS_QA), (const attn_body::bf16*)(ws + WS_KA), (const attn_body::bf16*)(ws + WS_VA), (attn_body::bf16*)(ws + WS_QA), a.rel_bias, (char*)lds + RING_OFF); }
    } SEAM(4);
    if (IN(5)) {
        for (int uix = F.vcu; uix < 512; uix += F.G) { const int r = uix >> 8, w = uix & 255, bh = w >> 2, s = w & 3; const int qb = r ? 7 - s : s;
            attn_body::attn_unit<1, 8>(bh >> 3, bh & 7, qb, (const attn_body::bf16*)(ws + WS_QB), (const attn_body::bf16*)(ws + WS_KB), (const attn_body::bf16*)(ws + WS_VB), (attn_body::bf16*)(ws + WS_QB), ws + WS_SEL, (char*)lds + RING_OFF); }
    } SEAM(5);
    if (IN(6)) {
        { pg8::Gemm g{(const bf16*)(ws + WS_QA), 512}; pg8::DenseOrder S; S.init(T, 1024, 512, ws + WS_WA, F.G, (int)blockIdx.x);
          EpiGate<1> E{(const bf16*)a.out, (float*)(ws + WS_TMP), (bf16*)(ws + WS_MERGED)}; pg8::gemm_phase<EpiGate<1>, pg8::DenseOrder, true>(F.lds + RING_OFF, g, S, E); }
        VM_WAIT(); __syncthreads();
        { pg8::Gemm g{(const bf16*)(ws + WS_QB), 512}; pg8::DenseOrder S; S.init(T, 1024, 512, ws + WS_WB, F.G, (int)blockIdx.x);
          EpiGate<2> E{(const bf16*)a.out, (float*)(ws + WS_TMP), (bf16*)(ws + WS_MERGED)}; pg8::gemm_phase<EpiGate<2>, pg8::DenseOrder, true>(F.lds + RING_OFF, g, S, E); }
    } SEAM(6);
    if (IN(7)) {
        pg8::Gemm g{(const bf16*)(ws + WS_MERGED), 1024}; pg8::DenseOrder S; S.init(T, 1024, 1024, ws + WS_WOUT, F.G, (int)blockIdx.x);
        EpiResid E{a.x, a.out, mod}; pg8::gemm_phase<EpiResid, pg8::DenseOrder, true>(F.lds + RING_OFF, g, S, E);
    } SEAM(7);
    if (IN(8)) { p_ln1_rows(a, F); } SEAM(8);
    if (IN(9)) {
        for (int tb = F.vcu; tb < T / 64; tb += F.G) router_unit(a, F, tb);
        __syncthreads();
        pg8::Gemm g{XN, 1024}; pg8::DenseOrder S; S.init(T, 512, 1024, ws + WS_SHGU, F.G, (int)blockIdx.x);
        EpiSilu E{(bf16*)(ws + WS_HSH)}; pg8::gemm_phase<EpiSilu, pg8::DenseOrder, true>(F.lds + RING_OFF, g, S, E);
    } SEAM(9);
#pragma unroll 1
    for (int ch = 0; ch < NCHUNK; ++ch) {
        const int pgu = 10 + 2 * ch, pd = 11 + 2 * ch;
        if (IN(pgu)) {
            if (ch > 0) { build_xtab(xt, ctl, ch - 1); combine_rows(a, F, ch - 1, xt); __syncthreads(); }
            build_xtab(xt, ctl, ch);
            { pg8::Gemm g{XN, 1024}; ExpertOrder<0> S{xt, 2, F.G, F.vcu, __builtin_amdgcn_readfirstlane(xt[64]), ch, (const unsigned short*)(ws + WS_TAB + TAB_LIST) + (size_t)ch * 64 * 8192, (const char*)(ws + WS_EGU), (size_t)512 * 1024 * 2, (size_t)256 * 1024 * 2};
              EpiExpGU E{(bf16*)(ws + WS_HEXP), xt, (const unsigned short*)(ws + WS_TAB + TAB_LIST) + (size_t)ch * 64 * 8192, (const float*)(ws + WS_TAB + TAB_W), ch};
              pg8::gemm_phase<EpiExpGU, ExpertOrder<0>, true>(F.lds + RING_OFF, g, S, E); }
            if (ch == 0) { VM_WAIT(); __syncthreads();
              pg8::Gemm g{(const bf16*)(ws + WS_HSH), 256}; pg8::DenseOrder S; S.init(T, 1024, 256, ws + WS_SHD, F.G, (int)blockIdx.x);
              EpiShD E{a.out, mod}; pg8::gemm_phase<EpiShD, pg8::DenseOrder, true>(F.lds + RING_OFF, g, S, E); }
        } SEAM(pgu);
        if (IN(pd)) {
            build_xtab(xt, ctl, ch);
            pg8::Gemm g{(const bf16*)(ws + WS_HEXP), 256}; ExpertOrder<1> S{xt, 4, F.G, F.vcu, __builtin_amdgcn_readfirstlane(xt[64]), ch, nullptr, (const char*)(ws + WS_ED), (size_t)1024 * 256 * 2, (size_t)256 * 256 * 2};
            EpiExpD E{(bf16*)(ws + WS_YEXP), xt}; pg8::gemm_phase<EpiExpD, ExpertOrder<1>, true>(F.lds + RING_OFF, g, S, E);
        } SEAM(pd);
    }
    if (IN(14)) { build_xtab(xt, ctl, NCHUNK - 1); combine_rows(a, F, NCHUNK - 1, xt); }
#undef IN
#undef SEAM
}
#if MK_NAIVE_MASK
__device__ __forceinline__ float dot_bf16(const bf16* a, const bf16* b, int K) {
    float s = 0.f;
    for (int k = 0; k < K; k += 8) { const v4u x = *(const v4u*)(a + k), y = *(const v4u*)(b + k);
        s += bflo(x.x) * bflo(y.x) + bfhi(x.x) * bfhi(y.x) + bflo(x.y) * bflo(y.y) + bfhi(x.y) * bfhi(y.y) + bflo(x.z) * bflo(y.z) + bfhi(x.z) * bfhi(y.z) + bflo(x.w) * bflo(y.w) + bfhi(x.w) * bfhi(y.w); }
    return s;
}
__device__ __forceinline__ void st2bf(bf16* p, float a, float b) { *(unsigned*)p = pk2(a, b); }
__global__ void __launch_bounds__(256) nv_inproj(Args a) {
    unsigned char* ws = a.ws; const int row = blockIdx.y, col = 2 * (blockIdx.x * 256 + threadIdx.x); if (col >= DINP) return;
    const bf16* xr = (const bf16*)(ws + WS_XN) + (size_t)row * 1024; const bf16* w = (const bf16*)(ws + WS_WIN) + (size_t)col * 1024;
    float v0 = dot_bf16(xr, w, 1024), v1 = dot_bf16(xr, w + 1024, 1024);
    const float* cosT = (const float*)(ws + WS_ROPE); const float* sinT = cosT + (size_t)T * 8;
    if (col < 3584) { const int seg = col >> 9, cc = col & 511; size_t off; float sc = 1.f; bool rope = false;
        if (seg < 6) { off = seg == 0 ? WS_QA : seg == 1 ? WS_KA : seg == 2 ? WS_VA : seg == 3 ? WS_QB : seg == 4 ? WS_KB : WS_VB; sc = (seg == 0 || seg == 3) ? attn_body::C2 : 1.f; rope = (seg == 3 || seg == 4); }
        else { off = WS_QI; rope = true; }
        const int p = cc & 63;
        if (rope && p < 16) { const float c = cosT[(size_t)row * 8 + (p >> 1)], s = sinT[(size_t)row * 8 + (p >> 1)]; const float o0 = v0 * c - v1 * s, o1 = v1 * c + v0 * s; v0 = o0; v1 = o1; }
        st2bf((bf16*)(ws + off) + (size_t)row * 512 + cc, v0 * sc, v1 * sc);
    } else if (col < 3840) { float* kiw = (float*)(ws + WS_KIW); const int cc = col - 3584; if (cc < 128) { kiw[(size_t)row * 128 + cc] = v0; kiw[(size_t)row * 128 + cc + 1] = v1; } }
    else { st2bf((bf16*)a.out + (size_t)row * 2048 + (col - 3840), sigmoidf_(v0), sigmoidf_(v1)); }
}
__global__ void __launch_bounds__(256) nv_index(Args a) {
    __shared__ float sc[2048]; __shared__ float q[512]; __shared__ float w8[8];
    unsigned char* ws = a.ws; const int t = blockIdx.x, b = t >> 11, tq = t & 2047, L = ((tq >> 6) + 1) * 64, tid = threadIdx.x;
    const bf16* QI = (const bf16*)(ws + WS_QI) + (size_t)t * 512; const bf16* KI = (const bf16*)(ws + WS_KI) + (size_t)b * SEQ * 64; const float* WI = (const float*)(ws + WS_WI) + (size_t)t * 8;
    unsigned long long* SEL = (unsigned long long*)(ws + WS_SEL) + (size_t)t * 32;
    q[tid] = bf2f(QI[tid]); q[tid + 256] = bf2f(QI[tid + 256]); if (tid < 8) w8[tid] = WI[tid];
    __syncthreads();
    for (int s = tid; s < L; s += 256) { const bf16* kr = KI + (size_t)s * 64; float kf[64];
#pragma unroll
        for (int d = 0; d < 64; ++d) kf[d] = bf2f(kr[d]);
        float tot = 0.f;
#pragma unroll
        for (int h = 0; h < 8; ++h) { float dsum = 0.f;
#pragma unroll
            for (int d = 0; d < 64; ++d) dsum += q[h * 64 + d] * kf[d];
            tot += w8[h] * fmaxf(dsum, 0.f); }
        sc[s] = tot; }
    __syncthreads();
    for (int s0 = 0; s0 < 2048; s0 += 256) { const int s = s0 + tid; bool sel = false;
        if (s < L) { if (L <= 256) sel = true; else { const float v = sc[s]; int rank = 0; for (int s2 = 0; s2 < L; ++s2) { const float v2 = sc[s2]; rank += (v2 > v || (v2 == v && s2 < s)) ? 1 : 0; } sel = rank < 256; } }
        const unsigned long long m = __ballot(sel); if ((tid & 63) == 0) SEL[s >> 6] = m; }
}
template <int MODE> __global__ void __launch_bounds__(256) nv_attn(Args a) {
    unsigned char* ws = a.ws; const int gw = blockIdx.x * 4 + (threadIdx.x >> 6), lane = threadIdx.x & 63; const int t = gw >> 3, h = gw & 7, b = t >> 11, tq = t & 2047, c = tq >> 6;
    const bf16* Q = (const bf16*)(ws + (MODE == 0 ? WS_QA : WS_QB)) + (size_t)t * 512 + h * 64;
    const bf16* K = (const bf16*)(ws + (MODE == 0 ? WS_KA : WS_KB)) + (size_t)b * SEQ * 512 + h * 64; const bf16* V = (const bf16*)(ws + (MODE == 0 ? WS_VA : WS_VB)) + (size_t)b * SEQ * 512 + h * 64;
    bf16* O = (bf16*)(ws + WS_NVO) + (size_t)(MODE == 0 ? 0 : (size_t)T * 512) + (size_t)t * 512 + h * 64;
    const unsigned long long* SEL = (const unsigned long long*)(ws + WS_SEL) + (size_t)t * 32;
    float qf[64];
#pragma unroll
    for (int d = 0; d < 64; ++d) qf[d] = bf2f(Q[d]);
    float m = -INFINITY, l = 0.f, o = 0.f;
    const int j0 = (MODE == 0) ? (c - 8 > 0 ? c - 8 : 0) : 0;
    for (int j = j0; j <= c; ++j) { const int s = 64 * j + lane; const bf16* kr = K + (size_t)s * 512; float sc = 0.f;
#pragma unroll
        for (int d = 0; d < 64; ++d) sc += qf[d] * bf2f(kr[d]);
        bool ok = true;
        if (MODE == 0) { int rel = tq - s; rel = rel > 128 ? 128 : (rel < -128 ? -128 : rel); sc += a.rel_bias[h * 257 + rel + 128] * LOG2E; }
        else ok = (SEL[j] >> lane) & 1ull;
        if (!ok) sc = -INFINITY;
        float tm = sc;
#pragma unroll
        for (int x = 1; x < 64; x <<= 1) tm = fmaxf(tm, __shfl_xor(tm, x));
        if (tm == -INFINITY) continue;
        const float mn = fmaxf(m, tm), f = exp2f(m - mn), p = exp2f(sc - mn);
        l = l * f + wave_sum(p); o *= f;
        for (int k2 = 0; k2 < 64; ++k2) { const float pk = __shfl(p, k2); o += pk * bf2f(V[(size_t)(64 * j + k2) * 512 + lane]); }
        m = mn; }
    O[lane] = (bf16)f2bf(o / l);
}
__global__ void __launch_bounds__(256) nv_copy_o(Args a, int which) {
    unsigned char* ws = a.ws; const size_t i = (size_t)blockIdx.x * 256 + threadIdx.x; const v4u* src = (const v4u*)(ws + WS_NVO);
    if (i < (size_t)T * 512 * 2 / 16) { if (which == 0) ((v4u*)(ws + WS_QA))[i] = src[i]; else ((v4u*)(ws + WS_QB))[i] = src[i + (size_t)T * 512 * 2 / 16]; }
}
__global__ void __launch_bounds__(256) nv_merge(Args a) {
    unsigned char* ws = a.ws; const int row = blockIdx.y, col = 2 * (blockIdx.x * 256 + threadIdx.x);
    const bf16* oa = (const bf16*)(ws + WS_QA) + (size_t)row * 512; const bf16* ob = (const bf16*)(ws + WS_QB) + (size_t)row * 512;
    const bf16* wa = (const bf16*)(ws + WS_WA) + (size_t)col * 512; const bf16* wb = (const bf16*)(ws + WS_WB) + (size_t)col * 512; const bf16* g = (const bf16*)a.out + (size_t)row * 2048;
    const float m0 = bf2f(g[col]) * dot_bf16(oa, wa, 512) + bf2f(g[1024 + col]) * dot_bf16(ob, wb, 512), m1 = bf2f(g[col + 1]) * dot_bf16(oa, wa + 512, 512) + bf2f(g[1024 + col + 1]) * dot_bf16(ob, wb + 512, 512);
    st2bf((bf16*)(ws + WS_MERGED) + (size_t)row * 1024 + col, m0, m1);
}
__global__ void __launch_bounds__(256) nv_outproj(Args a) {
    unsigned char* ws = a.ws; const int row = blockIdx.y, col = 2 * (blockIdx.x * 256 + threadIdx.x);
    const bf16* mr = (const bf16*)(ws + WS_MERGED) + (size_t)row * 1024; const bf16* w = (const bf16*)(ws + WS_WOUT) + (size_t)col * 1024; float* tmp = (float*)(ws + WS_TMP) + (size_t)row * 1024;
    tmp[col] = dot_bf16(mr, w, 1024); tmp[col + 1] = dot_bf16(mr, w + 1024, 1024);
}
__global__ void __launch_bounds__(256) nv_ln1(Args a) {
    unsigned char* ws = a.ws; const int m = blockIdx.x * 4 + (threadIdx.x >> 6), lane = threadIdx.x & 63; const float* mb = (const float*)(ws + WS_MOD) + (size_t)(m >> 11) * 6144;
    const f32x4* xr = (const f32x4*)(a.x + (size_t)m * D) + lane; const f32x4* tr = (const f32x4*)((const float*)(ws + WS_TMP) + (size_t)m * D) + lane; f32x4 v[4];
#pragma unroll
    for (int j = 0; j < 4; ++j) { const f32x4 g1 = *(const f32x4*)(mb + 2048 + 4 * lane + 256 * j); v[j] = xr[64 * j] * DN_ALPHA + g1 * tr[64 * j]; }
    float mean, rstd; ln_stats(v, mean, rstd);
#pragma unroll
    for (int j = 0; j < 4; ++j) { const f32x4 lg = *(const f32x4*)(a.ln1_g + 4 * lane + 256 * j), lb = *(const f32x4*)(a.ln1_b + 4 * lane + 256 * j); v[j] = (v[j] - mean) * rstd * lg + lb; ((f32x4*)(a.out + (size_t)m * D) + lane)[64 * j] = v[j]; }
    ln_stats(v, mean, rstd); if (lane == 0) { float* st = (float*)(ws + WS_STATS) + (size_t)m * 2; st[0] = mean; st[1] = rstd; }
    unsigned long long* o8 = (unsigned long long*)((bf16*)(ws + WS_XN) + (size_t)m * D) + lane;
#pragma unroll
    for (int j = 0; j < 4; ++j) { const f32x4 sc = *(const f32x4*)(mb + 4096 + 4 * lane + 256 * j), sh = *(const f32x4*)(mb + 3072 + 4 * lane + 256 * j); const f32x4 u = (v[j] - mean) * rstd * (sc + 1.0f) + sh;
        o8[64 * j] = (unsigned long long)pk2(u.x, u.y) | ((unsigned long long)pk2(u.z, u.w) << 32); }
}
__global__ void __launch_bounds__(256) nv_shgu(Args a) {
    unsigned char* ws = a.ws; const int row = blockIdx.y, j = threadIdx.x; const bf16* xr = (const bf16*)(ws + WS_XN) + (size_t)row * 1024; const bf16* w = (const bf16*)(ws + WS_SHGU) + (size_t)(2 * j) * 1024;
    ((bf16*)(ws + WS_HSH))[(size_t)row * 256 + j] = (bf16)f2bf(silu_mul(dot_bf16(xr, w, 1024), dot_bf16(xr, w + 1024, 1024)));
}
__global__ void __launch_bounds__(256) nv_expgu(Args a) {
    unsigned char* ws = a.ws; const int rs = blockIdx.x, t = rs >> 3, j = threadIdx.x; const unsigned er = ((const unsigned*)(ws + WS_TAB + TAB_ER))[rs]; const int e = er >> 16; const float wgt = ((const float*)(ws + WS_TAB + TAB_W))[rs];
    const bf16* xr = (const bf16*)(ws + WS_XN) + (size_t)t * 1024; const bf16* w = (const bf16*)(ws + WS_EGU) + ((size_t)e * 512 + 2 * j) * 1024;
    ((bf16*)(ws + WS_YEXP))[(size_t)rs * 256 + j] = (bf16)f2bf(wgt * silu_mul(dot_bf16(xr, w, 1024), dot_bf16(xr, w + 1024, 1024)));
}
__global__ void __launch_bounds__(256) nv_down(Args a) {
    unsigned char* ws = a.ws; const int t = blockIdx.y, col = blockIdx.x * 256 + threadIdx.x; const float* mb = (const float*)(ws + WS_MOD) + (size_t)(t >> 11) * 6144;
    float y = dot_bf16((const bf16*)(ws + WS_HSH) + (size_t)t * 256, (const bf16*)(ws + WS_SHD) + (size_t)col * 256, 256);
    for (int s = 0; s < 8; ++s) { const int e = ((const unsigned*)(ws + WS_TAB + TAB_ER))[t * 8 + s] >> 16;
        y += dot_bf16((const bf16*)(ws + WS_YEXP) + (size_t)(t * 8 + s) * 256, (const bf16*)(ws + WS_ED) + ((size_t)e * 1024 + col) * 256, 256); }
    float* z = a.out + (size_t)t * 1024 + col; *z = *z * DN_ALPHA + mb[5120 + col] * y;
}
__global__ void __launch_bounds__(256) nv_ln2(Args a) {
    const int m = blockIdx.x * 4 + (threadIdx.x >> 6), lane = threadIdx.x & 63; f32x4* zr = (f32x4*)(a.out + (size_t)m * D) + lane; f32x4 v[4];
#pragma unroll
    for (int j = 0; j < 4; ++j) v[j] = zr[64 * j];
    float mean, rstd; ln_stats(v, mean, rstd);
#pragma unroll
    for (int j = 0; j < 4; ++j) { const f32x4 lg = *(const f32x4*)(a.ln2_g + 4 * lane + 256 * j), lb = *(const f32x4*)(a.ln2_b + 4 * lane + 256 * j); zr[64 * j] = (v[j] - mean) * rstd * lg + lb; }
}
#endif
extern "C" void kernel_launch(void* const* d_in, const int* in_sizes, int n_in, void* d_out, int out_size, void* d_ws, size_t ws_size, hipStream_t stream) {
    static int grid = 0;
    if (grid == 0) {
        if (n_in != 24 || in_sizes[0] != T * D || out_size != T * D || ws_size < WS_END) { fprintf(stderr, "kernel_launch: unexpected shapes (n_in %d, in0 %d, out %d, ws %zu, need %zu); nothing launched\n", n_in, n_in > 0 ? in_sizes[0] : -1, out_size, ws_size, (size_t)WS_END); grid = -1; return; }
        int dev = 0, cus = 0, per_cu = 0;
        if (hipGetDevice(&dev) != hipSuccess || hipDeviceGetAttribute(&cus, hipDeviceAttributeMultiprocessorCount, dev) != hipSuccess) { grid = -1; return; }
        if (hipFuncSetAttribute((const void*)mk_fwd, hipFuncAttributeMaxDynamicSharedMemorySize, LDS_BYTES) != hipSuccess) { fprintf(stderr, "kernel_launch: hipFuncSetAttribute failed\n"); grid = -1; return; }
        if (hipOccupancyMaxActiveBlocksPerMultiprocessor(&per_cu, (const void*)mk_fwd, NWAVES * 64, LDS_BYTES) != hipSuccess || per_cu < 1) { fprintf(stderr, "kernel_launch: occupancy query reports %d\n", per_cu); per_cu = 1; }
        (void)hipGetLastError();
        grid = cus * 1;
        if (grid != 256) fprintf(stderr, "kernel_launch: %d CUs; this kernel is built for 256\n", grid);
    }
    if (grid < 0) return;
    (void)hipMemsetAsync((char*)d_ws + WS_CTL, 0, CTL_ZERO_BYTES, stream);
    Args a{};
    a.x = (const float*)d_in[0]; a.c = (const float*)d_in[1]; a.positions = (const int*)d_in[2]; a.w_ada = (const float*)d_in[3]; a.b_ada = (const float*)d_in[4]; a.w_in = (const float*)d_in[5];
    a.rel_bias = (const float*)d_in[6]; a.ikn_g = (const float*)d_in[7]; a.ikn_b = (const float*)d_in[8]; a.w_branch_a = (const float*)d_in[9]; a.w_branch_b = (const float*)d_in[10]; a.w_out = (const float*)d_in[11];
    a.ln1_g = (const float*)d_in[12]; a.ln1_b = (const float*)d_in[13]; a.w_router = (const float*)d_in[14]; a.router_bias = (const float*)d_in[15]; a.w_exp_gate = (const float*)d_in[16]; a.w_exp_up = (const float*)d_in[17];
    a.w_exp_down = (const float*)d_in[18]; a.w_sh_gate = (const float*)d_in[19]; a.w_sh_up = (const float*)d_in[20]; a.w_sh_down = (const float*)d_in[21]; a.ln2_g = (const float*)d_in[22]; a.ln2_b = (const float*)d_in[23];
    a.out = (float*)d_out; a.ws = (unsigned char*)d_ws;
    for (int j = 0; j < 8; ++j) { const float inv = (float)std::pow(500000.0, -(double)(2 * j) / 16.0); a.inv_freq_rev[j] = (double)inv / 6.283185307179586476925286766559; }
    auto run = [&](int lo, int hi, int flags) { a.ph_lo = lo; a.ph_hi = hi; a.li = 0; a.flags = flags; hipLaunchKernelGGL(mk_fwd, dim3(grid), dim3(NWAVES * 64), LDS_BYTES, stream, a); };
#if MK_NAIVE_MASK == 0 && MK_N_LAUNCHES == 1
    run(0, NPHASE, 0);
#elif MK_NAIVE_MASK == 0
    for (int k = 0; k < NPHASE; ++k) run(k, k + 1, 0);
#else
    constexpr int mask = MK_NAIVE_MASK;
    a.flags = 0;
    run(0, 1, 0); run(1, 2, 0);
    if (mask & 1) hipLaunchKernelGGL(nv_inproj, dim3(12, T), dim3(256), 0, stream, a); else run(2, 3, 0);
    run(3, 4, 0);
    run(4, 5, ((mask & 2) ? 1 : 0) | ((mask & 4) ? 2 : 0));
    if (mask & 2) hipLaunchKernelGGL(nv_index, dim3(T), dim3(256), 0, stream, a);
    if (mask & 4) { hipLaunchKernelGGL(nv_attn<0>, dim3(T * 8 / 4), dim3(256), 0, stream, a); hipLaunchKernelGGL(nv_copy_o, dim3(T * 512 * 2 / 16 / 256), dim3(256), 0, stream, a, 0); }
    if (mask & 8) { hipLaunchKernelGGL(nv_attn<1>, dim3(T * 8 / 4), dim3(256), 0, stream, a); hipLaunchKernelGGL(nv_copy_o, dim3(T * 512 * 2 / 16 / 256), dim3(256), 0, stream, a, 1); } else run(5, 6, 0);
    if (mask & 16) hipLaunchKernelGGL(nv_merge, dim3(2, T), dim3(256), 0, stream, a); else run(6, 7, 0);
    if (mask & 32) { hipLaunchKernelGGL(nv_outproj, dim3(2, T), dim3(256), 0, stream, a); hipLaunchKernelGGL(nv_ln1, dim3(T / 4), dim3(256), 0, stream, a); } else { run(7, 8, 0); run(8, 9, 0); }
    run(9, 10, 0);
    if (mask & 64) hipLaunchKernelGGL(nv_shgu, dim3(1, T), dim3(256), 0, stream, a);
    if (mask & 128) { hipLaunchKernelGGL(nv_expgu, dim3(T * 8), dim3(256), 0, stream, a); hipLaunchKernelGGL(nv_down, dim3(4, T), dim3(256), 0, stream, a); hipLaunchKernelGGL(nv_ln2, dim3(T / 4), dim3(256), 0, stream, a); }
    else { for (int k = 10; k < NPHASE; ++k) run(k, k + 1, 0); }
#endif
}
```

```cpp
#include <hip/hip_runtime.h>
#include <hip/hip_bf16.h>
#include <cstdio>
#include <cstdint>
#include <cmath>
#ifndef MK_NAIVE_MASK
#define MK_NAIVE_MASK 0
#endif
namespace pg8 {
#define PG8_LAS __attribute__((address_space(3)))
typedef unsigned short bf16_t;
typedef short bf16x8 __attribute__((ext_vector_type(8)));
typedef float f32x4 __attribute__((ext_vector_type(4)));
typedef float f32x2 __attribute__((ext_vector_type(2)));
typedef unsigned u32x4 __attribute__((ext_vector_type(4)));
typedef unsigned u32x2 __attribute__((ext_vector_type(2)));
constexpr int BM = 256, BK = 64, HALF = 128, HTB = HALF * BK * 2  , STAGE_BYTES = 8 * HTB, NXCD = 8, WGM = 8;

__host__ __device__ __forceinline__ int lds_byte(int r, int c) { const int st = (r >> 4) * 2 + (c >> 5), rr = r & 15, cc = c & 31, ob = rr * 64 + cc * 2; return st * 1024 + (ob ^ (((ob >> 9) & 1) << 5)); }
__host__ __device__ __forceinline__ void stage_rc(int b, int& R, int& C) { const int st = b / 1024, sb = b % 1024, swz = sb ^ (((sb >> 9) & 1) << 5); R = (st >> 1) * 16 + swz / 64; C = (st & 1) * 32 + (swz % 64) / 2; }
__host__ __device__ __forceinline__ int perm32(int rho) { const int n = rho >> 4, i = rho & 15; return 8 * (i >> 2) + 4 * n + (i & 3); }

struct Unit { int pm, pn, e, nrows; };

struct DenseOrder {
    int nM, nN, nwg, G, c; unsigned arow; const char* Bt; size_t btile;
    __device__ void init(int M, int N, int K, const void* Bt_, int G_, int c_) { nM = M / BM; nN = N / BM; nwg = nM * nN; G = G_; c = c_; arow = (unsigned)K * 2u; Bt = (const char*)Bt_; btile = (size_t)BM * K * 2; }
    __device__ __forceinline__ bool next(int i, Unit& u) const {
        const long L = (long)i * G + c; if (L >= nwg) return false;
        int wgid = (int)L; { const int q = nwg / NXCD, r = nwg % NXCD, xcd = wgid % NXCD, off = wgid / NXCD; wgid = (xcd < r ? xcd * (q + 1) : r * (q + 1) + (xcd - r) * q) + off; }
        const int nig = WGM * nN, gid = wgid / nig, fm = gid * WGM, gsz = (nM - fm) < WGM ? (nM - fm) : WGM;
        u.pm = fm + ((wgid % nig) % gsz); u.pn = (wgid % nig) / gsz; u.e = 0; u.nrows = 256; return true;
    }
    __device__ __forceinline__ unsigned a_off(const Unit& u, int row) const { return (unsigned)(u.pm * BM + row) * arow; }
    __device__ __forceinline__ const char* b_ptr(const Unit& u) const { return Bt + (size_t)u.pn * btile; }
};

__device__ __forceinline__ unsigned cvt_pk_bf16(float lo, float hi) { unsigned r; asm volatile("v_cvt_pk_bf16_f32 %0, %1, %2" : "=v"(r) : "v"(lo), "v"(hi)); return r; }

struct PanelStats {
    unsigned* xbuf;
    unsigned* cnt;
    unsigned* tmo;
    int ntn; float eps;
    unsigned code;
    __device__ __forceinline__ bool run(const f32x4 (&v)[2][2][4][2], const Unit& u, int wr, int wc, int fr, int fq, PG8_LAS unsigned char* lds, int wid, int lane) const {
        typedef float f32x2v __attribute__((ext_vector_type(2)));
        PG8_LAS f32x2v* P = (PG8_LAS f32x2v*)lds;
        PG8_LAS f32x2v* S = (PG8_LAS f32x2v*)(lds + 8192);
        PG8_LAS unsigned* flag = (PG8_LAS unsigned*)(lds + 8192 + 2048);
#pragma unroll
        for (int ai = 0; ai < 2; ++ai)
#pragma unroll
            for (int m = 0; m < 4; ++m) {
                float s = 0.f;
#pragma unroll
                for (int bj = 0; bj < 2; ++bj)
#pragma unroll
                    for (int n = 0; n < 2; ++n) { const f32x4 x = v[ai][bj][m][n]; s += (x[0] + x[1]) + (x[2] + x[3]); }
                s += __shfl_xor(s, 16); s += __shfl_xor(s, 32);
                const float mw = s * (1.0f / 64.0f); float q = 0.f;
#pragma unroll
                for (int bj = 0; bj < 2; ++bj)
#pragma unroll
                    for (int n = 0; n < 2; ++n) { const f32x4 d = v[ai][bj][m][n] - mw; q += (d[0] * d[0] + d[1] * d[1]) + (d[2] * d[2] + d[3] * d[3]); }
                q += __shfl_xor(q, 16); q += __shfl_xor(q, 32);
                if (fq == 0) P[(ai * HALF + wr * 64 + m * 16 + fr) * 4 + wc] = (f32x2v){mw, q};
            }
        asm volatile("s_waitcnt lgkmcnt(0)" ::: "memory"); __builtin_amdgcn_s_barrier(); asm volatile("" ::: "memory");
        const int row = wid * 32 + (lane & 31);
        if (lane < 32) {
            const f32x2v a = P[row * 4 + 0], b = P[row * 4 + 1], c = P[row * 4 + 2], d = P[row * 4 + 3];
            const float mt = (a.x + b.x + c.x + d.x) * 0.25f;
            const float da = a.x - mt, db = b.x - mt, dc = c.x - mt, dd = d.x - mt;
            const float m2 = (a.y + b.y) + (c.y + d.y) + 64.0f * ((da * da + db * db) + (dc * dc + dd * dd));
            unsigned long long* slot = (unsigned long long*)xbuf + ((size_t)(u.pm * BM + row) * 4 + u.pn);
            __hip_atomic_store(slot, ((unsigned long long)__float_as_uint(m2) << 32) | __float_as_uint(mt), __ATOMIC_RELAXED, __HIP_MEMORY_SCOPE_AGENT);
        }
        asm volatile("s_waitcnt vmcnt(0)" ::: "memory");
        if (lane == 0) __hip_atomic_fetch_add(cnt + 64 * u.pm, 1u, __ATOMIC_RELAXED, __HIP_MEMORY_SCOPE_AGENT);
        if (wid == 0) {
            bool dead = false; const unsigned long long t0 = __builtin_amdgcn_s_memrealtime(); const unsigned want = 8u * (unsigned)ntn;
            for (;;) {
                if ((unsigned)__builtin_amdgcn_readfirstlane(__hip_atomic_load(cnt + 64 * u.pm, __ATOMIC_RELAXED, __HIP_MEMORY_SCOPE_AGENT)) >= want) break;
                if (__builtin_amdgcn_s_memrealtime() - t0 > 2000000ull) {
                    if (lane == 0) { unsigned expect = 0u; __hip_atomic_compare_exchange_strong(tmo + 1, &expect, code | (unsigned)(u.pm & 0xff), __ATOMIC_RELAXED, __ATOMIC_RELAXED, __HIP_MEMORY_SCOPE_AGENT);
                                     __hip_atomic_store(tmo, 1u, __ATOMIC_RELAXED, __HIP_MEMORY_SCOPE_AGENT); }
                    dead = true; break; }
                __builtin_amdgcn_s_sleep(2);
            }
            __builtin_amdgcn_fence(__ATOMIC_ACQUIRE, "agent");
            if (lane == 0) flag[0] = dead ? 1u : 0u;
        }
        asm volatile("s_waitcnt vmcnt(0) lgkmcnt(0)" ::: "memory"); __builtin_amdgcn_s_barrier(); asm volatile("" ::: "memory");
        const bool bad = flag[0] != 0u;
        if (lane < 32) {
            const unsigned long long* slot = (const unsigned long long*)xbuf + (size_t)(u.pm * BM + row) * 4; float mt[4], m2[4]; float ms = 0.f;
#pragma unroll
            for (int t = 0; t < 4; ++t) { if (t < ntn) { const unsigned long long w = __hip_atomic_load(slot + t, __ATOMIC_RELAXED, __HIP_MEMORY_SCOPE_AGENT); mt[t] = __uint_as_float((unsigned)w); m2[t] = __uint_as_float((unsigned)(w >> 32)); } else { mt[t] = 0.f; m2[t] = 0.f; } ms += mt[t]; }
            const float mean = ms / (float)ntn; float q = 0.f;
#pragma unroll
            for (int t = 0; t < 4; ++t) if (t < ntn) { const float dm = mt[t] - mean; q += m2[t] + 256.0f * dm * dm; }
            S[row] = (f32x2v){mean, 1.0f / sqrtf(q / (256.0f * (float)ntn) + eps)};
        }
        asm volatile("s_waitcnt lgkmcnt(0)" ::: "memory"); __builtin_amdgcn_s_barrier(); asm volatile("" ::: "memory");
        return bad;
    }
};

struct Gemm { const bf16_t* A; int K; };

template <class Epi, class Sched, bool ALIGN_EPI = false>
__device__ __forceinline__ void gemm_phase(PG8_LAS unsigned char* lds, const Gemm g, const Sched& S, const Epi& E) {
    int tid_ = threadIdx.x; asm volatile("" : "+v"(tid_));
    const int tid = tid_, wid = __builtin_amdgcn_readfirstlane(tid >> 6), lane = tid & 63, wr = wid >> 2, wc = wid & 3, fr = lane & 15, fq = lane >> 4;
    const int K = g.K, nt = K / BK;
    int RA[2], CA2[2]; unsigned voffB[2];
#pragma unroll
    for (int i = 0; i < 2; ++i) { int R, C; stage_rc(tid * 16 + i * 8192, R, C); const int Rb = Epi::PERM ? ((R & ~31) + perm32(R & 31)) : R;
        RA[i] = R; CA2[i] = C * 2; voffB[i] = (unsigned)(Rb * K + C) * 2u; }
    const size_t kstep = (size_t)(BK * 2);
    const size_t hstep = (size_t)HALF * K * 2;
    const unsigned ldsw = (unsigned)wid * 1024u;
    const int aoff = lds_byte(wr * 64 + fr, fq * 8), boff = lds_byte(wc * 32 + fr, fq * 8);
    const char* Abase = (const char*)g.A;
#define PG8_SA(b, h) (((b) * 2 + (h)) * HTB)
#define PG8_SB(b, h) ((4 + (b) * 2 + (h)) * HTB)
#define PG8_STAGE(bufoff, gbase, voff) do { _Pragma("unroll") for (int _i = 0; _i < 2; ++_i) \
        __builtin_amdgcn_global_load_lds((const unsigned*)((const char*)(gbase) + (voff)[_i]), (PG8_LAS unsigned*)(lds + (bufoff) + ldsw + _i * 8192), 16, 0, 0); } while (0)
#define PG8_STAGEA(bufoff, offs, koff) do { _Pragma("unroll") for (int _i = 0; _i < 2; ++_i) \
        __builtin_amdgcn_global_load_lds((const unsigned*)((Abase + (size_t)(koff)) + (size_t)(offs)[_i]), (PG8_LAS unsigned*)(lds + (bufoff) + ldsw + _i * 8192), 16, 0, 0); } while (0)
#define PG8_LDA(dst, b, h) do { _Pragma("unroll") for (int m = 0; m < 4; ++m) _Pragma("unroll") for (int k = 0; k < 2; ++k) dst[m][k] = *(const PG8_LAS bf16x8*)(lds + PG8_SA(b, h) + aoff + m * 2048 + k * 1024); } while (0)
#define PG8_LDB(dst, b, h) do { _Pragma("unroll") for (int n = 0; n < 2; ++n) _Pragma("unroll") for (int k = 0; k < 2; ++k) dst[n][k] = *(const PG8_LAS bf16x8*)(lds + PG8_SB(b, h) + boff + n * 2048 + k * 1024); } while (0)
#define PG8_MMA(ai, bj, At, Bt) do { __builtin_amdgcn_s_setprio(1); _Pragma("unroll") for (int m = 0; m < 4; ++m) _Pragma("unroll") for (int n = 0; n < 2; ++n) _Pragma("unroll") for (int k = 0; k < 2; ++k) \
        acc[ai][bj][m][n] = __builtin_amdgcn_mfma_f32_16x16x32_bf16(Bt[n][k], At[m][k], acc[ai][bj][m][n], 0, 0, 0); __builtin_amdgcn_s_setprio(0); } while (0)
#define PG8_WAIT_V(n) asm volatile("s_waitcnt vmcnt(" #n ")" ::: "memory")
#define PG8_WAIT_L(n) asm volatile("s_waitcnt lgkmcnt(" #n ")" ::: "memory")
#define PG8_BAR __builtin_amdgcn_s_barrier()
#define PG8_SCHED __builtin_amdgcn_sched_barrier(0)
    Unit cur, nxt; int ui = 0;
    if (!S.next(0, cur)) return;
    f32x4 acc[2][2][4][2];
#pragma unroll
    for (int a = 0; a < 2; ++a)
#pragma unroll
        for (int b = 0; b < 2; ++b)
#pragma unroll
            for (int m = 0; m < 4; ++m)
#pragma unroll
                for (int n = 0; n < 2; ++n) acc[a][b][m][n] = (f32x4){0.f, 0.f, 0.f, 0.f};
    bf16x8 At[4][2], B0[2][2], B1[2][2];
    unsigned ca0[2], ca1[2], na0[2], na1[2];
#pragma unroll
    for (int i = 0; i < 2; ++i) { ca0[i] = S.a_off(cur, RA[i]) + (unsigned)CA2[i]; ca1[i] = S.a_off(cur, HALF + RA[i]) + (unsigned)CA2[i]; }
    const char* cB = S.b_ptr(cur);
    {
        PG8_STAGE(PG8_SB(0, 0), cB, voffB); PG8_STAGE(PG8_SB(0, 1), cB + hstep, voffB); PG8_STAGEA(PG8_SA(0, 0), ca0, 0); PG8_STAGEA(PG8_SA(0, 1), ca1, 0);
        if (wr == 1) PG8_BAR;
        PG8_WAIT_V(2); PG8_BAR;
        PG8_STAGE(PG8_SB(1, 0), cB + kstep, voffB); PG8_STAGEA(PG8_SA(1, 0), ca0, kstep); PG8_STAGE(PG8_SB(1, 1), cB + hstep + kstep, voffB);
        PG8_WAIT_V(6); PG8_BAR;
    }
    for (;;) {
        const bool has_next = S.next(ui + 1, nxt);
        const char* nB = cB;
#pragma unroll
        for (int i = 0; i < 2; ++i) { na0[i] = ca0[i]; na1[i] = ca1[i]; }
        if (has_next) { nB = S.b_ptr(nxt);
#pragma unroll
            for (int i = 0; i < 2; ++i) { int R, C; stage_rc(tid * 16 + i * 8192, R, C); na0[i] = S.a_off(nxt, R) + (unsigned)(C * 2); na1[i] = S.a_off(nxt, HALF + R) + (unsigned)(C * 2); } }
#pragma unroll 1
        for (int t = 0; t < nt; t += 2) {
            const bool last = (t == nt - 2);
            const size_t k1 = (size_t)(t + 1) * kstep;
            const size_t k2 = last ? (size_t)0 : (size_t)(t + 2) * kstep, k3 = k2 + kstep;
            const char* b2 = (last ? nB : cB) + k2; const char* b3 = b2 + kstep;
            PG8_LDB(B0, 0, 0); PG8_LDB(B1, 0, 1); PG8_SCHED; PG8_LDA(At, 0, 0); PG8_STAGEA(PG8_SA(1, 1), ca1, k1);
            if (last) {
#pragma unroll
                for (int i = 0; i < 2; ++i) { ca0[i] = na0[i]; ca1[i] = na1[i]; } }
            PG8_WAIT_V(8); PG8_WAIT_L(0); PG8_BAR; PG8_MMA(0, 0, At, B0); PG8_MMA(0, 1, At, B1); PG8_BAR; PG8_SCHED;
            PG8_LDA(At, 0, 1); PG8_STAGE(PG8_SB(0, 0), b2, voffB); PG8_STAGE(PG8_SB(0, 1), b2 + hstep, voffB); PG8_STAGEA(PG8_SA(0, 0), ca0, k2);
            PG8_WAIT_V(8); PG8_WAIT_L(0); PG8_BAR; PG8_MMA(1, 0, At, B0); PG8_MMA(1, 1, At, B1); PG8_BAR; PG8_SCHED;
            PG8_LDB(B0, 1, 0); PG8_LDB(B1, 1, 1); PG8_SCHED; PG8_LDA(At, 1, 0); PG8_STAGEA(PG8_SA(0, 1), ca1, k2);
            PG8_WAIT_V(8); PG8_WAIT_L(0); PG8_BAR; PG8_MMA(0, 0, At, B0); PG8_MMA(0, 1, At, B1); PG8_BAR; PG8_SCHED;
            PG8_LDA(At, 1, 1); PG8_STAGE(PG8_SB(1, 0), b3, voffB); PG8_STAGE(PG8_SB(1, 1), b3 + hstep, voffB); PG8_STAGEA(PG8_SA(1, 0), ca0, k3);
            PG8_WAIT_V(8); PG8_WAIT_L(0); PG8_BAR; PG8_MMA(1, 0, At, B0); PG8_MMA(1, 1, At, B1); PG8_BAR; PG8_SCHED;
        }
        if constexpr (ALIGN_EPI) { if (wr == 0) PG8_BAR; }
        if constexpr (!Epi::AFTER_DRAIN) { E(acc, cur, wr, wc, fr, fq); }
        if (!has_next) break;
#pragma unroll
        for (int a = 0; a < 2; ++a)
#pragma unroll
            for (int b = 0; b < 2; ++b)
#pragma unroll
                for (int m = 0; m < 4; ++m)
#pragma unroll
                    for (int n = 0; n < 2; ++n) acc[a][b][m][n] = (f32x4){0.f, 0.f, 0.f, 0.f};
        cur = nxt; cB = nB; ++ui;
        if constexpr (ALIGN_EPI) { if (wr == 1) PG8_BAR; }
    }
    PG8_WAIT_V(0);
    if constexpr (!ALIGN_EPI) { if (wr == 0) PG8_BAR; }
    PG8_BAR;
    if constexpr (Epi::AFTER_DRAIN) { E.fused(acc, cur, wr, wc, fr, fq, lds, wid, lane); }
#undef PG8_SA
#undef PG8_SB
#undef PG8_STAGE
#undef PG8_STAGEA
#undef PG8_LDA
#undef PG8_LDB
#undef PG8_MMA
#undef PG8_WAIT_V
#undef PG8_WAIT_L
#undef PG8_BAR
#undef PG8_SCHED
}
}
namespace attn_body {
using bf16=__hip_bfloat16;
using bf16x8=__attribute__((ext_vector_type(8)))short;
using s16x4=__attribute__((ext_vector_type(4)))short;
using f32x16=__attribute__((ext_vector_type(16)))float;
using u32x4=__attribute__((ext_vector_type(4)))unsigned;
using u32x2=__attribute__((ext_vector_type(2)))unsigned;
constexpr int SEQ=2048,D=64,DM=512;
constexpr int NW=8,QBLK=32,QB=QBLK*NW,KVBLK=64;
__device__ __forceinline__ int crow(int r,int hi){return (r&3)+8*(r>>2)+4*hi;}
#define SBAR() __builtin_amdgcn_sched_barrier(0)
constexpr float NEGB=-1000.0f;
constexpr int NSLOT=3, SLOTB=8192;
constexpr int LDS_K=0, LDS_V=NSLOT*SLOTB, LDS_WS=2*NSLOT*SLOTB, LDS_BIAS=LDS_WS+NW*64*4, LDS_X=LDS_BIAS+2048, LDS_OST=LDS_X, LDS_BYTES=LDS_X+65536;
constexpr float C2=0.125f*1.4426950408889634f;
__device__ __forceinline__ void glds16(const void*gsrc,unsigned lds_dst){unsigned keep;
  asm volatile("s_mov_b32 %0, m0\n\ts_mov_b32 m0, %2\n\ts_nop 0\n\tglobal_load_lds_dwordx4 %1, off\n\ts_mov_b32 m0, %0":"=&s"(keep):"v"(gsrc),"s"(lds_dst):"memory");}
__device__ __forceinline__ float max3f(float a,float b,float c){float r;asm("v_max3_f32 %0, %1, %2, %3":"=v"(r):"v"(a),"v"(b),"v"(c));return r;}
__device__ __forceinline__ float max2f(float a,float b){float r;asm("v_max_f32_e32 %0, %1, %2":"=v"(r):"v"(a),"v"(b));return r;}
__device__ __forceinline__ float fadd_s(float a,float b){float r;asm("v_add_f32_e32 %0, %1, %2":"=v"(r):"v"(a),"v"(b));return r;}
__device__ __forceinline__ float fsub_s(float a,float b){float r;asm("v_sub_f32_e32 %0, %1, %2":"=v"(r):"v"(a),"v"(b));return r;}
typedef float f32x2_t __attribute__((ext_vector_type(2))); typedef __bf16 bf16x2_t __attribute__((ext_vector_type(2)));
__device__ __forceinline__ unsigned cvtpk_s(float lo,float hi){f32x2_t v={lo,hi};bf16x2_t b=__builtin_convertvector(v,bf16x2_t);return __builtin_bit_cast(unsigned,b);}
#define WAIT_BAR(N) asm volatile("s_waitcnt vmcnt(" #N ") lgkmcnt(0)\n\ts_barrier":::"memory")

__device__ __forceinline__ void qkt(f32x16&p0,f32x16&p1,const char*Kslot,const bf16x8*qr,const f32x16&negm,int r32,int hi){
  const char*kb=Kslot+hi*1024+r32*16;
  #pragma unroll
  for(int d0=0;d0<4;++d0){
    const bf16x8 b0=*reinterpret_cast<const bf16x8*>(kb+d0*2048);
    const bf16x8 b1=*reinterpret_cast<const bf16x8*>(kb+d0*2048+512);
    if(d0==0){p0=__builtin_amdgcn_mfma_f32_32x32x16_bf16(b0,qr[0],negm,0,0,0);p1=__builtin_amdgcn_mfma_f32_32x32x16_bf16(b1,qr[0],negm,0,0,0);}
    else{p0=__builtin_amdgcn_mfma_f32_32x32x16_bf16(b0,qr[d0],p0,0,0,0);p1=__builtin_amdgcn_mfma_f32_32x32x16_bf16(b1,qr[d0],p1,0,0,0);}}
}
typedef __attribute__((address_space(3))) const char* lds_cptr;
typedef __attribute__((address_space(3))) char* lds_ptr;
typedef short v4i16_t __attribute__((ext_vector_type(4)));
__device__ __forceinline__ void kload8(bf16x8*kf,lds_cptr kp){
  kf[0]=*(const __attribute__((address_space(3))) bf16x8*)(kp);      kf[1]=*(const __attribute__((address_space(3))) bf16x8*)(kp+512);
  kf[2]=*(const __attribute__((address_space(3))) bf16x8*)(kp+2048); kf[3]=*(const __attribute__((address_space(3))) bf16x8*)(kp+2560);
  kf[4]=*(const __attribute__((address_space(3))) bf16x8*)(kp+4096); kf[5]=*(const __attribute__((address_space(3))) bf16x8*)(kp+4608);
  kf[6]=*(const __attribute__((address_space(3))) bf16x8*)(kp+6144); kf[7]=*(const __attribute__((address_space(3))) bf16x8*)(kp+6656);
}
__device__ __forceinline__ void kload2(bf16x8*kf,lds_cptr kp,int j){ kf[2*j]=*(const __attribute__((address_space(3))) bf16x8*)(kp+j*2048); kf[2*j+1]=*(const __attribute__((address_space(3))) bf16x8*)(kp+j*2048+512); }
__device__ __forceinline__ s16x4 vtr(lds_cptr p){ return __builtin_bit_cast(s16x4,__builtin_amdgcn_ds_read_tr16_b64_v4i16((__attribute__((address_space(3))) v4i16_t*)p)); }
__device__ __forceinline__ float rowmax(const f32x16&p0,const f32x16&p1){
  float a=max3f(p0[0],p0[1],p1[0]),b=max3f(p0[2],p0[3],p1[1]);a=max3f(a,p1[2],p1[3]);
  #pragma unroll
  for(int r=4;r<16;r+=4){a=max3f(a,p0[r],p0[r+1]);b=max3f(b,p0[r+2],p0[r+3]);a=max3f(a,p1[r],p1[r+1]);b=max3f(b,p1[r+2],p1[r+3]);}
  const float m=max2f(a,b);
  auto rr=__builtin_amdgcn_permlane32_swap(__float_as_uint(m),__float_as_uint(m),false,false);
  return max2f(__uint_as_float(rr[0]),__uint_as_float(rr[1]));
}
__device__ __forceinline__ void pv(f32x16*o,int vb,bf16x8 pa0,bf16x8 pa1,bf16x8 pa2,bf16x8 pa3){
  #pragma unroll
  for(int d0=0;d0<2;++d0){s16x4 lo[4],hi[4];
    #pragma unroll
    for(int ks=0;ks<4;++ks){
      asm volatile("ds_read_b64_tr_b16 %0,%1 offset:%c2":"=&v"(lo[ks]):"v"(vb),"i"(d0*4096+ks*1024):"memory");
      asm volatile("ds_read_b64_tr_b16 %0,%1 offset:%c2":"=&v"(hi[ks]):"v"(vb),"i"(d0*4096+ks*1024+512):"memory");}
    asm volatile("s_waitcnt lgkmcnt(0)":::"memory");SBAR();
    #define PK(k) (bf16x8){lo[k][0],lo[k][1],lo[k][2],lo[k][3],hi[k][0],hi[k][1],hi[k][2],hi[k][3]}
    o[d0]=__builtin_amdgcn_mfma_f32_32x32x16_bf16(pa0,PK(0),o[d0],0,0,0);
    o[d0]=__builtin_amdgcn_mfma_f32_32x32x16_bf16(pa1,PK(1),o[d0],0,0,0);
    o[d0]=__builtin_amdgcn_mfma_f32_32x32x16_bf16(pa2,PK(2),o[d0],0,0,0);
    o[d0]=__builtin_amdgcn_mfma_f32_32x32x16_bf16(pa3,PK(3),o[d0],0,0,0);
    #undef PK
  }
}

template<int MODE,int THRL> __device__ __forceinline__ void attn_unit(int b,int h,int qb,const bf16*Q,const bf16*__restrict__ K,const bf16*__restrict__ V,bf16*O,const void*extra,char*shm){
  int tid_=threadIdx.x; asm volatile("":"+v"(tid_));
  const int tid=tid_,lane=tid&63,r32=lane&31,hi=lane>>5; const int wid=__builtin_amdgcn_readfirstlane(tid>>6);
  const long rowbase=(long)b*SEQ; const int q0=qb*QB;
  const int jt0=(MODE==0)?((4*qb-8)>0?(4*qb-8):0):0;
  const int NT=4*qb+4-jt0;
  const bf16*Qw=Q+(rowbase+q0+wid*QBLK)*DM+h*D;
  const bf16*Kh=K+(rowbase+(long)jt0*KVBLK)*DM+h*D,*Vh=V+(rowbase+(long)jt0*KVBLK)*DM+h*D;
  const unsigned lds0=(unsigned)(uintptr_t)shm;
  __attribute__((address_space(3))) float*wsf=(__attribute__((address_space(3))) float*)((lds_ptr)shm+LDS_WS)+wid*64;
  const lds_cptr shm3=(lds_cptr)shm;
  if(MODE==1){ const unsigned long long*selg=(const unsigned long long*)extra+(size_t)(rowbase+q0)*32; int row=tid>>1,par=tid&1; asm volatile("":"+v"(row),"+v"(par)); lds_ptr xm=(lds_ptr)shm+LDS_X;
    _Pragma("unroll 1") for(int cc=par;cc<NT/2;cc+=2){ const u32x4 v=*(const u32x4*)(selg+(size_t)row*32+2*cc);
      *(__attribute__((address_space(3))) u32x2*)(xm+((2*cc)*256+row)*8)=(u32x2){v.x,v.y}; *(__attribute__((address_space(3))) u32x2*)(xm+((2*cc+1)*256+row)*8)=(u32x2){v.z,v.w}; } }
  else { int tb_=tid; asm volatile("":"+v"(tb_)); if(tb_<257){ const float bv=((const float*)extra)[h*257+tb_]*1.4426950408889634f; *(__attribute__((address_space(3))) float*)((lds_ptr)shm+LDS_BIAS+tb_*4)=bv; } }
  const __attribute__((address_space(3))) float* biasl=(const __attribute__((address_space(3))) float*)(shm3+LDS_BIAS);
  const lds_cptr xmr=shm3+LDS_X+(wid*32+r32)*8;
  const bf16*ksrc=Kh+(long)lane*DM+wid*8;
  const bf16*vsrc=Vh+(long)(16*(wid&3)+(lane>>2))*DM+(wid>>2)*32+(lane&3)*8;
  const unsigned kdst=lds0+LDS_K+wid*1024, vdst=lds0+LDS_V+wid*1024;
  #define DMA_K(t,slot) glds16(ksrc+(long)(t)*KVBLK*DM,(unsigned)__builtin_amdgcn_readfirstlane(kdst+(slot)))
  #define DMA_V(t,slot) glds16(vsrc+(long)(t)*KVBLK*DM,(unsigned)__builtin_amdgcn_readfirstlane(vdst+(slot)))
  const char*Kbase=shm+LDS_K; bf16x8 kf[8];
  const lds_cptr kp0=shm3+LDS_K+hi*1024+r32*16; const lds_cptr vp0=shm3+LDS_V+((lane>>4)&1)*32+(lane&3)*8+(4*hi+((lane&15)>>2))*64;
  DMA_K(0,0);DMA_V(0,0);DMA_K(1,SLOTB);
  bf16x8 qr[4];
  #pragma unroll
  for(int d0=0;d0<4;++d0)qr[d0]=*reinterpret_cast<const bf16x8*>(&Qw[(long)r32*DM+d0*16+hi*8]);
  float mhat=0.f,l_reg=0.f;f32x16 o[2];o[0]=f32x16{};o[1]=f32x16{};const f32x16 negm=f32x16{};
  const int qpos=q0+wid*QBLK+r32;
  const int cw=4*qb+(wid>>1);
  #define MASKT(P0,P1,t) do{ \
    if(MODE==1){ const u32x2 mw_=*(const __attribute__((address_space(3))) u32x2*)(xmr+(t)*2048); const unsigned m0_=mw_.x>>(4*hi), m1_=mw_.y>>(4*hi); \
      _Pragma("unroll") for(int r=0;r<16;++r){ const int bit_=(r&3)+8*(r>>2); P0[r]=((m0_>>bit_)&1u)?P0[r]:NEGB; P1[r]=((m1_>>bit_)&1u)?P1[r]:NEGB; } } \
    else { const int jc_=jt0+(t); \
      if(jc_>cw||jc_+8<cw){ _Pragma("unroll") for(int r=0;r<16;++r){P0[r]=NEGB;P1[r]=NEGB;} } \
      else if((q0+wid*QBLK)-(64*jc_+63)>=128){ const float bc_=biasl[256]; _Pragma("unroll") for(int r=0;r<16;++r){P0[r]+=bc_;P1[r]+=bc_;} } \
      else { const int rb_=qpos-(64*jc_+4*hi); \
        _Pragma("unroll") for(int r=0;r<16;++r){ const int rel_=rb_-((r&3)+8*(r>>2)); int i0_=rel_<128?rel_:128; int i1_=(rel_-32)<128?(rel_-32):128; i0_=i0_<-128?-128:i0_; i1_=i1_<-128?-128:i1_; \
          P0[r]+=biasl[i0_+128]; P1[r]+=biasl[i1_+128]; } } } \
  }while(0)
  bool resc=false;
  #define START(P0,P1) do{ const float rm=rowmax(P0,P1); resc=false; \
    { const float dl=rm; mhat=fadd_s(mhat,dl); \
      _Pragma("unroll") for(int r=0;r<16;++r){P0[r]=fsub_s(P0[r],dl);P1[r]=fsub_s(P1[r],dl);} \
      } \
    _Pragma("unroll") for(int r=0;r<16;++r)P0[r]=__builtin_amdgcn_exp2f(P0[r]); }while(0)
  #define RESC() do{ if(resc){ asm volatile("s_waitcnt lgkmcnt(0)":::"memory"); \
      _Pragma("unroll") for(int d_=0;d_<2;++d_) _Pragma("unroll") for(int r=0;r<16;++r)o[d_][r]*=wsf[crow(r,hi)]; } }while(0)
  f32x16 pA0,pA1,pB0,pB1;
  int sl_prev=0,sl_cur=0,sl_next=SLOTB;
  #define ROT() do{sl_prev=sl_cur;sl_cur=sl_next;sl_next=(sl_next==(NSLOT-1)*SLOTB)?0:sl_next+SLOTB;}while(0)
  DMA_K(2,2*SLOTB);
  WAIT_BAR(3);
  qkt(pA0,pA1,Kbase,qr,negm,r32,hi);asm volatile("s_nop 15\n\ts_nop 7":"+v"(pA0),"+v"(pA1));MASKT(pA0,pA1,0);
  START(pA0,pA1);
  _Pragma("unroll") for(int r=0;r<16;++r)pA1[r]=__builtin_amdgcn_exp2f(pA1[r]);
  WAIT_BAR(0);
  DMA_K(3,0);DMA_V(1,SLOTB);
  ROT();
  kload8(kf,kp0+sl_cur);
  WAIT_BAR(2);
  s16x4 vlo[8],vhi[8]; u32x4 pw0,pw1,pw2,pw3;
  #define PKW(P,B) cvtpk_s(P[B],P[B+1])
  #define PAF(k) __builtin_bit_cast(bf16x8,pw##k)
  #define VFR(i) (bf16x8){vlo[i][0],vlo[i][1],vlo[i][2],vlo[i][3],vhi[i][0],vhi[i][1],vhi[i][2],vhi[i][3]}
  #define PIN(x) asm volatile("":"+v"(x))
  #define MX3(a,b,c) __builtin_fmaxf(__builtin_fmaxf((a),(b)),(c))
  #define GAPA(MF,A0,A1,A2,A3,W0,W1,PW) do{ MF; sacc+=A0; sacc+=A1; sacc+=A2; sacc+=A3; PIN(sacc); W0; W1; PIN(PW); SBAR(); }while(0)
  #define EX(v) __builtin_amdgcn_exp2f(v)
  #define GAPB(MF,X,B) do{ MF; X[B]=EX(X[B]); X[B+1]=EX(X[B+1]); X[B+2]=EX(X[B+2]); X[B+3]=EX(X[B+3]); PIN(X); SBAR(); }while(0)
  #define VRD(i) do{ vlo[i]=vtr(vp_+(((i)>>2)*4096+((i)&3)*1024)); vhi[i]=vtr(vp_+(((i)>>2)*4096+((i)&3)*1024+512)); }while(0)
  #define KRD(G,j) do{ if(G){ kload2(kf,kp0+sl_next,j); SBAR(); } }while(0)
  #define STEP(C0,C1,P0,P1,t,GK,GV,GL) do{ SBAR(); \
    const lds_cptr vp_=vp0+sl_prev; \
    VRD(0); SBAR(); float sacc=(P0[0]+P0[1]); \
    GAPA(C0=__builtin_amdgcn_mfma_f32_32x32x16_bf16(kf[0],qr[0],negm,0,0,0), P0[2],P0[3],P0[4],P0[5],     pw0[0]=PKW(P0,0), pw0[1]=PKW(P0,2), pw0); \
    VRD(4); SBAR(); GAPA(C1=__builtin_amdgcn_mfma_f32_32x32x16_bf16(kf[1],qr[0],negm,0,0,0), P0[6],P0[7],P0[8],P0[9],     pw0[2]=PKW(P0,4), pw0[3]=PKW(P0,6), pw0); \
    VRD(1); SBAR(); GAPA(C0=__builtin_amdgcn_mfma_f32_32x32x16_bf16(kf[2],qr[1],C0,0,0,0),   P0[10],P0[11],P0[12],P0[13], pw1[0]=PKW(P0,8), pw1[1]=PKW(P0,10), pw1); \
    VRD(5); SBAR(); GAPA(C1=__builtin_amdgcn_mfma_f32_32x32x16_bf16(kf[3],qr[1],C1,0,0,0),   P0[14],P0[15],P1[0],P1[1],   pw1[2]=PKW(P0,12),pw1[3]=PKW(P0,14), pw1); \
    VRD(2); SBAR(); GAPA(C0=__builtin_amdgcn_mfma_f32_32x32x16_bf16(kf[4],qr[2],C0,0,0,0),   P1[2],P1[3],P1[4],P1[5],     pw2[0]=PKW(P1,0), pw2[1]=PKW(P1,2), pw2); \
    VRD(6); SBAR(); GAPA(C1=__builtin_amdgcn_mfma_f32_32x32x16_bf16(kf[5],qr[2],C1,0,0,0),   P1[6],P1[7],P1[8],P1[9],     pw2[2]=PKW(P1,4), pw2[3]=PKW(P1,6), pw2); \
    VRD(3); SBAR(); GAPA(C0=__builtin_amdgcn_mfma_f32_32x32x16_bf16(kf[6],qr[3],C0,0,0,0),   P1[10],P1[11],P1[12],P1[13], pw3[0]=PKW(P1,8), pw3[1]=PKW(P1,10), pw3); \
    VRD(7); SBAR(); GAPA(C1=__builtin_amdgcn_mfma_f32_32x32x16_bf16(kf[7],qr[3],C1,0,0,0),   P1[14],P1[15],0.f,0.f,       pw3[2]=PKW(P1,12),pw3[3]=PKW(P1,14), pw3); \
    l_reg+=sacc; \
    if(GK){DMA_K((t)+3,sl_cur);} if(GV){DMA_V((t)+1,sl_next);} \
    _Pragma("unroll") for(int r=0;r<16;++r){C0[r]-=mhat;C1[r]-=mhat;} \
    MASKT(C0,C1,t); \
    { float a=MX3(C0[0],C0[1],C1[0]),b=MX3(C0[2],C0[3],C1[1]); a=MX3(a,C1[2],C1[3]); \
      _Pragma("unroll") for(int r=4;r<16;r+=4){a=MX3(a,C0[r],C0[r+1]);b=MX3(b,C0[r+2],C0[r+3]);a=MX3(a,C1[r],C1[r+1]);b=MX3(b,C1[r+2],C1[r+3]);} \
      float rm=__builtin_fmaxf(a,b); { auto rr=__builtin_amdgcn_permlane32_swap(__float_as_uint(rm),__float_as_uint(rm),false,false); rm=__builtin_fmaxf(__uint_as_float(rr[0]),__uint_as_float(rr[1])); } \
      resc=false; \
      if(__builtin_expect(__any(rm>(float)THRL),0)){ const float dl=__builtin_fmaxf(rm,0.f); mhat+=dl; \
        _Pragma("unroll") for(int r=0;r<16;++r){C0[r]-=dl;C1[r]-=dl;} \
        const float f=__builtin_amdgcn_exp2f(-dl); l_reg*=f; if(hi==0)wsf[r32]=f; resc=true; } } \
    SBAR(); \
    GAPB(o[0]=__builtin_amdgcn_mfma_f32_32x32x16_bf16(PAF(0),VFR(0),o[0],0,0,0), C0,0); \
    GAPB(o[1]=__builtin_amdgcn_mfma_f32_32x32x16_bf16(PAF(0),VFR(4),o[1],0,0,0), C0,4); \
    KRD(GL,0); GAPB(o[0]=__builtin_amdgcn_mfma_f32_32x32x16_bf16(PAF(1),VFR(1),o[0],0,0,0), C0,8); \
    KRD(GL,1); GAPB(o[1]=__builtin_amdgcn_mfma_f32_32x32x16_bf16(PAF(1),VFR(5),o[1],0,0,0), C0,12); \
    KRD(GL,2); GAPB(o[0]=__builtin_amdgcn_mfma_f32_32x32x16_bf16(PAF(2),VFR(2),o[0],0,0,0), C1,0); \
    KRD(GL,3); GAPB(o[1]=__builtin_amdgcn_mfma_f32_32x32x16_bf16(PAF(2),VFR(6),o[1],0,0,0), C1,4); \
    GAPB(o[0]=__builtin_amdgcn_mfma_f32_32x32x16_bf16(PAF(3),VFR(3),o[0],0,0,0), C1,8); \
    GAPB(o[1]=__builtin_amdgcn_mfma_f32_32x32x16_bf16(PAF(3),VFR(7),o[1],0,0,0), C1,12); \
    }while(0)
  int t=1;
  for(;t+5<NT;t+=2){
    STEP(pB0,pB1,pA0,pA1,t,true,true,true);     WAIT_BAR(2); RESC(); ROT();
    STEP(pA0,pA1,pB0,pB1,t+1,true,true,true);   WAIT_BAR(2); RESC(); ROT();
  }
  #define ENDW(tt) do{ if((tt)+3<NT){WAIT_BAR(2);} else if((tt)+2<NT){WAIT_BAR(1);} else {WAIT_BAR(0);} }while(0)
  for(;t+1<NT;t+=2){
    STEP(pB0,pB1,pA0,pA1,t,(t+3<NT),(t+1<NT),(t+1<NT));       ENDW(t);   RESC(); ROT();
    STEP(pA0,pA1,pB0,pB1,t+1,(t+4<NT),(t+2<NT),(t+2<NT));     ENDW(t+1); RESC(); ROT();
  }
  STEP(pB0,pB1,pA0,pA1,NT-1,false,false,false); RESC();
  { float sacc=pB0[0]+pB0[1]; _Pragma("unroll") for(int r=2;r<16;++r)sacc+=pB0[r]; _Pragma("unroll") for(int r=0;r<16;++r)sacc+=pB1[r]; l_reg+=sacc;
    pw0=(u32x4){PKW(pB0,0),PKW(pB0,2),PKW(pB0,4),PKW(pB0,6)};pw1=(u32x4){PKW(pB0,8),PKW(pB0,10),PKW(pB0,12),PKW(pB0,14)};pw2=(u32x4){PKW(pB1,0),PKW(pB1,2),PKW(pB1,4),PKW(pB1,6)};pw3=(u32x4){PKW(pB1,8),PKW(pB1,10),PKW(pB1,12),PKW(pB1,14)};
    const int vb0=(int)(lds0+LDS_V)+((lane>>4)&1)*32+(lane&3)*8+(4*hi+((lane&15)>>2))*64;
    SBAR(); pv(o,vb0+sl_cur,PAF(0),PAF(1),PAF(2),PAF(3)); }
  #undef PKW
  #undef PAF
  #undef VFR
  #undef PIN
  #undef MX3
  #undef GAPA
  #undef GAPB
  #undef EX
  #undef VRD
  #undef KRD
  #undef STEP
  #undef ENDW
  {auto rr=__builtin_amdgcn_permlane32_swap(__float_as_uint(l_reg),__float_as_uint(l_reg),false,false);l_reg=__uint_as_float(rr[0])+__uint_as_float(rr[1]);}
  if(hi==0)wsf[32+r32]=l_reg;
  asm volatile("s_waitcnt lgkmcnt(0)\n\ts_barrier":::"memory");
  float rli[16];
  #pragma unroll
  for(int r=0;r<16;++r)rli[r]=__builtin_amdgcn_rcpf(wsf[32+crow(r,hi)]);
  bf16*Ow=O+(rowbase+q0+wid*QBLK)*DM+h*D;
  { bf16*stg=(bf16*)(shm+LDS_OST)+wid*2048;
    #pragma unroll
    for(int r=0;r<16;++r){const int orow=crow(r,hi);
      #pragma unroll
      for(int d0=0;d0<2;++d0)stg[orow*64+d0*32+r32]=__float2bfloat16(o[d0][r]*rli[r]);}
    asm volatile("s_waitcnt lgkmcnt(0)":::"memory");
    #pragma unroll
    for(int i=0;i<4;++i){const int row=i*8+(lane>>3),ch=lane&7; const u32x4 v=*(const u32x4*)(stg+row*64+ch*8); *(u32x4*)(Ow+(long)row*DM+ch*8)=v;} }
  asm volatile("s_waitcnt lgkmcnt(0)\n\ts_barrier":::"memory");
  #undef DMA_K
  #undef DMA_V
  #undef MASKT
  #undef START
  #undef RESC
  #undef ROT
}
constexpr int ATTN_LDS_BYTES=LDS_BYTES;
#undef SBAR
#undef WAIT_BAR
}
constexpr int NB = 8, SEQ = 2048, T = NB * SEQ, D = 1024;
constexpr int DIN = 5704, DINP = 5888;
constexpr int NEXP = 64, DEXP = 256, TOPK = 8;
constexpr int NCHUNK = 2, CHTOK = T / NCHUNK, CHROWS = CHTOK * TOPK;
constexpr float LN_EPS = 1e-5f;
constexpr float DN_ALPHA = 1.189207115002721f;
constexpr float LOG2E = 1.4426950408889634f;
constexpr int NWAVES = 8;
constexpr int NPHASE = 13;

constexpr size_t MiB = 1u << 20;
constexpr size_t WS_CTL = 0, CTL_ZERO_BYTES = 1 * MiB;
constexpr size_t WS_MOD = 1 * MiB, WS_STATS = 1 * MiB + 256 * 1024, WS_ROPE = 2 * MiB, WS_XCH = 3 * MiB;
constexpr size_t WS_EGU = 4 * MiB, WS_ED = 68 * MiB, WS_SHGU = 100 * MiB, WS_SHD = 101 * MiB;
constexpr size_t WS_WA = 102 * MiB, WS_WB = 103 * MiB, WS_WOUT = 104 * MiB, WS_WIN = 106 * MiB;
constexpr size_t WS_XN = 118 * MiB;
constexpr size_t WS_QA = 150 * MiB, WS_QB = 166 * MiB, WS_KA = 182 * MiB, WS_VA = 198 * MiB, WS_KB = 214 * MiB, WS_VB = 230 * MiB;
constexpr size_t WS_QI = 246 * MiB, WS_KIW = 262 * MiB, WS_KI = 270 * MiB, WS_WI = 272 * MiB, WS_SEL = 273 * MiB;
constexpr size_t WS_TMP = 182 * MiB, WS_MERGED = 246 * MiB;
constexpr size_t WS_NVO = 277 * MiB;
constexpr size_t WS_HSH = 102 * MiB, WS_TAB = 110 * MiB, WS_HEXP = 150 * MiB, WS_YEXP = 182 * MiB, WS_END = 310 * MiB;
constexpr size_t TAB_ER = 0, TAB_W = 512 * 1024, TAB_LIST = 1 * MiB;
constexpr int CW_TMO = 0, CW_CODE = 1, CW_BAR = 4096, CW_SEAM = 16384, SEAM_BANK = 128 * 64, CW_CNT = 40960;

constexpr int RING_OFF = 0, RING_BYTES = 131072;
constexpr int LDSCTL_OFF = RING_BYTES, MISC_OFF = LDSCTL_OFF + 320;
constexpr int XTAB_OFF = MISC_OFF + 128;
constexpr int LDS_BYTES = 147456;
static_assert(XTAB_OFF + 1024 <= LDS_BYTES, "LDS map");

#define GAS __attribute__((address_space(1)))
#define LAS __attribute__((address_space(3)))
typedef unsigned short bf16;
typedef unsigned v4u __attribute__((ext_vector_type(4)));
typedef unsigned v2u __attribute__((ext_vector_type(2)));
typedef float f32x4 __attribute__((ext_vector_type(4)));
typedef float f32x2 __attribute__((ext_vector_type(2)));
typedef short bf16x8 __attribute__((ext_vector_type(8)));
typedef float f32x16 __attribute__((ext_vector_type(16)));
typedef GAS unsigned gu32;
#define RLX_AGENT __ATOMIC_RELAXED, __HIP_MEMORY_SCOPE_AGENT
#define LDS_WAIT() asm volatile("s_waitcnt lgkmcnt(0)" ::: "memory")
#define VM_WAIT() asm volatile("s_waitcnt vmcnt(0)" ::: "memory")
__device__ __forceinline__ unsigned f2bf(float f) { unsigned u = __builtin_bit_cast(unsigned, f); return (u + 0x7fffu + ((u >> 16) & 1u)) >> 16; }
__device__ __forceinline__ unsigned pk2(float lo, float hi) { return f2bf(lo) | (f2bf(hi) << 16); }
__device__ __forceinline__ float bf2f(unsigned short h) { return __uint_as_float((unsigned)h << 16); }
__device__ __forceinline__ float bflo(unsigned w) { return __uint_as_float(w << 16); }
__device__ __forceinline__ float bfhi(unsigned w) { return __uint_as_float(w & 0xffff0000u); }
__device__ __forceinline__ float sigmoidf_(float v) { return __builtin_amdgcn_rcpf(1.0f + __builtin_amdgcn_exp2f(-v * LOG2E)); }

#define XB_TMO      128
#define XB_XCNT(j)  (256  + 64 * (j))
#define XB_XSUB(j)  (1280 + 64 * (j))
#define XB_XGEN(j)  (2304 + 64 * (j))
#define XB_TOP      3328
#define XB_TOPGEN   3392
#define XCD_BAR_WORDS 3456
#define XB_SPIN_CAP (1u << 18)
__device__ __forceinline__ unsigned xb_ld(unsigned* p)              { return __hip_atomic_load(p, __ATOMIC_RELAXED, __HIP_MEMORY_SCOPE_AGENT); }
__device__ __forceinline__ unsigned xb_add(unsigned* p, unsigned v) { return __hip_atomic_fetch_add(p, v, __ATOMIC_RELAXED, __HIP_MEMORY_SCOPE_AGENT); }
__device__ __forceinline__ unsigned xb_xcc_id() { return (unsigned)__builtin_amdgcn_s_getreg((3 << 11) | 20) & 0xFu; }
#define XB_SPIN(cond, bar) do { unsigned _sp = 0; while (cond) { __builtin_amdgcn_s_sleep(1); \
    if ((++_sp & 255u) == 0u) { if (xb_ld(&(bar)[XB_TMO])) break; if (_sp > XB_SPIN_CAP) { atomicAdd(&(bar)[XB_TMO], 1u); break; } } } } while (0)
struct XcdBarrier { unsigned* bar; unsigned x; volatile LAS unsigned* st; };
__device__ __forceinline__ XcdBarrier xcd_barrier_post(unsigned* bar, volatile LAS unsigned* st) {
    XcdBarrier b; b.bar = bar; b.x = xb_xcc_id(); b.st = st;
    if (threadIdx.x == 0) (void)xb_add(&bar[XB_XCNT(b.x)], 1u);
    return b;
}
__device__ __forceinline__ void xcd_barrier_complete(unsigned* bar, unsigned x, unsigned& nloc, unsigned& nx) {
    const unsigned G = gridDim.x * gridDim.y * gridDim.z;
    unsigned sum, cnt, mine, sp = 0u;
    for (;;) {
        sum = 0u; cnt = 0u; mine = 0u;
#pragma unroll
        for (unsigned j = 0; j < 16; ++j) { const unsigned c = xb_ld(&bar[XB_XCNT(j)]); sum += c; cnt += (c > 0u) ? 1u : 0u; mine = (j == x) ? c : mine; }
        if (sum == G) break;
        __builtin_amdgcn_s_sleep(1);
        if ((++sp & 255u) == 0u) { if (xb_ld(&bar[XB_TMO])) break; if (sp > XB_SPIN_CAP) { atomicAdd(&bar[XB_TMO], 1u); break; } }
    }
    nloc = mine > 0u ? mine : 1u; nx = cnt > 0u ? cnt : 1u;
}
__device__ __forceinline__ void xcd_barrier(const XcdBarrier& b) {
    asm volatile("s_waitcnt vmcnt(0)" ::: "memory");
    __syncthreads();
    if (threadIdx.x == 0) {
        unsigned* bar = b.bar;
        __builtin_amdgcn_s_waitcnt(0);
        unsigned nloc = b.st[0], nx = b.st[1];
        if (nloc == 0u) { xcd_barrier_complete(bar, b.x, nloc, nx); b.st[0] = nloc; b.st[1] = nx; }
        const unsigned old = xb_add(&bar[XB_XSUB(b.x)], 1u);
        const unsigned gen = old / nloc;
        if (old + 1u == (gen + 1u) * nloc) {
            __builtin_amdgcn_fence(__ATOMIC_RELEASE, "agent");
            asm volatile("s_waitcnt vmcnt(0)" ::: "memory");
            const unsigned og = xb_add(&bar[XB_TOP], 1u);
            const unsigned tg = og / nx;
            if (og + 1u == (tg + 1u) * nx) xb_add(&bar[XB_TOPGEN], 1u);
            else XB_SPIN(xb_ld(&bar[XB_TOPGEN]) == tg, bar);
            __builtin_amdgcn_fence(__ATOMIC_ACQUIRE, "agent");
            xb_add(&bar[XB_XGEN(b.x)], 1u);
            asm volatile("s_waitcnt vmcnt(0)" ::: "memory");
        } else {
            XB_SPIN(xb_ld(&bar[XB_XGEN(b.x)]) == gen, bar);
            __builtin_amdgcn_fence(__ATOMIC_ACQUIRE, "agent");
            asm volatile("s_waitcnt vmcnt(0)" ::: "memory");
        }
    }
    __syncthreads();
}

__device__ __forceinline__ float wave_sum(float v) {
#pragma unroll
    for (int o = 1; o < 64; o <<= 1) v += __shfl_xor(v, o);
    return v;
}

struct Args {
    const float* x; const float* c; const int* positions; const float* w_ada; const float* b_ada; const float* w_in; const float* rel_bias;
    const float* ikn_g; const float* ikn_b; const float* w_branch_a; const float* w_branch_b; const float* w_out; const float* ln1_g; const float* ln1_b;
    const float* w_router; const float* router_bias; const float* w_exp_gate; const float* w_exp_up; const float* w_exp_down;
    const float* w_sh_gate; const float* w_sh_up; const float* w_sh_down; const float* ln2_g; const float* ln2_b;
    float* out; unsigned char* ws;
    double inv_freq_rev[8];
    int ph_lo, ph_hi, li, flags;
};
using pg8::Unit; using pg8::cvt_pk_bf16;
__device__ __forceinline__ v4u pack8(const f32x4& v0, const f32x4& v1) { v4u w; w.x = cvt_pk_bf16(v0[0], v0[1]); w.y = cvt_pk_bf16(v0[2], v0[3]); w.z = cvt_pk_bf16(v1[0], v1[1]); w.w = cvt_pk_bf16(v1[2], v1[3]); return w; }

__device__ __forceinline__ void kidx_rows(unsigned char* ws, const float* ikn_g, const float* ikn_b, const float* cosT, const float* sinT, int row0, int tid) {
    const float* kiw = (const float*)(ws + WS_KIW); bf16* KI = (bf16*)(ws + WS_KI); float* WI = (float*)(ws + WS_WI);
    asm volatile("" : "+v"(tid));
    const int sub = tid & 15;
#pragma unroll 1
    for (int pass = 0; pass < 8; ++pass) { const int t = row0 + pass * 32 + (tid >> 4); const f32x4 g = *(const f32x4*)(ikn_g + 4 * sub), bb = *(const f32x4*)(ikn_b + 4 * sub);
        const f32x4 q = __builtin_nontemporal_load((const f32x4*)(kiw + (size_t)t * 128 + 4 * sub));
        float s = (q.x + q.y) + (q.z + q.w); s += __shfl_xor(s, 1); s += __shfl_xor(s, 2); s += __shfl_xor(s, 4); s += __shfl_xor(s, 8);
        const float mean = s * (1.f / 64.f); const f32x4 d = q - mean;
        float s2 = (d.x * d.x + d.y * d.y) + (d.z * d.z + d.w * d.w); s2 += __shfl_xor(s2, 1); s2 += __shfl_xor(s2, 2); s2 += __shfl_xor(s2, 4); s2 += __shfl_xor(s2, 8);
        const float rstd = 1.f / sqrtf(s2 * (1.f / 64.f) + LN_EPS);
        const f32x4 v = d * rstd * g + bb;
        f32x4 pv; pv.x = __shfl_xor(v.x, 2); pv.y = __shfl_xor(v.y, 2); pv.z = __shfl_xor(v.z, 2); pv.w = __shfl_xor(v.w, 2);
        if (sub < 2) { const f32x4 c = *(const f32x4*)(cosT + (size_t)t * 8 + 4 * sub), sn = *(const f32x4*)(sinT + (size_t)t * 8 + 4 * sub);
            v4u w; w.x = pk2(v.x * c.x - pv.x * sn.x, pv.x * c.x + v.x * sn.x); w.y = pk2(v.y * c.y - pv.y * sn.y, pv.y * c.y + v.y * sn.y);
            w.z = pk2(v.z * c.z - pv.z * sn.z, pv.z * c.z + v.z * sn.z); w.w = pk2(v.w * c.w - pv.w * sn.w, pv.w * c.w + v.w * sn.w);
            *(v4u*)(KI + (size_t)t * 64 + 8 * sub) = w;
            const f32x4 wr_ = __builtin_nontemporal_load((const f32x4*)(kiw + (size_t)t * 128 + 64 + 4 * sub)); *(f32x4*)(WI + (size_t)t * 8 + 4 * sub) = wr_ * (0.35355339059327373f * 0.125f); }
        else if (sub >= 4) { v2u w; w.x = pk2(v.x, v.y); w.y = pk2(v.z, v.w); *(v2u*)(KI + (size_t)t * 64 + 4 * sub) = w; }
    }
}

struct EpiInProj {
    static constexpr bool PERM = true, AFTER_DRAIN = false;
    unsigned char* ws; bf16* gates; const float* cosT; const float* sinT; const float* ikn_g; const float* ikn_b;
    __device__ __forceinline__ void operator()(const f32x4 (&acc)[2][2][4][2], const Unit& u, int wr, int wc, int fr, int fq) const {
        const int pn = u.pn, row0 = u.pm * 256 + wr * 64 + fr, ct = wc * 32 + 8 * fq;
        if (pn < 14) {
            size_t off; float sc = 1.f; bool rope = false; int colbase = (pn & 1) * 256;
            if (pn < 12) { const int seg = pn >> 1;
                off = seg == 0 ? WS_QA : seg == 1 ? WS_KA : seg == 2 ? WS_VA : seg == 3 ? WS_QB : seg == 4 ? WS_KB : WS_VB;
                sc = (seg == 0 || seg == 3) ? attn_body::C2 : 1.f; rope = (seg == 3 || seg == 4); }
            else { off = WS_QI; rope = true; }
            bf16* base = (bf16*)(ws + off);
            const bool dor = rope && ((wc & 1) == 0) && (fq < 2);
#pragma unroll
            for (int ai = 0; ai < 2; ++ai)
#pragma unroll
                for (int m = 0; m < 4; ++m) { const int row = row0 + ai * 128 + m * 16;
                    f32x4 c4 = (f32x4){1.f, 1.f, 1.f, 1.f}, s4 = (f32x4){0.f, 0.f, 0.f, 0.f};
                    if (dor) { c4 = *(const f32x4*)(cosT + (size_t)row * 8 + 4 * fq); s4 = *(const f32x4*)(sinT + (size_t)row * 8 + 4 * fq); }
#pragma unroll
                    for (int bj = 0; bj < 2; ++bj) { f32x4 v0 = acc[ai][bj][m][0], v1 = acc[ai][bj][m][1];
                        { f32x4 r0, r1;
                          r0[0] = v0[0] * c4[0] - v0[1] * s4[0]; r0[1] = v0[1] * c4[0] + v0[0] * s4[0]; r0[2] = v0[2] * c4[1] - v0[3] * s4[1]; r0[3] = v0[3] * c4[1] + v0[2] * s4[1];
                          r1[0] = v1[0] * c4[2] - v1[1] * s4[2]; r1[1] = v1[1] * c4[2] + v1[0] * s4[2]; r1[2] = v1[2] * c4[3] - v1[3] * s4[3]; r1[3] = v1[3] * c4[3] + v1[2] * s4[3];
                          v0 = r0 * sc; v1 = r1 * sc; }
                        *(v4u*)(base + (size_t)row * 512 + colbase + bj * 128 + ct) = pack8(v0, v1); } }
        } else if (pn == 14) {
            float* kiw = (float*)(ws + WS_KIW);
#pragma unroll
            for (int ai = 0; ai < 2; ++ai)
#pragma unroll
                for (int m = 0; m < 4; ++m) { const int row = row0 + ai * 128 + m * 16;
                    *(f32x4*)(kiw + (size_t)row * 128 + ct) = acc[ai][0][m][0]; *(f32x4*)(kiw + (size_t)row * 128 + ct + 4) = acc[ai][0][m][1]; }
            asm volatile("s_waitcnt vmcnt(0)" ::: "memory"); __builtin_amdgcn_s_barrier(); asm volatile("" ::: "memory");
            int tid = (wr * 4 + wc) * 64 + fq * 16 + fr;
            kidx_rows(ws, ikn_g, ikn_b, cosT, sinT, u.pm * 256, tid);
        } else {
            const int colbase = (pn - 15) * 256;
#pragma unroll
            for (int ai = 0; ai < 2; ++ai)
#pragma unroll
                for (int m = 0; m < 4; ++m) { const int row = row0 + ai * 128 + m * 16;
#pragma unroll
                    for (int bj = 0; bj < 2; ++bj) { f32x4 v0 = acc[ai][bj][m][0], v1 = acc[ai][bj][m][1];
#pragma unroll
                        for (int i = 0; i < 4; ++i) { v0[i] = sigmoidf_(v0[i]); v1[i] = sigmoidf_(v1[i]); }
                        *(v4u*)(gates + (size_t)row * 2048 + colbase + bj * 128 + ct) = pack8(v0, v1); } }
        }
    }
};

template <int PASS> struct EpiGate {
    static constexpr bool PERM = true, AFTER_DRAIN = false;
    const bf16* gates; float* tmp; bf16* merged;
    __device__ __forceinline__ void operator()(const f32x4 (&acc)[2][2][4][2], const Unit& u, int wr, int wc, int fr, int fq) const {
        const int row0 = u.pm * 256 + wr * 64 + fr, c0 = u.pn * 256 + wc * 32 + 8 * fq;
#pragma unroll
        for (int ai = 0; ai < 2; ++ai)
#pragma unroll
            for (int m = 0; m < 4; ++m) { const int row = row0 + ai * 128 + m * 16;
#pragma unroll
                for (int bj = 0; bj < 2; ++bj) { const int c = c0 + bj * 128;
                    const v4u g = *(const v4u*)(gates + (size_t)row * 2048 + (PASS == 1 ? 0 : 1024) + c);
                    f32x4 v0 = acc[ai][bj][m][0], v1 = acc[ai][bj][m][1];
                    v0[0] *= bflo(g.x); v0[1] *= bfhi(g.x); v0[2] *= bflo(g.y); v0[3] *= bfhi(g.y); v1[0] *= bflo(g.z); v1[1] *= bfhi(g.z); v1[2] *= bflo(g.w); v1[3] *= bfhi(g.w);
                    float* tp = tmp + (size_t)row * 1024 + c;
                    if (PASS == 1) { *(f32x4*)tp = v0; *(f32x4*)(tp + 4) = v1; }
                    else { v0 += *(const f32x4*)tp; v1 += *(const f32x4*)(tp + 4); *(v4u*)(merged + (size_t)row * 1024 + c) = pack8(v0, v1); } } }
    }
};

__device__ __forceinline__ float silu_mul(float g, float u) { return g * sigmoidf_(g) * u; }
struct EpiSilu {
    static constexpr bool PERM = true, AFTER_DRAIN = false;
    bf16* H;
    __device__ __forceinline__ void operator()(const f32x4 (&acc)[2][2][4][2], const Unit& u, int wr, int wc, int fr, int fq) const {
        const int row0 = u.pm * 256 + wr * 64 + fr, c0 = (u.pn * 256 + wc * 32 + 8 * fq) >> 1;
#pragma unroll
        for (int ai = 0; ai < 2; ++ai)
#pragma unroll
            for (int m = 0; m < 4; ++m) { const int row = row0 + ai * 128 + m * 16;
#pragma unroll
                for (int bj = 0; bj < 2; ++bj) { const f32x4 v0 = acc[ai][bj][m][0], v1 = acc[ai][bj][m][1];
                    v2u w; w.x = cvt_pk_bf16(silu_mul(v0[0], v0[1]), silu_mul(v0[2], v0[3])); w.y = cvt_pk_bf16(silu_mul(v1[0], v1[1]), silu_mul(v1[2], v1[3]));
                    *(v2u*)(H + (size_t)row * 256 + c0 + bj * 64) = w; } }
    }
};
struct EpiExpGU {
    static constexpr bool PERM = true, AFTER_DRAIN = false;
    bf16* H; const LAS int* xt; const unsigned short* list; const float* rw; int chunk;
    __device__ __forceinline__ void operator()(const f32x4 (&acc)[2][2][4][2], const Unit& u, int wr, int wc, int fr, int fq) const {
        const int r0 = wr * 64 + fr, c0 = (u.pn * 256 + wc * 32 + 8 * fq) >> 1; const int pos0 = __builtin_amdgcn_readfirstlane(xt[144 + u.e]) + u.pm * 256;
#pragma unroll
        for (int ai = 0; ai < 2; ++ai)
#pragma unroll
            for (int m = 0; m < 4; ++m) { const int r = r0 + ai * 128 + m * 16;
                if (r < u.nrows) { const unsigned ent = list[(size_t)u.e * 8192 + u.pm * 256 + r]; const float w = rw[(size_t)(chunk * CHTOK + (int)(ent >> 3)) * 8 + (ent & 7u)];
#pragma unroll
                    for (int bj = 0; bj < 2; ++bj) { const f32x4 v0 = acc[ai][bj][m][0], v1 = acc[ai][bj][m][1];
                        v2u pk; pk.x = cvt_pk_bf16(w * silu_mul(v0[0], v0[1]), w * silu_mul(v0[2], v0[3])); pk.y = cvt_pk_bf16(w * silu_mul(v1[0], v1[1]), w * silu_mul(v1[2], v1[3]));
                        *(v2u*)(H + (size_t)(pos0 + r) * 256 + c0 + bj * 64) = pk; } } }
    }
};
struct EpiExpD {
    static constexpr bool PERM = true, AFTER_DRAIN = false;
    bf16* Y; const LAS int* xt;
    __device__ __forceinline__ void operator()(const f32x4 (&acc)[2][2][4][2], const Unit& u, int wr, int wc, int fr, int fq) const {
        const int r0 = wr * 64 + fr, c0 = u.pn * 256 + wc * 32 + 8 * fq; const int pos0 = __builtin_amdgcn_readfirstlane(xt[144 + u.e]) + u.pm * 256;
#pragma unroll
        for (int ai = 0; ai < 2; ++ai)
#pragma unroll
            for (int m = 0; m < 4; ++m) { const int r = r0 + ai * 128 + m * 16;
                if (r < u.nrows) {
#pragma unroll
                    for (int bj = 0; bj < 2; ++bj) *(v4u*)(Y + (size_t)(pos0 + r) * 1024 + c0 + bj * 128) = pack8(acc[ai][bj][m][0], acc[ai][bj][m][1]); } }
    }
};
struct EpiShD {
    static constexpr bool PERM = true, AFTER_DRAIN = false;
    float* z; const float* mod;
    __device__ __forceinline__ void operator()(const f32x4 (&acc)[2][2][4][2], const Unit& u, int wr, int wc, int fr, int fq) const {
        const int row0 = u.pm * 256 + wr * 64 + fr, c0 = u.pn * 256 + wc * 32 + 8 * fq; const float* g2 = mod + (size_t)(u.pm >> 3) * 6144 + 5120;
#pragma unroll
        for (int bj = 0; bj < 2; ++bj) { const int c = c0 + bj * 128; const f32x4 ga = *(const f32x4*)(g2 + c), gb = *(const f32x4*)(g2 + c + 4);
#pragma unroll
            for (int ai = 0; ai < 2; ++ai)
#pragma unroll
                for (int m = 0; m < 4; ++m) { float* p = z + (size_t)(row0 + ai * 128 + m * 16) * 1024 + c;
                    const f32x4 a = *(const f32x4*)p, b = *(const f32x4*)(p + 4);
                    *(f32x4*)p = a * DN_ALPHA + ga * acc[ai][bj][m][0]; *(f32x4*)(p + 4) = b * DN_ALPHA + gb * acc[ai][bj][m][1]; } }
    }
};
struct EpiResid {
    static constexpr bool PERM = true, AFTER_DRAIN = false;
    const float* x; float* v; const float* mod;
    __device__ __forceinline__ void operator()(const f32x4 (&acc)[2][2][4][2], const Unit& u, int wr, int wc, int fr, int fq) const {
        const int row0 = u.pm * 256 + wr * 64 + fr, c0 = u.pn * 256 + wc * 32 + 8 * fq; const float* g1 = mod + (size_t)(u.pm >> 3) * 6144 + 2048;
#pragma unroll
        for (int bj = 0; bj < 2; ++bj) { const int c = c0 + bj * 128; const f32x4 ga = *(const f32x4*)(g1 + c), gb = *(const f32x4*)(g1 + c + 4);
#pragma unroll
            for (int ai = 0; ai < 2; ++ai)
#pragma unroll
                for (int m = 0; m < 4; ++m) { const size_t o = (size_t)(row0 + ai * 128 + m * 16) * 1024 + c;
                    const f32x4 a = *(const f32x4*)(x + o), b = *(const f32x4*)(x + o + 4);
                    *(f32x4*)(v + o) = a * DN_ALPHA + ga * acc[ai][bj][m][0]; *(f32x4*)(v + o + 4) = b * DN_ALPHA + gb * acc[ai][bj][m][1]; } }
    }
};

template <int MODE> struct ExpertOrder {
    const LAS int* xt; int nN, G, c, total, chunk; const unsigned short* list; const char* W; size_t wexp, btile;
    __device__ __forceinline__ bool next(int i, Unit& u) const {
        const long L = (long)i * G + c; if (L >= (long)total * nN) return false;
        const int lt = (int)(L / nN); u.pn = (int)(L - (long)lt * nN);
        int e = 0;
#pragma unroll
        for (int s = 32; s >= 1; s >>= 1) { const int v = __builtin_amdgcn_readfirstlane(xt[e + s]); if (v <= lt) e += s; }
        u.e = e; u.pm = lt - __builtin_amdgcn_readfirstlane(xt[e]); const int rem = __builtin_amdgcn_readfirstlane(xt[80 + e]) - u.pm * 256; u.nrows = rem < 256 ? rem : 256; return true;
    }
    __device__ __forceinline__ unsigned a_off(const Unit& u, int row) const {
        if (MODE == 0) { int idx = u.pm * 256 + row; const int last = __builtin_amdgcn_readfirstlane(xt[80 + u.e]) - 1; idx = idx < last ? idx : last;
            const unsigned ent = list[(size_t)u.e * 8192 + idx]; return (unsigned)(chunk * CHTOK + (int)(ent >> 3)) * 2048u; }
        int p = __builtin_amdgcn_readfirstlane(xt[144 + u.e]) + u.pm * 256 + row; p = p < CHROWS - 1 ? p : CHROWS - 1; return (unsigned)p * 512u;
    }
    __device__ __forceinline__ const char* b_ptr(const Unit& u) const { return W + (size_t)u.e * wexp + (size_t)u.pn * btile; }
};
__device__ __forceinline__ void build_xtab(LAS int* xt, const unsigned* ctl, int chunk) {
    int tid = threadIdx.x; asm volatile("" : "+v"(tid));
    if (tid < 64) xt[80 + tid] = (int)__hip_atomic_load(ctl + CW_CNT + (chunk * 64 + tid) * 16, RLX_AGENT);
    LDS_WAIT(); __syncthreads();
    if (tid == 0) { int ts = 0, of = 0; for (int e = 0; e < 64; ++e) { const int c = xt[80 + e]; xt[e] = ts; xt[144 + e] = of; ts += (c + 255) >> 8; of += c; } xt[64] = ts; }
    LDS_WAIT(); __syncthreads();
}
struct Ctx { LAS unsigned char* lds; int tid, lane, wave, vcu, G; };

struct MapId { int base; __device__ __forceinline__ int operator()(int s) const { return base + s; } };
struct MapIl { int base, par; __device__ __forceinline__ int operator()(int s) const { return base + 2 * s + par; } };
__device__ __forceinline__ int dperm_inv(int d) { return d < 8 ? 2 * d : (d < 16 ? 2 * (d - 8) + 1 : d); }
struct MapIn { __device__ __forceinline__ int operator()(int s) const {
    if (s < 1536) return s;
    if (s < 3072) { const int q = s - 1536, seg = q >> 9, hh = (q >> 6) & 7, d = q & 63; return 1536 + seg * 512 + hh * 64 + (seg < 2 ? dperm_inv(d) : d); }
    if (s < 3584) { const int q = s - 3072, hh = q >> 6, d = q & 63; return 3072 + hh * 64 + dperm_inv(d); }
    if (s < 3656) return s;
    return 3840 + (s - 3656); } };
template <class Map> __device__ __forceinline__ void xpose_item(const float* W, int N, int K, int item, bf16* WT, const Map& map, LAS float* scr, int lane) {
    const int nblk = (N + 31) / 32, kb = item / nblk, nb = item % nblk, k0 = 64 * kb, n0 = 32 * nb;
    const bool cin = (n0 + (lane & 31)) < N;
#pragma unroll
    for (int i = 0; i < 32; ++i) { const int kk = 2 * i + (lane >> 5); scr[kk * 33 + (lane & 31)] = cin ? W[(size_t)(k0 + kk) * N + n0 + (lane & 31)] : 0.f; }
    LDS_WAIT(); asm volatile("" ::: "memory");
    const int c = lane & 7;
#pragma unroll
    for (int j = 0; j < 4; ++j) { const int n = (lane >> 3) + 8 * j; const LAS float* s = scr + (8 * c) * 33 + n;
        v4u o; o.x = pk2(s[0 * 33], s[1 * 33]); o.y = pk2(s[2 * 33], s[3 * 33]); o.z = pk2(s[4 * 33], s[5 * 33]); o.w = pk2(s[6 * 33], s[7 * 33]);
        if (n0 + n < N) *(GAS v4u*)(WT + (size_t)map(n0 + n) * K + k0 + 8 * c) = o; }
    LDS_WAIT(); asm volatile("" ::: "memory");
}

__device__ __forceinline__ void p0_prologue(const Args& a, const Ctx& F) {
    unsigned char* ws = a.ws;
    {
        LAS float* cact = (LAS float*)(F.lds);
        LAS float* red = (LAS float*)(F.lds + 32768);
        for (int i = F.tid; i < 8 * 1024; i += 512) { const float v = a.c[i]; cact[i] = v * sigmoidf_(v); }
        LDS_WAIT(); __syncthreads();
        float* mod = (float*)(ws + WS_MOD);
        for (int item = F.vcu; item < 6144 / 32; item += F.G) {
            const int n0 = item * 32, kk = F.tid >> 5, col = F.tid & 31; float acc[8];
#pragma unroll
            for (int b = 0; b < 8; ++b) acc[b] = 0.f;
#pragma unroll 4
            for (int k = kk; k < 1024; k += 16) { const float w = a.w_ada[(size_t)k * 6144 + n0 + col];
#pragma unroll
                for (int b = 0; b < 8; ++b) acc[b] += cact[b * 1024 + k] * w; }
#pragma unroll
            for (int b = 0; b < 8; ++b) red[(kk * 8 + b) * 32 + col] = acc[b];
            LDS_WAIT(); __syncthreads();
            if (F.tid < 256) { const int b = F.tid >> 5; float s = 0.f;
#pragma unroll
                for (int q = 0; q < 16; ++q) s += red[(q * 8 + b) * 32 + col];
                mod[(size_t)b * 6144 + n0 + col] = s + a.b_ada[n0 + col]; }
            LDS_WAIT(); __syncthreads();
        }
        LDS_WAIT(); __syncthreads();
    }
    const int gw = F.vcu * NWAVES + F.wave, NGW = F.G * NWAVES;
    {
        float* cosT = (float*)(ws + WS_ROPE); float* sinT = cosT + (size_t)T * 8;
        for (int i = gw * 64 + F.lane; i < T * 8; i += NGW * 64) { const int t = i >> 3, j = i & 7;
            const double rev = (double)a.positions[t] * a.inv_freq_rev[j]; const float fr = (float)(rev - __builtin_floor(rev));
            cosT[i] = __builtin_amdgcn_cosf(fr); sinT[i] = __builtin_amdgcn_sinf(fr); }
    }
    {
        v4u* z = (v4u*)((bf16*)(ws + WS_WIN) + (size_t)3656 * 1024); const int n16 = 184 * 1024 * 2 / 16;
        for (int i = gw * 64 + F.lane; i < n16; i += NGW * 64) z[i] = (v4u){0u, 0u, 0u, 0u};
    }
    LAS float* scr = (LAS float*)(F.lds + F.wave * 16384);
    constexpr int I_IN = 16 * 179, I_BR = 8 * 32, I_OUT = 16 * 32, I_SG = 16 * 8, I_SD = 4 * 32, I_EG = 64 * 16 * 8, I_EDN = 64 * 4 * 32;
    constexpr int NITEMS = I_IN + 2 * I_BR + I_OUT + 2 * I_SG + I_SD + 2 * I_EG + I_EDN;
    for (int it = gw; it < NITEMS; it += NGW) {
        int r = it;
        if (r < I_IN) { xpose_item(a.w_in, DIN, 1024, r, (bf16*)(ws + WS_WIN), MapIn{}, scr, F.lane); continue; } r -= I_IN;
        if (r < I_BR) { xpose_item(a.w_branch_a, 1024, 512, r, (bf16*)(ws + WS_WA), MapId{0}, scr, F.lane); continue; } r -= I_BR;
        if (r < I_BR) { xpose_item(a.w_branch_b, 1024, 512, r, (bf16*)(ws + WS_WB), MapId{0}, scr, F.lane); continue; } r -= I_BR;
        if (r < I_OUT) { xpose_item(a.w_out, 1024, 1024, r, (bf16*)(ws + WS_WOUT), MapId{0}, scr, F.lane); continue; } r -= I_OUT;
        if (r < I_SG) { xpose_item(a.w_sh_gate, 256, 1024, r, (bf16*)(ws + WS_SHGU), MapIl{0, 0}, scr, F.lane); continue; } r -= I_SG;
        if (r < I_SG) { xpose_item(a.w_sh_up, 256, 1024, r, (bf16*)(ws + WS_SHGU), MapIl{0, 1}, scr, F.lane); continue; } r -= I_SG;
        if (r < I_SD) { xpose_item(a.w_sh_down, 1024, 256, r, (bf16*)(ws + WS_SHD), MapId{0}, scr, F.lane); continue; } r -= I_SD;
        if (r < I_EG) { const int e = r >> 7; xpose_item(a.w_exp_gate + (size_t)e * 1024 * 256, 256, 1024, r & 127, (bf16*)(ws + WS_EGU) + (size_t)e * 512 * 1024, MapIl{0, 0}, scr, F.lane); continue; } r -= I_EG;
        if (r < I_EG) { const int e = r >> 7; xpose_item(a.w_exp_up + (size_t)e * 1024 * 256, 256, 1024, r & 127, (bf16*)(ws + WS_EGU) + (size_t)e * 512 * 1024, MapIl{0, 1}, scr, F.lane); continue; } r -= I_EG;
        { const int e = r >> 7; xpose_item(a.w_exp_down + (size_t)e * 256 * 1024, 1024, 256, r & 127, (bf16*)(ws + WS_ED) + (size_t)e * 1024 * 256, MapId{0}, scr, F.lane); }
    }
}

__device__ __forceinline__ void ln_stats(const f32x4 (&v)[4], float& mean, float& rstd) {
    float s = 0.f;
#pragma unroll
    for (int j = 0; j < 4; ++j) s += (v[j].x + v[j].y) + (v[j].z + v[j].w);
    mean = wave_sum(s) * (1.f / D); float s2 = 0.f;
#pragma unroll
    for (int j = 0; j < 4; ++j) { const f32x4 d = v[j] - mean; s2 += (d.x * d.x + d.y * d.y) + (d.z * d.z + d.w * d.w); }
    rstd = 1.f / sqrtf(wave_sum(s2) * (1.f / D) + LN_EPS);
}
__device__ __forceinline__ void p1_ln_mod(const Args& a, const Ctx& F) {
    const int gw = F.vcu * NWAVES + F.wave, NGW = F.G * NWAVES; const float* mod = (const float*)(a.ws + WS_MOD); bf16* XN = (bf16*)(a.ws + WS_XN);
    for (int m = gw; m < T; m += NGW) {
        const GAS f32x4* xr = (const GAS f32x4*)(a.x + (size_t)m * D) + F.lane; const float* mb = mod + (size_t)(m >> 11) * 6144;
        f32x4 v[4];
#pragma unroll
        for (int j = 0; j < 4; ++j) v[j] = xr[64 * j];
        float mean, rstd; ln_stats(v, mean, rstd);
        GAS unsigned long long* o8 = (GAS unsigned long long*)(XN + (size_t)m * D) + F.lane;
#pragma unroll
        for (int j = 0; j < 4; ++j) { const f32x4 sc = *(const f32x4*)(mb + 1024 + 4 * F.lane + 256 * j), sh = *(const f32x4*)(mb + 4 * F.lane + 256 * j);
            const f32x4 u = (v[j] - mean) * rstd * (sc + 1.0f) + sh;
            o8[64 * j] = (unsigned long long)pk2(u.x, u.y) | ((unsigned long long)pk2(u.z, u.w) << 32); }
    }
}
__device__ __forceinline__ void p_ln1_rows(const Args& a, const Ctx& F) {
    const int gw = F.vcu * NWAVES + F.wave, NGW = F.G * NWAVES; const float* mod = (const float*)(a.ws + WS_MOD); bf16* XN = (bf16*)(a.ws + WS_XN); float* stats = (float*)(a.ws + WS_STATS);
    for (int m = gw; m < T; m += NGW) {
        GAS f32x4* vr = (GAS f32x4*)(a.out + (size_t)m * D) + F.lane; const float* mb = mod + (size_t)(m >> 11) * 6144;
        f32x4 v[4];
#pragma unroll
        for (int j = 0; j < 4; ++j) v[j] = vr[64 * j];
        float mean, rstd; ln_stats(v, mean, rstd);
#pragma unroll
        for (int j = 0; j < 4; ++j) { const f32x4 lg = *(const f32x4*)(a.ln1_g + 4 * F.lane + 256 * j), lb = *(const f32x4*)(a.ln1_b + 4 * F.lane + 256 * j); v[j] = (v[j] - mean) * rstd * lg + lb; vr[64 * j] = v[j]; }
        ln_stats(v, mean, rstd);
        if (F.lane == 0) { stats[(size_t)m * 2] = mean; stats[(size_t)m * 2 + 1] = rstd; }
        GAS unsigned long long* o8 = (GAS unsigned long long*)(XN + (size_t)m * D) + F.lane;
#pragma unroll
        for (int j = 0; j < 4; ++j) { const f32x4 sc = *(const f32x4*)(mb + 4096 + 4 * F.lane + 256 * j), sh = *(const f32x4*)(mb + 3072 + 4 * F.lane + 256 * j);
            const f32x4 u = (v[j] - mean) * rstd * (sc + 1.0f) + sh;
            o8[64 * j] = (unsigned long long)pk2(u.x, u.y) | ((unsigned long long)pk2(u.z, u.w) << 32); }
    }
}
__device__ __forceinline__ unsigned fkey(float v) { const unsigned u = __float_as_uint(v + 0.0f);   return u ^ ((unsigned)((int)u >> 31) | 0x80000000u); }
__device__ __forceinline__ void half_sums(int v, int& s0, int& s1) {
    v += __builtin_amdgcn_update_dpp(0, v, 0x111, 0xf, 0xf, true); v += __builtin_amdgcn_update_dpp(0, v, 0x112, 0xf, 0xf, true);
    v += __builtin_amdgcn_update_dpp(0, v, 0x114, 0xf, 0xf, true); v += __builtin_amdgcn_update_dpp(0, v, 0x118, 0xf, 0xf, true);
    v += __builtin_amdgcn_update_dpp(0, v, 0x142, 0xa, 0xf, false);
    s0 = __builtin_amdgcn_readlane(v, 31); s1 = __builtin_amdgcn_readlane(v, 63);
}
__device__ __forceinline__ void idx_unit(const Args& a, const Ctx& F, int b, int c, int g) {
    const bf16* QI = (const bf16*)(a.ws + WS_QI); const bf16* KI = (const bf16*)(a.ws + WS_KI); const float* WI = (const float*)(a.ws + WS_WI);
    unsigned long long* SEL = (unsigned long long*)(a.ws + WS_SEL);
    const int lane = F.lane, wid = F.wave;
    const int L = 64 * (c + 1), t0 = b * SEQ + 64 * c + 16 * g + 2 * wid, kq = lane & 15, q = lane >> 4, tl = q >> 1, par = q & 1;
    if (c < 4) {
        const int w = lane & 31; SEL[(size_t)(t0 + (lane >> 5)) * 32 + w] = (64 * w + 64 <= L) ? ~0ull : 0ull; return; }
    bf16x8 af[2];
    { const int r = lane & 15; const bf16* qrow = QI + (size_t)(t0 + (r >> 3)) * 512 + (r & 7) * 64 + 8 * q; af[0] = *(const bf16x8*)qrow; af[1] = *(const bf16x8*)(qrow + 32); }
    const f32x4 wv = *(const f32x4*)(WI + (size_t)(t0 + tl) * 8 + 4 * par);
    const int ntile = L >> 4, nkb = (L + 255) >> 8;
    const bf16* kb0 = KI + (size_t)b * SEQ * 64;
    const unsigned lds0 = (unsigned)(uintptr_t)(unsigned char*)F.lds;
#define IDX_DMA(blk) do { _Pragma("unroll") for (int i_ = 0; i_ < 4; ++i_) { const int p_ = wid * 256 + i_ * 64 + lane, row_ = p_ >> 3; int kr_ = (blk) * 256 + row_; kr_ = kr_ < L ? kr_ : L - 1; \
        attn_body::glds16(kb0 + (size_t)kr_ * 64 + (((p_ & 7) ^ (row_ & 7)) << 3), (unsigned)__builtin_amdgcn_readfirstlane(lds0 + (((blk) & 3) << 15) + (wid * 256 + i_ * 64) * 16)); } } while (0)
    const bool pr_nodma = (a.flags & 16) != 0, pr_nocomp = (a.flags & 8) != 0;
    if (!pr_nodma) { IDX_DMA(0); if (nkb > 1) IDX_DMA(1); if (nkb > 2) IDX_DMA(2); }
    const int sw0 = ((q ^ (kq & 7)) << 4), sw1 = (((4 + q) ^ (kq & 7)) << 4);
    unsigned key[64];
#pragma unroll
    for (int e = 0; e < 64; ++e) key[e] = 0u;
#pragma unroll
    for (int blk = 0; blk < 8; ++blk) {
        if (blk < nkb) {
            const int ahead = (nkb - 1 - blk) < 2 ? (nkb - 1 - blk) : 2;
            if (ahead == 2) asm volatile("s_waitcnt vmcnt(8)" ::: "memory"); else if (ahead == 1) asm volatile("s_waitcnt vmcnt(4)" ::: "memory"); else asm volatile("s_waitcnt vmcnt(0)" ::: "memory");
            asm volatile("s_waitcnt lgkmcnt(0)\n\ts_barrier" ::: "memory");
            if (blk + 3 < nkb && !pr_nodma) IDX_DMA(blk + 3);
            const LAS unsigned char* kbuf = F.lds + ((blk & 3) << 15) + kq * 128;
            if (!pr_nocomp)
#pragma unroll
            for (int hb = 0; hb < 2; ++hb) {
                f32x4 acc[8];
#pragma unroll
                for (int j = 0; j < 8; ++j) { const bf16x8 b0 = *(const LAS bf16x8*)(kbuf + (hb * 8 + j) * 2048 + sw0); acc[j] = __builtin_amdgcn_mfma_f32_16x16x32_bf16(af[0], b0, (f32x4){0.f, 0.f, 0.f, 0.f}, 0, 0, 0); }
#pragma unroll
                for (int j = 0; j < 8; ++j) { const bf16x8 b1 = *(const LAS bf16x8*)(kbuf + (hb * 8 + j) * 2048 + sw1); acc[j] = __builtin_amdgcn_mfma_f32_16x16x32_bf16(af[1], b1, acc[j], 0, 0, 0); }
#pragma unroll
                for (int jj = 0; jj < 4; ++jj) { float pe[2];
#pragma unroll
                    for (int h2 = 0; h2 < 2; ++h2) { const f32x4 ac = acc[2 * jj + h2];
                        float p = wv[0] * __builtin_amdgcn_fmed3f(ac[0], 0.f, INFINITY) + wv[1] * __builtin_amdgcn_fmed3f(ac[1], 0.f, INFINITY) + wv[2] * __builtin_amdgcn_fmed3f(ac[2], 0.f, INFINITY) + wv[3] * __builtin_amdgcn_fmed3f(ac[3], 0.f, INFINITY);
                        { auto rr = __builtin_amdgcn_permlane16_swap(__float_as_uint(p), __float_as_uint(p), false, false); p = __uint_as_float(rr[0]) + __uint_as_float(rr[1]); } pe[h2] = p; }
                    const int kt0 = blk * 16 + hb * 8 + 2 * jj; const float s = par ? pe[1] : pe[0];
                    const unsigned vm = (unsigned)-(int)(kt0 < ntile);
                    key[blk * 8 + hb * 4 + jj] = fkey(s) & vm; }
            }
        }
    }
#undef IDX_DMA
    asm volatile("s_waitcnt lgkmcnt(0)\n\ts_barrier" ::: "memory");
    if (a.flags & 4) { SEL[(size_t)(t0 + tl) * 32 + (lane & 31)] = key[0] + key[17] + key[63]; return; }
    const int nblk = (ntile + 15) >> 4;
    unsigned T0 = 0u, T1 = 0u; bool d0 = false, d1 = false;
    for (int bit = 31; bit >= 0; --bit) {
        const unsigned bm = 1u << bit; const unsigned cand = tl ? (T1 | bm) : (T0 | bm); int cnt = 0;
#pragma unroll
        for (int blk = 0; blk < 8; ++blk) if (blk < nblk) {
#pragma unroll
            for (int e = 0; e < 8; ++e) cnt += (key[blk * 8 + e] >= cand) ? 1 : 0; }
        int s0, s1; half_sums(cnt, s0, s1);
        if (!d0 && s0 >= 256) T0 |= bm;
        if (!d1 && s1 >= 256) T1 |= bm;
        d0 = d0 || (s0 == 256); d1 = d1 || (s1 == 256);
        if (d0 && d1) break;
    }
    const unsigned Tk = tl ? T1 : T0; const int l32 = lane & 31; unsigned myw_lo = 0u, myw_hi = 0u;
    if (d0 && d1) {
#pragma unroll
        for (int e = 0; e < 64; ++e) { const unsigned long long sm = __ballot(key[e] >= Tk); const unsigned smh = tl ? (unsigned)(sm >> 32) : (unsigned)sm;
            if (l32 == (e >> 1)) { if (e & 1) myw_hi = smh; else myw_lo = smh; } }
    } else {
        int cg = 0;
#pragma unroll
        for (int e = 0; e < 64; ++e) cg += (key[e] > Tk) ? 1 : 0;
        int g0, g1; half_sums(cg, g0, g1);
        const int need = 256 - (tl ? g1 : g0); int taken = 0;
#pragma unroll
        for (int e = 0; e < 64; ++e) {
            const bool eq = key[e] == Tk; const unsigned long long em = __ballot(eq); const unsigned emh = tl ? (unsigned)(em >> 32) : (unsigned)em;
            const int rank = __builtin_popcount(emh & ((1u << l32) - 1u));
            const bool s = (key[e] > Tk) || (eq && (taken + rank < need)); const unsigned long long sm = __ballot(s); const unsigned smh = tl ? (unsigned)(sm >> 32) : (unsigned)sm;
            taken += __builtin_popcount(emh);
            if (l32 == (e >> 1)) { if (e & 1) myw_hi = smh; else myw_lo = smh; } }
    }
    SEL[(size_t)(t0 + tl) * 32 + l32] = ((unsigned long long)myw_hi << 32) | myw_lo;
}

__device__ __forceinline__ void router_unit(const Args& a, const Ctx& F, int tb) {
    const float* X1 = a.out; const float* mod = (const float*)(a.ws + WS_MOD);
    LAS f32x2* stl = (LAS f32x2*)(F.lds + 33792 + 32768 + 33280);
    {
        bf16* XN = (bf16*)(a.ws + WS_XN);
        for (int j = 0; j < 8; ++j) { const int m = tb * 64 + F.wave * 8 + j;
            GAS f32x4* vr = (GAS f32x4*)(a.out + (size_t)m * D) + F.lane; const float* mbr = mod + (size_t)(m >> 11) * 6144;
            f32x4 v[4];
#pragma unroll
            for (int jj = 0; jj < 4; ++jj) v[jj] = vr[64 * jj];
            float mean, rstd; ln_stats(v, mean, rstd);
#pragma unroll
            for (int jj = 0; jj < 4; ++jj) { const f32x4 lg = *(const f32x4*)(a.ln1_g + 4 * F.lane + 256 * jj), lb = *(const f32x4*)(a.ln1_b + 4 * F.lane + 256 * jj); v[jj] = (v[jj] - mean) * rstd * lg + lb; vr[64 * jj] = v[jj]; }
            ln_stats(v, mean, rstd);
            if (F.lane == 0) stl[F.wave * 8 + j] = (f32x2){mean, rstd};
            GAS unsigned long long* o8 = (GAS unsigned long long*)(XN + (size_t)m * D) + F.lane;
#pragma unroll
            for (int jj = 0; jj < 4; ++jj) { const f32x4 sc = *(const f32x4*)(mbr + 4096 + 4 * F.lane + 256 * jj), sh = *(const f32x4*)(mbr + 3072 + 4 * F.lane + 256 * jj);
                const f32x4 u = (v[jj] - mean) * rstd * (sc + 1.0f) + sh;
                o8[64 * jj] = (unsigned long long)pk2(u.x, u.y) | ((unsigned long long)pk2(u.z, u.w) << 32); }
        }
        VM_WAIT(); LDS_WAIT(); __syncthreads();
    }
    unsigned* ctl = (unsigned*)(a.ws + WS_CTL); unsigned* ER = (unsigned*)(a.ws + WS_TAB + TAB_ER); float* RW = (float*)(a.ws + WS_TAB + TAB_W); unsigned short* LIST = (unsigned short*)(a.ws + WS_TAB + TAB_LIST);
    const int t0 = tb * 64, b = t0 >> 11, lane = F.lane, wid = F.wave, tid = F.tid;
    LAS float* U = (LAS float*)F.lds;
    LAS float* Wc = (LAS float*)(F.lds + 33792);
    LAS float* Lg = (LAS float*)(F.lds + 33792 + 32768);
    const float* mb = mod + (size_t)b * 6144;
    const int rh = wid & 1, eh = (wid >> 1) & 1, kh = wid >> 2, r32 = lane & 31, kk = lane >> 5;
    f32x16 acc = f32x16{};
    const int urow = tid >> 3, ucol = (tid & 7) * 16; const f32x2 st = stl[urow];
    for (int kc = 0; kc < 8; ++kc) {
        const int k0 = kc * 128;
#pragma unroll
        for (int q = 0; q < 4; ++q) { const int k = k0 + ucol + 4 * q; const f32x4 xv = __builtin_nontemporal_load((const f32x4*)(X1 + (size_t)(t0 + urow) * 1024 + k));
            const f32x4 sc = *(const f32x4*)(mb + 4096 + k), sh = *(const f32x4*)(mb + 3072 + k); const f32x4 u = (xv - st.x) * st.y * (sc + 1.0f) + sh;
            LAS float* d = U + urow * 129 + ucol + 4 * q; d[0] = u.x; d[1] = u.y; d[2] = u.z; d[3] = u.w; }
#pragma unroll
        for (int q = 0; q < 4; ++q) { const int idx = tid * 16 + 4 * q; *(LAS f32x4*)(Wc + idx) = *(const f32x4*)(a.w_router + (size_t)k0 * 64 + idx); }
        LDS_WAIT(); __syncthreads();
#pragma unroll 8
        for (int s = 0; s < 32; ++s) { const int k = kh * 64 + 2 * s + kk;
            acc = __builtin_amdgcn_mfma_f32_32x32x2f32(U[(rh * 32 + r32) * 129 + k], Wc[k * 64 + eh * 32 + r32], acc, 0, 0, 0); }
        LDS_WAIT(); __syncthreads();
    }
#pragma unroll
    for (int i = 0; i < 16; ++i) { const int row = (i & 3) + 8 * (i >> 2) + 4 * kk; Lg[(kh * 64 + rh * 32 + row) * 65 + eh * 32 + r32] = acc[i]; }
    LDS_WAIT(); __syncthreads();
    for (int j = 0; j < 8; ++j) { const int tl = wid * 8 + j, t = t0 + tl; const int e = lane;
        const float logit = Lg[tl * 65 + e] + Lg[(64 + tl) * 65 + e];
        const float aff = 1.0f / (1.0f + __expf(-logit)); const float bsd = aff + a.router_bias[e];
        float m1 = bsd; m1 = __builtin_fmaxf(m1, __shfl_xor(m1, 1)); m1 = __builtin_fmaxf(m1, __shfl_xor(m1, 2)); m1 = __builtin_fmaxf(m1, __shfl_xor(m1, 4));
        const unsigned long long em = __ballot(bsd == m1); const int g = e >> 3; const unsigned gm = (unsigned)(em >> (8 * g)) & 0xffu; const int first = 8 * g + __builtin_ctz(gm);
        float m2 = (e == first) ? -INFINITY : bsd; m2 = __builtin_fmaxf(m2, __shfl_xor(m2, 1)); m2 = __builtin_fmaxf(m2, __shfl_xor(m2, 2)); m2 = __builtin_fmaxf(m2, __shfl_xor(m2, 4));
        const float gs = m1 + m2; int grank = 0;
#pragma unroll
        for (int g2 = 0; g2 < 8; ++g2) { const float s2 = __uint_as_float(__builtin_amdgcn_readlane(__float_as_uint(gs), 8 * g2)); grank += (s2 > gs || (s2 == gs && g2 < g)) ? 1 : 0; }
        const bool gsel = grank < 4; const float mv = gsel ? bsd : -INFINITY; int rk = 0;
#pragma unroll
        for (int e2 = 0; e2 < 64; ++e2) { const float v = __uint_as_float(__builtin_amdgcn_readlane(__float_as_uint(mv), e2)); rk += (v > mv || (v == mv && e2 < e)) ? 1 : 0; }
        const bool sel = gsel && rk < 8; const float sa = wave_sum(sel ? aff : 0.f);
        if (sel) { const int chunk = t / CHTOK, tk = t - chunk * CHTOK;
            const unsigned r = __hip_atomic_fetch_add(ctl + CW_CNT + (chunk * 64 + e) * 16, 1u, RLX_AGENT);
            ER[(size_t)t * 8 + rk] = ((unsigned)e << 16) | r; RW[(size_t)t * 8 + rk] = aff / sa;
            LIST[((size_t)chunk * 64 + e) * 8192 + r] = (unsigned short)((tk << 3) | rk); }
    }
    LDS_WAIT(); __syncthreads();
}

__device__ __forceinline__ void combine_rows(const Args& a, const Ctx& F, int chunk, const LAS int* xt) {
    const int gw = F.vcu * NWAVES + F.wave, NGW = F.G * NWAVES; const float* mod = (const float*)(a.ws + WS_MOD); const bf16* Y = (const bf16*)(a.ws + WS_YEXP);
    const unsigned* ER = (const unsigned*)(a.ws + WS_TAB + TAB_ER);
    for (int m = chunk * CHTOK + gw; m < (chunk + 1) * CHTOK; m += NGW) {
        GAS f32x4* zr = (GAS f32x4*)(a.out + (size_t)m * D) + F.lane; const float* g2 = mod + (size_t)(m >> 11) * 6144 + 5120;
        f32x4 y[4];
#pragma unroll
        for (int j = 0; j < 4; ++j) y[j] = (f32x4){0.f, 0.f, 0.f, 0.f};
#pragma unroll
        for (int s = 0; s < 8; ++s) { const unsigned er = ER[(size_t)m * 8 + s]; const int pos = xt[144 + (int)(er >> 16)] + (int)(er & 0xffffu);
            const v2u* yr = (const v2u*)(Y + (size_t)pos * 1024) + F.lane;
#pragma unroll
            for (int j = 0; j < 4; ++j) { const v2u w = yr[64 * j]; y[j].x += bflo(w.x); y[j].y += bfhi(w.x); y[j].z += bflo(w.y); y[j].w += bfhi(w.y); } }
        f32x4 v[4];
#pragma unroll
        for (int j = 0; j < 4; ++j) { const f32x4 g = *(const f32x4*)(g2 + 4 * F.lane + 256 * j); v[j] = zr[64 * j] + g * y[j]; }
        float mean, rstd; ln_stats(v, mean, rstd);
#pragma unroll
        for (int j = 0; j < 4; ++j) { const f32x4 lg = *(const f32x4*)(a.ln2_g + 4 * F.lane + 256 * j), lb = *(const f32x4*)(a.ln2_b + 4 * F.lane + 256 * j);
            zr[64 * j] = (v[j] - mean) * rstd * lg + lb; }
    }
}
#ifndef MK_N_LAUNCHES
#define MK_N_LAUNCHES 1
#endif
__global__ void __launch_bounds__(NWAVES * 64, 2) mk_fwd(Args a) {
    extern __shared__ __attribute__((aligned(16))) unsigned char lds[];
    Ctx F; F.lds = (LAS unsigned char*)lds; F.tid = threadIdx.x; F.lane = F.tid & 63; F.wave = __builtin_amdgcn_readfirstlane(F.tid >> 6);
    F.G = gridDim.x; { const int bx = blockIdx.x; F.vcu = (F.G % 8 == 0) ? (bx % 8) * (F.G / 8) + bx / 8 : bx; }
    volatile LAS unsigned* MISC = (volatile LAS unsigned*)(F.lds + MISC_OFF);
    LAS int* xt = (LAS int*)(F.lds + XTAB_OFF);
    unsigned char* ws = a.ws; unsigned* ctl = (unsigned*)(ws + WS_CTL);
    for (int u = F.tid; u < (LDS_BYTES - LDSCTL_OFF) / 4; u += NWAVES * 64) ((LAS unsigned*)(F.lds + LDSCTL_OFF))[u] = 0u;
    __syncthreads();
    const int lo = a.ph_lo, hi = a.ph_hi;
    XcdBarrier bar; bar.bar = ctl + CW_BAR; bar.x = 0; bar.st = nullptr;
    if (hi - lo > 1) bar = xcd_barrier_post(ctl + CW_BAR, MISC + 8);
#ifndef PHM
#define PHM 0xffff
#endif
#define IN(k) (((PHM >> (k)) & 1) && lo <= (k) && (k) < hi)
#define SEAM(k) do { if (IN(k) && IN((k) + 1)) xcd_barrier(bar); { int t_ = threadIdx.x; asm volatile("" : "+v"(t_)); F.tid = t_; F.lane = t_ & 63; F.wave = __builtin_amdgcn_readfirstlane(t_ >> 6); } } while (0)
    const float* mod = (const float*)(ws + WS_MOD);
    bf16* XN = (bf16*)(ws + WS_XN);

    if (IN(0)) { p0_prologue(a, F); } SEAM(0);
    if (IN(1)) { p1_ln_mod(a, F); } SEAM(1);
    if (IN(2)) {
        pg8::Gemm g{XN, 1024}; pg8::DenseOrder S; S.init(T, DINP, 1024, ws + WS_WIN, F.G, (int)blockIdx.x);
        EpiInProj E{ws, (bf16*)a.out, (const float*)(ws + WS_ROPE), (const float*)(ws + WS_ROPE) + (size_t)T * 8, a.ikn_g, a.ikn_b};
        pg8::gemm_phase<EpiInProj, pg8::DenseOrder, true>(F.lds + RING_OFF, g, S, E);
    } SEAM(2);
    if (IN(3)) {
        if (!(a.flags & 1)) for (int uix = F.vcu; uix < 1024; uix += F.G) { const int r = uix >> 8, w = uix & 255, b = w >> 5, i = w & 31; idx_unit(a, F, b, r < 2 ? i : 31 - i, r); }
        __syncthreads();
        if (!(a.flags & 2)) for (int uix = F.vcu; uix < 512; uix += F.G) { const int r = uix >> 8, w = uix & 255, bh = w >> 2, s = w & 3; const int qb = s == 0 ? (r ? 2 : 0) : s == 1 ? (r ? 3 : 1) : s == 2 ? (r ? 5 : 4) : (r ? 7 : 6);
            attn_body::attn_unit<0, 8>(bh >> 3, bh & 7, qb, (const attn_body::bf16*)(ws + WS_QA), (const attn_body::bf16*)(ws + WS_KA), (const attn_body::bf16*)(ws + WS_VA), (attn_body::bf16*)(ws + WS_QA), a.rel_bias, (char*)lds + RING_OFF); }
    } SEAM(3);
    if (IN(4)) {
        for (int uix = F.vcu; uix < 512; uix += F.G) { const int r = uix >> 8, w = uix & 255, bh = w >> 2, s = w & 3; const int qb = r ? 7 - s : s;
            attn_body::attn_unit<1, 8>(bh >> 3, bh & 7, qb, (const attn_body::bf16*)(ws + WS_QB), (const attn_body::bf16*)(ws + WS_KB), (const attn_body::bf16*)(ws + WS_VB), (attn_body::bf16*)(ws + WS_QB), ws + WS_SEL, (char*)lds + RING_OFF); }
    } SEAM(4);
    if (IN(5)) {
        { pg8::Gemm g{(const bf16*)(ws + WS_QA), 512}; pg8::DenseOrder S; S.init(T, 1024, 512, ws + WS_WA, F.G, (int)blockIdx.x);
          EpiGate<1> E{(const bf16*)a.out, (float*)(ws + WS_TMP), (bf16*)(ws + WS_MERGED)}; pg8::gemm_phase<EpiGate<1>, pg8::DenseOrder, true>(F.lds + RING_OFF, g, S, E); }
        VM_WAIT(); __syncthreads();
        { pg8::Gemm g{(const bf16*)(ws + WS_QB), 512}; pg8::DenseOrder S; S.init(T, 1024, 512, ws + WS_WB, F.G, (int)blockIdx.x);
          EpiGate<2> E{(const bf16*)a.out, (float*)(ws + WS_TMP), (bf16*)(ws + WS_MERGED)}; pg8::gemm_phase<EpiGate<2>, pg8::DenseOrder, true>(F.lds + RING_OFF, g, S, E); }
    } SEAM(5);
    if (IN(6)) {
        pg8::Gemm g{(const bf16*)(ws + WS_MERGED), 1024}; pg8::DenseOrder S; S.init(T, 1024, 1024, ws + WS_WOUT, F.G, (int)blockIdx.x);
        EpiResid E{a.x, a.out, mod}; pg8::gemm_phase<EpiResid, pg8::DenseOrder, true>(F.lds + RING_OFF, g, S, E);
    } SEAM(6);
    if (IN(7)) {
        for (int tb = F.vcu; tb < T / 64; tb += F.G) router_unit(a, F, tb);
    } SEAM(7);
#pragma unroll 1
    for (int ch = 0; ch < NCHUNK; ++ch) {
        const int pgu = 8 + 2 * ch, pd = 9 + 2 * ch;
        if (IN(pgu)) {
            if (ch > 0) { build_xtab(xt, ctl, ch - 1); combine_rows(a, F, ch - 1, xt); __syncthreads(); }
            build_xtab(xt, ctl, ch);
            { pg8::Gemm g{XN, 1024}; ExpertOrder<0> S{xt, 2, F.G, F.vcu, __builtin_amdgcn_readfirstlane(xt[64]), ch, (const unsigned short*)(ws + WS_TAB + TAB_LIST) + (size_t)ch * 64 * 8192, (const char*)(ws + WS_EGU), (size_t)512 * 1024 * 2, (size_t)256 * 1024 * 2};
              EpiExpGU E{(bf16*)(ws + WS_HEXP), xt, (const unsigned short*)(ws + WS_TAB + TAB_LIST) + (size_t)ch * 64 * 8192, (const float*)(ws + WS_TAB + TAB_W), ch};
              pg8::gemm_phase<EpiExpGU, ExpertOrder<0>, true>(F.lds + RING_OFF, g, S, E); }
            if (ch == 0) { VM_WAIT(); __syncthreads();
              pg8::Gemm g{XN, 1024}; pg8::DenseOrder S; S.init(T, 512, 1024, ws + WS_SHGU, F.G, F.G - 1 - F.vcu);
              EpiSilu E{(bf16*)(ws + WS_HSH)}; pg8::gemm_phase<EpiSilu, pg8::DenseOrder, true>(F.lds + RING_OFF, g, S, E); }
        } SEAM(pgu);
        if (IN(pd)) {
            build_xtab(xt, ctl, ch);
            { pg8::Gemm g{(const bf16*)(ws + WS_HEXP), 256}; ExpertOrder<1> S{xt, 4, F.G, F.vcu, __builtin_amdgcn_readfirstlane(xt[64]), ch, nullptr, (const char*)(ws + WS_ED), (size_t)1024 * 256 * 2, (size_t)256 * 256 * 2};
              EpiExpD E{(bf16*)(ws + WS_YEXP), xt}; pg8::gemm_phase<EpiExpD, ExpertOrder<1>, true>(F.lds + RING_OFF, g, S, E); }
            if (ch == 0) { VM_WAIT(); __syncthreads();
              pg8::Gemm g{(const bf16*)(ws + WS_HSH), 256}; pg8::DenseOrder S; S.init(T, 1024, 256, ws + WS_SHD, F.G, F.G - 1 - F.vcu);
              EpiShD E{a.out, mod}; pg8::gemm_phase<EpiShD, pg8::DenseOrder, true>(F.lds + RING_OFF, g, S, E); }
        } SEAM(pd);
    }
    if (IN(12)) { build_xtab(xt, ctl, NCHUNK - 1); combine_rows(a, F, NCHUNK - 1, xt); }
#undef IN
#undef SEAM
}
extern "C" void kernel_launch(void* const* d_in, const int* in_sizes, int n_in, void* d_out, int out_size, void* d_ws, size_t ws_size, hipStream_t stream) {
    static int grid = 0;
    if (grid == 0) {
        if (n_in != 24 || in_sizes[0] != T * D || out_size != T * D || ws_size < WS_END) { fprintf(stderr, "kernel_launch: unexpected shapes (n_in %d, in0 %d, out %d, ws %zu, need %zu); nothing launched\n", n_in, n_in > 0 ? in_sizes[0] : -1, out_size, ws_size, (size_t)WS_END); grid = -1; return; }
        int dev = 0, cus = 0, per_cu = 0;
        if (hipGetDevice(&dev) != hipSuccess || hipDeviceGetAttribute(&cus, hipDeviceAttributeMultiprocessorCount, dev) != hipSuccess) { grid = -1; return; }
        if (hipFuncSetAttribute((const void*)mk_fwd, hipFuncAttributeMaxDynamicSharedMemorySize, LDS_BYTES) != hipSuccess) { fprintf(stderr, "kernel_launch: hipFuncSetAttribute failed\n"); grid = -1; return; }
        if (hipOccupancyMaxActiveBlocksPerMultiprocessor(&per_cu, (const void*)mk_fwd, NWAVES * 64, LDS_BYTES) != hipSuccess || per_cu < 1) { fprintf(stderr, "kernel_launch: occupancy query reports %d\n", per_cu); per_cu = 1; }
        (void)hipGetLastError();
        grid = cus * 1;
        if (grid != 256) fprintf(stderr, "kernel_launch: %d CUs; this kernel is built for 256\n", grid);
    }
    if (grid < 0) return;
    (void)hipMemsetAsync((char*)d_ws + WS_CTL, 0, CTL_ZERO_BYTES, stream);
    Args a{};
    a.x = (const float*)d_in[0]; a.c = (const float*)d_in[1]; a.positions = (const int*)d_in[2]; a.w_ada = (const float*)d_in[3]; a.b_ada = (const float*)d_in[4]; a.w_in = (const float*)d_in[5];
    a.rel_bias = (const float*)d_in[6]; a.ikn_g = (const float*)d_in[7]; a.ikn_b = (const float*)d_in[8]; a.w_branch_a = (const float*)d_in[9]; a.w_branch_b = (const float*)d_in[10]; a.w_out = (const float*)d_in[11];
    a.ln1_g = (const float*)d_in[12]; a.ln1_b = (const float*)d_in[13]; a.w_router = (const float*)d_in[14]; a.router_bias = (const float*)d_in[15]; a.w_exp_gate = (const float*)d_in[16]; a.w_exp_up = (const float*)d_in[17];
    a.w_exp_down = (const float*)d_in[18]; a.w_sh_gate = (const float*)d_in[19]; a.w_sh_up = (const float*)d_in[20]; a.w_sh_down = (const float*)d_in[21]; a.ln2_g = (const float*)d_in[22]; a.ln2_b = (const float*)d_in[23];
    a.out = (float*)d_out; a.ws = (unsigned char*)d_ws;
    for (int j = 0; j < 8; ++j) { const float inv = (float)std::pow(500000.0, -(double)(2 * j) / 16.0); a.inv_freq_rev[j] = (double)inv / 6.283185307179586476925286766559; }
    auto run = [&](int lo, int hi, int flags) { a.ph_lo = lo; a.ph_hi = hi; a.li = 0; a.flags = flags; hipLaunchKernelGGL(mk_fwd, dim3(grid), dim3(NWAVES * 64), LDS_BYTES, stream, a); };
#if defined(PROBE_K)
#ifndef PROBE_FLAGS
#define PROBE_FLAGS 0
#endif
    run(0, PROBE_K + 1, PROBE_FLAGS);
    (void)hipMemsetAsync((char*)d_ws + WS_CTL, 0, CTL_ZERO_BYTES, stream);
    run(0, NPHASE, 0);
#elif MK_NAIVE_MASK == 0 && MK_N_LAUNCHES == 1
    run(0, NPHASE, 0);
#elif MK_NAIVE_MASK == 0
    for (int k = 0; k < NPHASE; ++k) run(k, k + 1, 0);
#else
    constexpr int mask = MK_NAIVE_MASK;
    a.flags = 0;
    run(0, 1, 0); run(1, 2, 0);
    if (mask & 1) hipLaunchKernelGGL(nv_inproj, dim3(12, T), dim3(256), 0, stream, a); else run(2, 3, 0);
    run(3, 4, 0);
    run(4, 5, ((mask & 2) ? 1 : 0) | ((mask & 4) ? 2 : 0));
    if (mask & 2) hipLaunchKernelGGL(nv_index, dim3(T), dim3(256), 0, stream, a);
    if (mask & 4) { hipLaunchKernelGGL(nv_attn<0>, dim3(T * 8 / 4), dim3(256), 0, stream, a); hipLaunchKernelGGL(nv_copy_o, dim3(T * 512 * 2 / 16 / 256), dim3(256), 0, stream, a, 0); }
    if (mask & 8) { hipLaunchKernelGGL(nv_attn<1>, dim3(T * 8 / 4), dim3(256), 0, stream, a); hipLaunchKernelGGL(nv_copy_o, dim3(T * 512 * 2 / 16 / 256), dim3(256), 0, stream, a, 1); } else run(5, 6, 0);
    if (mask & 16) hipLaunchKernelGGL(nv_merge, dim3(2, T), dim3(256), 0, stream, a); else run(6, 7, 0);
    if (mask & 32) { hipLaunchKernelGGL(nv_outproj, dim3(2, T), dim3(256), 0, stream, a); hipLaunchKernelGGL(nv_ln1, dim3(T / 4), dim3(256), 0, stream, a); } else { run(7, 8, 0); run(8, 9, 0); }
    run(9, 10, 0);
    if (mask & 64) hipLaunchKernelGGL(nv_shgu, dim3(1, T), dim3(256), 0, stream, a);
    if (mask & 128) { hipLaunchKernelGGL(nv_expgu, dim3(T * 8), dim3(256), 0, stream, a); hipLaunchKernelGGL(nv_down, dim3(4, T), dim3(256), 0, stream, a); hipLaunchKernelGGL(nv_ln2, dim3(T / 4), dim3(256), 0, stream, a); }
    else { for (int k = 10; k < NPHASE; ++k) run(k, k + 1, 0); }
#endif
}
```

```cpp
#include <hip/hip_runtime.h>
#include <hip/hip_bf16.h>
#include <cstdio>
#include <cstdint>
#include <cmath>
#ifndef MK_NAIVE_MASK
#define MK_NAIVE_MASK 0
#endif
namespace pg8 {
#define PG8_LAS __attribute__((address_space(3)))
typedef unsigned short bf16_t;
typedef short bf16x8 __attribute__((ext_vector_type(8)));
typedef float f32x4 __attribute__((ext_vector_type(4)));
typedef float f32x2 __attribute__((ext_vector_type(2)));
typedef unsigned u32x4 __attribute__((ext_vector_type(4)));
typedef unsigned u32x2 __attribute__((ext_vector_type(2)));
constexpr int BM = 256, BK = 64, HALF = 128, HTB = HALF * BK * 2  , STAGE_BYTES = 8 * HTB, NXCD = 8, WGM = 8;

__host__ __device__ __forceinline__ int lds_byte(int r, int c) { const int st = (r >> 4) * 2 + (c >> 5), rr = r & 15, cc = c & 31, ob = rr * 64 + cc * 2; return st * 1024 + (ob ^ (((ob >> 9) & 1) << 5)); }
__host__ __device__ __forceinline__ void stage_rc(int b, int& R, int& C) { const int st = b / 1024, sb = b % 1024, swz = sb ^ (((sb >> 9) & 1) << 5); R = (st >> 1) * 16 + swz / 64; C = (st & 1) * 32 + (swz % 64) / 2; }
__host__ __device__ __forceinline__ int perm32(int rho) { const int n = rho >> 4, i = rho & 15; return 8 * (i >> 2) + 4 * n + (i & 3); }

struct Unit { int pm, pn, e, nrows; };

struct DenseOrder {
    int nM, nN, nwg, G, c; unsigned arow; const char* Bt; size_t btile;
    __device__ void init(int M, int N, int K, const void* Bt_, int G_, int c_) { nM = M / BM; nN = N / BM; nwg = nM * nN; G = G_; c = c_; arow = (unsigned)K * 2u; Bt = (const char*)Bt_; btile = (size_t)BM * K * 2; }
    __device__ __forceinline__ bool next(int i, Unit& u) const {
        const long L = (long)i * G + c; if (L >= nwg) return false;
        int wgid = (int)L; { const int q = nwg / NXCD, r = nwg % NXCD, xcd = wgid % NXCD, off = wgid / NXCD; wgid = (xcd < r ? xcd * (q + 1) : r * (q + 1) + (xcd - r) * q) + off; }
        const int nig = WGM * nN, gid = wgid / nig, fm = gid * WGM, gsz = (nM - fm) < WGM ? (nM - fm) : WGM;
        u.pm = fm + ((wgid % nig) % gsz); u.pn = (wgid % nig) / gsz; u.e = 0; u.nrows = 256; return true;
    }
    static constexpr bool UNIFORM_A = true;
    __device__ __forceinline__ size_t a_base(const Unit& u) const { return (size_t)(u.pm * BM) * arow; }
    __device__ __forceinline__ unsigned a_rel(int row) const { return (unsigned)row * arow; }
    __device__ __forceinline__ unsigned a_off(const Unit& u, int row) const { return (unsigned)(u.pm * BM + row) * arow; }
    __device__ __forceinline__ const char* b_ptr(const Unit& u) const { return Bt + (size_t)u.pn * btile; }
};

__device__ __forceinline__ unsigned cvt_pk_bf16(float lo, float hi) { unsigned r; asm volatile("v_cvt_pk_bf16_f32 %0, %1, %2" : "=v"(r) : "v"(lo), "v"(hi)); return r; }

struct PanelStats {
    unsigned* xbuf;
    unsigned* cnt;
    unsigned* tmo;
    int ntn; float eps;
    unsigned code;
    __device__ __forceinline__ bool run(const f32x4 (&v)[2][2][4][2], const Unit& u, int wr, int wc, int fr, int fq, PG8_LAS unsigned char* lds, int wid, int lane) const {
        typedef float f32x2v __attribute__((ext_vector_type(2)));
        PG8_LAS f32x2v* P = (PG8_LAS f32x2v*)lds;
        PG8_LAS f32x2v* S = (PG8_LAS f32x2v*)(lds + 8192);
        PG8_LAS unsigned* flag = (PG8_LAS unsigned*)(lds + 8192 + 2048);
#pragma unroll
        for (int ai = 0; ai < 2; ++ai)
#pragma unroll
            for (int m = 0; m < 4; ++m) {
                float s = 0.f;
#pragma unroll
                for (int bj = 0; bj < 2; ++bj)
#pragma unroll
                    for (int n = 0; n < 2; ++n) { const f32x4 x = v[ai][bj][m][n]; s += (x[0] + x[1]) + (x[2] + x[3]); }
                s += __shfl_xor(s, 16); s += __shfl_xor(s, 32);
                const float mw = s * (1.0f / 64.0f); float q = 0.f;
#pragma unroll
                for (int bj = 0; bj < 2; ++bj)
#pragma unroll
                    for (int n = 0; n < 2; ++n) { const f32x4 d = v[ai][bj][m][n] - mw; q += (d[0] * d[0] + d[1] * d[1]) + (d[2] * d[2] + d[3] * d[3]); }
                q += __shfl_xor(q, 16); q += __shfl_xor(q, 32);
                if (fq == 0) P[(ai * HALF + wr * 64 + m * 16 + fr) * 4 + wc] = (f32x2v){mw, q};
            }
        asm volatile("s_waitcnt lgkmcnt(0)" ::: "memory"); __builtin_amdgcn_s_barrier(); asm volatile("" ::: "memory");
        const int row = wid * 32 + (lane & 31);
        if (lane < 32) {
            const f32x2v a = P[row * 4 + 0], b = P[row * 4 + 1], c = P[row * 4 + 2], d = P[row * 4 + 3];
            const float mt = (a.x + b.x + c.x + d.x) * 0.25f;
            const float da = a.x - mt, db = b.x - mt, dc = c.x - mt, dd = d.x - mt;
            const float m2 = (a.y + b.y) + (c.y + d.y) + 64.0f * ((da * da + db * db) + (dc * dc + dd * dd));
            unsigned long long* slot = (unsigned long long*)xbuf + ((size_t)(u.pm * BM + row) * 4 + u.pn);
            __hip_atomic_store(slot, ((unsigned long long)__float_as_uint(m2) << 32) | __float_as_uint(mt), __ATOMIC_RELAXED, __HIP_MEMORY_SCOPE_AGENT);
        }
        asm volatile("s_waitcnt vmcnt(0)" ::: "memory");
        if (lane == 0) __hip_atomic_fetch_add(cnt + 64 * u.pm, 1u, __ATOMIC_RELAXED, __HIP_MEMORY_SCOPE_AGENT);
        if (wid == 0) {
            bool dead = false; const unsigned long long t0 = __builtin_amdgcn_s_memrealtime(); const unsigned want = 8u * (unsigned)ntn;
            for (;;) {
                if ((unsigned)__builtin_amdgcn_readfirstlane(__hip_atomic_load(cnt + 64 * u.pm, __ATOMIC_RELAXED, __HIP_MEMORY_SCOPE_AGENT)) >= want) break;
                if (__builtin_amdgcn_s_memrealtime() - t0 > 2000000ull) {
                    if (lane == 0) { unsigned expect = 0u; __hip_atomic_compare_exchange_strong(tmo + 1, &expect, code | (unsigned)(u.pm & 0xff), __ATOMIC_RELAXED, __ATOMIC_RELAXED, __HIP_MEMORY_SCOPE_AGENT);
                                     __hip_atomic_store(tmo, 1u, __ATOMIC_RELAXED, __HIP_MEMORY_SCOPE_AGENT); }
                    dead = true; break; }
                __builtin_amdgcn_s_sleep(2);
            }
            __builtin_amdgcn_fence(__ATOMIC_ACQUIRE, "agent");
            if (lane == 0) flag[0] = dead ? 1u : 0u;
        }
        asm volatile("s_waitcnt vmcnt(0) lgkmcnt(0)" ::: "memory"); __builtin_amdgcn_s_barrier(); asm volatile("" ::: "memory");
        const bool bad = flag[0] != 0u;
        if (lane < 32) {
            const unsigned long long* slot = (const unsigned long long*)xbuf + (size_t)(u.pm * BM + row) * 4; float mt[4], m2[4]; float ms = 0.f;
#pragma unroll
            for (int t = 0; t < 4; ++t) { if (t < ntn) { const unsigned long long w = __hip_atomic_load(slot + t, __ATOMIC_RELAXED, __HIP_MEMORY_SCOPE_AGENT); mt[t] = __uint_as_float((unsigned)w); m2[t] = __uint_as_float((unsigned)(w >> 32)); } else { mt[t] = 0.f; m2[t] = 0.f; } ms += mt[t]; }
            const float mean = ms / (float)ntn; float q = 0.f;
#pragma unroll
            for (int t = 0; t < 4; ++t) if (t < ntn) { const float dm = mt[t] - mean; q += m2[t] + 256.0f * dm * dm; }
            S[row] = (f32x2v){mean, 1.0f / sqrtf(q / (256.0f * (float)ntn) + eps)};
        }
        asm volatile("s_waitcnt lgkmcnt(0)" ::: "memory"); __builtin_amdgcn_s_barrier(); asm volatile("" ::: "memory");
        return bad;
    }
};

struct Gemm { const bf16_t* A; int K; int kbreak; unsigned kdelta; };

template <class Epi, class Sched, bool ALIGN_EPI = false>
__device__ __forceinline__ void gemm_phase(PG8_LAS unsigned char* lds, const Gemm g, const Sched& S, const Epi& E) {
    int tid_ = threadIdx.x; asm volatile("" : "+v"(tid_));
    const int tid = tid_, wid = __builtin_amdgcn_readfirstlane(tid >> 6), lane = tid & 63, wr = wid >> 2, wc = wid & 3, fr = lane & 15, fq = lane >> 4;
    const int K = g.K, nt = K / BK;
    int RA[2], CA2[2]; unsigned voffB[2];
#pragma unroll
    for (int i = 0; i < 2; ++i) { int R, C; stage_rc(tid * 16 + i * 8192, R, C); const int Rb = Epi::PERM ? ((R & ~31) + perm32(R & 31)) : R;
        RA[i] = R; CA2[i] = C * 2; voffB[i] = (unsigned)(Rb * K + C) * 2u; }
    const size_t kstep = (size_t)(BK * 2);
    const int kbreak = g.kbreak; const size_t kdelta = g.kdelta;
#define PG8_KOF(tt) ((size_t)(tt) * kstep + ((tt) >= kbreak ? kdelta : (size_t)0))
    const size_t hstep = (size_t)HALF * K * 2;
    const unsigned ldsw = (unsigned)wid * 1024u;
    const int aoff = lds_byte(wr * 64 + fr, fq * 8), boff = lds_byte(wc * 32 + fr, fq * 8);
    const char* Abase = (const char*)g.A;
#define PG8_SA(b, h) (((b) * 2 + (h)) * HTB)
#define PG8_SB(b, h) ((4 + (b) * 2 + (h)) * HTB)
#define PG8_STAGE(bufoff, gbase, voff) do { _Pragma("unroll") for (int _i = 0; _i < 2; ++_i) \
        __builtin_amdgcn_global_load_lds((const unsigned*)((const char*)(gbase) + (voff)[_i]), (PG8_LAS unsigned*)(lds + (bufoff) + ldsw + _i * 8192), 16, 0, 0); } while (0)
#define PG8_STAGEA(bufoff, offs, koff) do { _Pragma("unroll") for (int _i = 0; _i < 2; ++_i) \
        __builtin_amdgcn_global_load_lds((const unsigned*)((Abase + ub + (size_t)(koff)) + (size_t)(offs)[_i]), (PG8_LAS unsigned*)(lds + (bufoff) + ldsw + _i * 8192), 16, 0, 0); } while (0)
#define PG8_LDA(dst, b, h) do { _Pragma("unroll") for (int m = 0; m < 4; ++m) _Pragma("unroll") for (int k = 0; k < 2; ++k) dst[m][k] = *(const PG8_LAS bf16x8*)(lds + PG8_SA(b, h) + aoff + m * 2048 + k * 1024); } while (0)
#define PG8_LDB(dst, b, h) do { _Pragma("unroll") for (int n = 0; n < 2; ++n) _Pragma("unroll") for (int k = 0; k < 2; ++k) dst[n][k] = *(const PG8_LAS bf16x8*)(lds + PG8_SB(b, h) + boff + n * 2048 + k * 1024); } while (0)
#define PG8_MMA(ai, bj, At, Bt) do { __builtin_amdgcn_s_setprio(1); _Pragma("unroll") for (int m = 0; m < 4; ++m) _Pragma("unroll") for (int n = 0; n < 2; ++n) _Pragma("unroll") for (int k = 0; k < 2; ++k) \
        acc[ai][bj][m][n] = __builtin_amdgcn_mfma_f32_16x16x32_bf16(Bt[n][k], At[m][k], acc[ai][bj][m][n], 0, 0, 0); __builtin_amdgcn_s_setprio(0); } while (0)
#define PG8_WAIT_V(n) asm volatile("s_waitcnt vmcnt(" #n ")" ::: "memory")
#define PG8_WAIT_L(n) asm volatile("s_waitcnt lgkmcnt(" #n ")" ::: "memory")
#define PG8_BAR __builtin_amdgcn_s_barrier()
#define PG8_SCHED __builtin_amdgcn_sched_barrier(0)
    Unit cur, nxt; int ui = 0;
    if (!S.next(0, cur)) return;
    f32x4 acc[2][2][4][2];
#pragma unroll
    for (int a = 0; a < 2; ++a)
#pragma unroll
        for (int b = 0; b < 2; ++b)
#pragma unroll
            for (int m = 0; m < 4; ++m)
#pragma unroll
                for (int n = 0; n < 2; ++n) acc[a][b][m][n] = (f32x4){0.f, 0.f, 0.f, 0.f};
    bf16x8 At[4][2], B0[2][2], B1[2][2];
    constexpr bool UA = Sched::UNIFORM_A;
    unsigned ca0[2], ca1[2], na0[2], na1[2]; size_t ub = 0, nub = 0;
    if constexpr (UA) { ub = S.a_base(cur);
#pragma unroll
        for (int i = 0; i < 2; ++i) { ca0[i] = S.a_rel(RA[i]) + (unsigned)CA2[i]; ca1[i] = S.a_rel(HALF + RA[i]) + (unsigned)CA2[i]; } }
    else {
#pragma unroll
        for (int i = 0; i < 2; ++i) { ca0[i] = S.a_off(cur, RA[i]) + (unsigned)CA2[i]; ca1[i] = S.a_off(cur, HALF + RA[i]) + (unsigned)CA2[i]; } }
    const char* cB = S.b_ptr(cur);
    {
        PG8_STAGE(PG8_SB(0, 0), cB, voffB); PG8_STAGE(PG8_SB(0, 1), cB + hstep, voffB); PG8_STAGEA(PG8_SA(0, 0), ca0, 0); PG8_STAGEA(PG8_SA(0, 1), ca1, 0);
        if (wr == 1) PG8_BAR;
        PG8_WAIT_V(2); PG8_BAR;
        PG8_STAGE(PG8_SB(1, 0), cB + kstep, voffB); PG8_STAGEA(PG8_SA(1, 0), ca0, kstep); PG8_STAGE(PG8_SB(1, 1), cB + hstep + kstep, voffB);
        PG8_WAIT_V(6); PG8_BAR;
    }
    for (;;) {
        const bool has_next = S.next(ui + 1, nxt);
        const char* nB = cB; nub = ub;
        if constexpr (!UA) {
#pragma unroll
            for (int i = 0; i < 2; ++i) { na0[i] = ca0[i]; na1[i] = ca1[i]; } }
        if (has_next) { nB = S.b_ptr(nxt);
            if constexpr (UA) nub = S.a_base(nxt);
            else {
#pragma unroll
                for (int i = 0; i < 2; ++i) { int R, C; stage_rc(tid * 16 + i * 8192, R, C); na0[i] = S.a_off(nxt, R) + (unsigned)(C * 2); na1[i] = S.a_off(nxt, HALF + R) + (unsigned)(C * 2); } } }
#pragma unroll 1
        for (int t = 0; t < nt; t += 2) {
            const bool last = (t == nt - 2);
            const size_t k1 = PG8_KOF(t + 1);
            const size_t k2 = last ? (size_t)0 : PG8_KOF(t + 2), k3 = last ? kstep : PG8_KOF(t + 3);
            const size_t kb2 = last ? (size_t)0 : (size_t)(t + 2) * kstep;
            if constexpr (Epi::HAS_MID) { if (t == kbreak) E.mid(acc, cur, wr, wc, fr, fq); }
            const char* b2 = (last ? nB : cB) + kb2; const char* b3 = b2 + kstep;
            PG8_LDB(B0, 0, 0); PG8_LDB(B1, 0, 1); PG8_SCHED; PG8_LDA(At, 0, 0); PG8_STAGEA(PG8_SA(1, 1), ca1, k1);
            if (last) { if constexpr (UA) ub = nub; else {
#pragma unroll
                for (int i = 0; i < 2; ++i) { ca0[i] = na0[i]; ca1[i] = na1[i]; } } }
            PG8_WAIT_V(8); PG8_WAIT_L(0); PG8_BAR; PG8_MMA(0, 0, At, B0); PG8_MMA(0, 1, At, B1); PG8_BAR; PG8_SCHED;
            PG8_LDA(At, 0, 1); PG8_STAGE(PG8_SB(0, 0), b2, voffB); PG8_STAGE(PG8_SB(0, 1), b2 + hstep, voffB); PG8_STAGEA(PG8_SA(0, 0), ca0, k2);
            PG8_WAIT_V(8); PG8_WAIT_L(0); PG8_BAR; PG8_MMA(1, 0, At, B0); PG8_MMA(1, 1, At, B1); PG8_BAR; PG8_SCHED;
            PG8_LDB(B0, 1, 0); PG8_LDB(B1, 1, 1); PG8_SCHED; PG8_LDA(At, 1, 0); PG8_STAGEA(PG8_SA(0, 1), ca1, k2);
            PG8_WAIT_V(8); PG8_WAIT_L(0); PG8_BAR; PG8_MMA(0, 0, At, B0); PG8_MMA(0, 1, At, B1); PG8_BAR; PG8_SCHED;
            PG8_LDA(At, 1, 1); PG8_STAGE(PG8_SB(1, 0), b3, voffB); PG8_STAGE(PG8_SB(1, 1), b3 + hstep, voffB); PG8_STAGEA(PG8_SA(1, 0), ca0, k3);
            PG8_WAIT_V(8); PG8_WAIT_L(0); PG8_BAR; PG8_MMA(1, 0, At, B0); PG8_MMA(1, 1, At, B1); PG8_BAR; PG8_SCHED;
        }
        if constexpr (ALIGN_EPI) { if (wr == 0) PG8_BAR; }
        if constexpr (!Epi::AFTER_DRAIN) { E(acc, cur, wr, wc, fr, fq); }
        if (!has_next) break;
#pragma unroll
        for (int a = 0; a < 2; ++a)
#pragma unroll
            for (int b = 0; b < 2; ++b)
#pragma unroll
                for (int m = 0; m < 4; ++m)
#pragma unroll
                    for (int n = 0; n < 2; ++n) acc[a][b][m][n] = (f32x4){0.f, 0.f, 0.f, 0.f};
        cur = nxt; cB = nB; ++ui;
        if constexpr (ALIGN_EPI) { if (wr == 1) PG8_BAR; }
    }
    PG8_WAIT_V(0);
    if constexpr (!ALIGN_EPI) { if (wr == 0) PG8_BAR; }
    PG8_BAR;
    if constexpr (Epi::AFTER_DRAIN) { E.fused(acc, cur, wr, wc, fr, fq, lds, wid, lane); }
#undef PG8_KOF
#undef PG8_SA
#undef PG8_SB
#undef PG8_STAGE
#undef PG8_STAGEA
#undef PG8_LDA
#undef PG8_LDB
#undef PG8_MMA
#undef PG8_WAIT_V
#undef PG8_WAIT_L
#undef PG8_BAR
#undef PG8_SCHED
}
}
namespace attn_body {
using bf16=__hip_bfloat16;
using bf16x8=__attribute__((ext_vector_type(8)))short;
using s16x4=__attribute__((ext_vector_type(4)))short;
using f32x16=__attribute__((ext_vector_type(16)))float;
using u32x4=__attribute__((ext_vector_type(4)))unsigned;
using u32x2=__attribute__((ext_vector_type(2)))unsigned;
constexpr int SEQ=2048,D=64,DM=512;
constexpr int NW=8,QBLK=32,QB=QBLK*NW,KVBLK=64;
__device__ __forceinline__ int crow(int r,int hi){return (r&3)+8*(r>>2)+4*hi;}
#define SBAR() __builtin_amdgcn_sched_barrier(0)
constexpr float NEGB=-1000.0f;
constexpr int NSLOT=3, SLOTB=8192;
constexpr int LDS_K=0, LDS_V=NSLOT*SLOTB, LDS_WS=2*NSLOT*SLOTB, LDS_BIAS=LDS_WS+NW*64*4, LDS_X=LDS_BIAS+2048, LDS_OST=LDS_X, LDS_BYTES=LDS_X+65536;
constexpr float C2=0.125f*1.4426950408889634f;
__device__ __forceinline__ void glds16(const void*gsrc,unsigned lds_dst){unsigned keep;
  asm volatile("s_mov_b32 %0, m0\n\ts_mov_b32 m0, %2\n\ts_nop 0\n\tglobal_load_lds_dwordx4 %1, off\n\ts_mov_b32 m0, %0":"=&s"(keep):"v"(gsrc),"s"(lds_dst):"memory");}
__device__ __forceinline__ float max3f(float a,float b,float c){float r;asm("v_max3_f32 %0, %1, %2, %3":"=v"(r):"v"(a),"v"(b),"v"(c));return r;}
__device__ __forceinline__ float max2f(float a,float b){float r;asm("v_max_f32_e32 %0, %1, %2":"=v"(r):"v"(a),"v"(b));return r;}
__device__ __forceinline__ float fadd_s(float a,float b){float r;asm("v_add_f32_e32 %0, %1, %2":"=v"(r):"v"(a),"v"(b));return r;}
__device__ __forceinline__ float fsub_s(float a,float b){float r;asm("v_sub_f32_e32 %0, %1, %2":"=v"(r):"v"(a),"v"(b));return r;}
typedef float f32x2_t __attribute__((ext_vector_type(2))); typedef __bf16 bf16x2_t __attribute__((ext_vector_type(2)));
__device__ __forceinline__ unsigned cvtpk_s(float lo,float hi){f32x2_t v={lo,hi};bf16x2_t b=__builtin_convertvector(v,bf16x2_t);return __builtin_bit_cast(unsigned,b);}
#define WAIT_BAR(N) asm volatile("s_waitcnt vmcnt(" #N ") lgkmcnt(0)\n\ts_barrier":::"memory")

__device__ __forceinline__ void qkt(f32x16&p0,f32x16&p1,const char*Kslot,const bf16x8*qr,const f32x16&negm,int r32,int hi){
  const char*kb=Kslot+hi*1024+r32*16;
  #pragma unroll
  for(int d0=0;d0<4;++d0){
    const bf16x8 b0=*reinterpret_cast<const bf16x8*>(kb+d0*2048);
    const bf16x8 b1=*reinterpret_cast<const bf16x8*>(kb+d0*2048+512);
    if(d0==0){p0=__builtin_amdgcn_mfma_f32_32x32x16_bf16(b0,qr[0],negm,0,0,0);p1=__builtin_amdgcn_mfma_f32_32x32x16_bf16(b1,qr[0],negm,0,0,0);}
    else{p0=__builtin_amdgcn_mfma_f32_32x32x16_bf16(b0,qr[d0],p0,0,0,0);p1=__builtin_amdgcn_mfma_f32_32x32x16_bf16(b1,qr[d0],p1,0,0,0);}}
}
typedef __attribute__((address_space(3))) const char* lds_cptr;
typedef __attribute__((address_space(3))) char* lds_ptr;
typedef short v4i16_t __attribute__((ext_vector_type(4)));
__device__ __forceinline__ void kload8(bf16x8*kf,lds_cptr kp){
  kf[0]=*(const __attribute__((address_space(3))) bf16x8*)(kp);      kf[1]=*(const __attribute__((address_space(3))) bf16x8*)(kp+512);
  kf[2]=*(const __attribute__((address_space(3))) bf16x8*)(kp+2048); kf[3]=*(const __attribute__((address_space(3))) bf16x8*)(kp+2560);
  kf[4]=*(const __attribute__((address_space(3))) bf16x8*)(kp+4096); kf[5]=*(const __attribute__((address_space(3))) bf16x8*)(kp+4608);
  kf[6]=*(const __attribute__((address_space(3))) bf16x8*)(kp+6144); kf[7]=*(const __attribute__((address_space(3))) bf16x8*)(kp+6656);
}
__device__ __forceinline__ void kload2(bf16x8*kf,lds_cptr kp,int j){ kf[2*j]=*(const __attribute__((address_space(3))) bf16x8*)(kp+j*2048); kf[2*j+1]=*(const __attribute__((address_space(3))) bf16x8*)(kp+j*2048+512); }
__device__ __forceinline__ s16x4 vtr(lds_cptr p){ return __builtin_bit_cast(s16x4,__builtin_amdgcn_ds_read_tr16_b64_v4i16((__attribute__((address_space(3))) v4i16_t*)p)); }
__device__ __forceinline__ float rowmax(const f32x16&p0,const f32x16&p1){
  float a=max3f(p0[0],p0[1],p1[0]),b=max3f(p0[2],p0[3],p1[1]);a=max3f(a,p1[2],p1[3]);
  #pragma unroll
  for(int r=4;r<16;r+=4){a=max3f(a,p0[r],p0[r+1]);b=max3f(b,p0[r+2],p0[r+3]);a=max3f(a,p1[r],p1[r+1]);b=max3f(b,p1[r+2],p1[r+3]);}
  const float m=max2f(a,b);
  auto rr=__builtin_amdgcn_permlane32_swap(__float_as_uint(m),__float_as_uint(m),false,false);
  return max2f(__uint_as_float(rr[0]),__uint_as_float(rr[1]));
}
__device__ __forceinline__ void pv(f32x16*o,int vb,bf16x8 pa0,bf16x8 pa1,bf16x8 pa2,bf16x8 pa3){
  #pragma unroll
  for(int d0=0;d0<2;++d0){s16x4 lo[4],hi[4];
    #pragma unroll
    for(int ks=0;ks<4;++ks){
      asm volatile("ds_read_b64_tr_b16 %0,%1 offset:%c2":"=&v"(lo[ks]):"v"(vb),"i"(d0*4096+ks*1024):"memory");
      asm volatile("ds_read_b64_tr_b16 %0,%1 offset:%c2":"=&v"(hi[ks]):"v"(vb),"i"(d0*4096+ks*1024+512):"memory");}
    asm volatile("s_waitcnt lgkmcnt(0)":::"memory");SBAR();
    #define PK(k) (bf16x8){lo[k][0],lo[k][1],lo[k][2],lo[k][3],hi[k][0],hi[k][1],hi[k][2],hi[k][3]}
    o[d0]=__builtin_amdgcn_mfma_f32_32x32x16_bf16(pa0,PK(0),o[d0],0,0,0);
    o[d0]=__builtin_amdgcn_mfma_f32_32x32x16_bf16(pa1,PK(1),o[d0],0,0,0);
    o[d0]=__builtin_amdgcn_mfma_f32_32x32x16_bf16(pa2,PK(2),o[d0],0,0,0);
    o[d0]=__builtin_amdgcn_mfma_f32_32x32x16_bf16(pa3,PK(3),o[d0],0,0,0);
    #undef PK
  }
}

template<int MODE,int THRL> __device__ __forceinline__ void attn_unit(int b,int h,int qb,const bf16*Q,const bf16*__restrict__ K,const bf16*__restrict__ V,bf16*O,const void*extra,char*shm){
  int tid_=threadIdx.x; asm volatile("":"+v"(tid_));
  const int tid=tid_,lane=tid&63,r32=lane&31,hi=lane>>5; const int wid=__builtin_amdgcn_readfirstlane(tid>>6);
  const long rowbase=(long)b*SEQ; const int q0=qb*QB;
  const int jt0=(MODE==0)?((4*qb-8)>0?(4*qb-8):0):0;
  const int NT=4*qb+4-jt0;
  const bf16*Qw=Q+(rowbase+q0+wid*QBLK)*DM+h*D;
  const bf16*Kh=K+(rowbase+(long)jt0*KVBLK)*DM+h*D,*Vh=V+(rowbase+(long)jt0*KVBLK)*DM+h*D;
  const unsigned lds0=(unsigned)(uintptr_t)shm;
  __attribute__((address_space(3))) float*wsf=(__attribute__((address_space(3))) float*)((lds_ptr)shm+LDS_WS)+wid*64;
  const lds_cptr shm3=(lds_cptr)shm;
  if(MODE==1){ const unsigned long long*selg=(const unsigned long long*)extra+(size_t)(rowbase+q0)*32; int row=tid>>1,par=tid&1; asm volatile("":"+v"(row),"+v"(par)); lds_ptr xm=(lds_ptr)shm+LDS_X;
    _Pragma("unroll 1") for(int cc=par;cc<NT/2;cc+=2){ const u32x4 v=*(const u32x4*)(selg+(size_t)row*32+2*cc);
      *(__attribute__((address_space(3))) u32x2*)(xm+((2*cc)*256+row)*8)=(u32x2){v.x,v.y}; *(__attribute__((address_space(3))) u32x2*)(xm+((2*cc+1)*256+row)*8)=(u32x2){v.z,v.w}; } }
  else { int tb_=tid; asm volatile("":"+v"(tb_)); if(tb_<257){ const float bv=((const float*)extra)[h*257+tb_]*1.4426950408889634f; *(__attribute__((address_space(3))) float*)((lds_ptr)shm+LDS_BIAS+tb_*4)=bv; } }
  const __attribute__((address_space(3))) float* biasl=(const __attribute__((address_space(3))) float*)(shm3+LDS_BIAS);
  const lds_cptr xmr=shm3+LDS_X+(wid*32+r32)*8;
  const bf16*ksrc=Kh+(long)lane*DM+wid*8;
  const bf16*vsrc=Vh+(long)(16*(wid&3)+(lane>>2))*DM+(wid>>2)*32+(lane&3)*8;
  const unsigned kdst=lds0+LDS_K+wid*1024, vdst=lds0+LDS_V+wid*1024;
  #define DMA_K(t,slot) glds16(ksrc+(long)(t)*KVBLK*DM,(unsigned)__builtin_amdgcn_readfirstlane(kdst+(slot)))
  #define DMA_V(t,slot) glds16(vsrc+(long)(t)*KVBLK*DM,(unsigned)__builtin_amdgcn_readfirstlane(vdst+(slot)))
  const char*Kbase=shm+LDS_K; bf16x8 kf[8];
  const lds_cptr kp0=shm3+LDS_K+hi*1024+r32*16; const lds_cptr vp0=shm3+LDS_V+((lane>>4)&1)*32+(lane&3)*8+(4*hi+((lane&15)>>2))*64;
  DMA_K(0,0);DMA_V(0,0);DMA_K(1,SLOTB);
  bf16x8 qr[4];
  #pragma unroll
  for(int d0=0;d0<4;++d0)qr[d0]=*reinterpret_cast<const bf16x8*>(&Qw[(long)r32*DM+d0*16+hi*8]);
  float mhat=0.f,l_reg=0.f;f32x16 o[2];o[0]=f32x16{};o[1]=f32x16{};const f32x16 negm=f32x16{};
  const int qpos=q0+wid*QBLK+r32;
  const int cw=4*qb+(wid>>1);
  #define MASKT(P0,P1,t) do{ \
    if(MODE==1){ const u32x2 mw_=*(const __attribute__((address_space(3))) u32x2*)(xmr+(t)*2048); const unsigned m0_=mw_.x>>(4*hi), m1_=mw_.y>>(4*hi); \
      _Pragma("unroll") for(int r=0;r<16;++r){ const int bit_=(r&3)+8*(r>>2); P0[r]=((m0_>>bit_)&1u)?P0[r]:NEGB; P1[r]=((m1_>>bit_)&1u)?P1[r]:NEGB; } } \
    else { const int jc_=jt0+(t); \
      if(jc_>cw||jc_+8<cw){ _Pragma("unroll") for(int r=0;r<16;++r){P0[r]=NEGB;P1[r]=NEGB;} } \
      else if((q0+wid*QBLK)-(64*jc_+63)>=128){ const float bc_=biasl[256]; _Pragma("unroll") for(int r=0;r<16;++r){P0[r]+=bc_;P1[r]+=bc_;} } \
      else { const int rb_=qpos-(64*jc_+4*hi); \
        _Pragma("unroll") for(int r=0;r<16;++r){ const int rel_=rb_-((r&3)+8*(r>>2)); int i0_=rel_<128?rel_:128; int i1_=(rel_-32)<128?(rel_-32):128; i0_=i0_<-128?-128:i0_; i1_=i1_<-128?-128:i1_; \
          P0[r]+=biasl[i0_+128]; P1[r]+=biasl[i1_+128]; } } } \
  }while(0)
  bool resc=false;
  #define START(P0,P1) do{ const float rm=rowmax(P0,P1); resc=false; \
    { const float dl=rm; mhat=fadd_s(mhat,dl); \
      _Pragma("unroll") for(int r=0;r<16;++r){P0[r]=fsub_s(P0[r],dl);P1[r]=fsub_s(P1[r],dl);} \
      } \
    _Pragma("unroll") for(int r=0;r<16;++r)P0[r]=__builtin_amdgcn_exp2f(P0[r]); }while(0)
  #define RESC() do{ if(resc){ asm volatile("s_waitcnt lgkmcnt(0)":::"memory"); \
      _Pragma("unroll") for(int d_=0;d_<2;++d_) _Pragma("unroll") for(int r=0;r<16;++r)o[d_][r]*=wsf[crow(r,hi)]; } }while(0)
  f32x16 pA0,pA1,pB0,pB1;
  int sl_prev=0,sl_cur=0,sl_next=SLOTB;
  #define ROT() do{sl_prev=sl_cur;sl_cur=sl_next;sl_next=(sl_next==(NSLOT-1)*SLOTB)?0:sl_next+SLOTB;}while(0)
  DMA_K(2,2*SLOTB);
  WAIT_BAR(3);
  qkt(pA0,pA1,Kbase,qr,negm,r32,hi);asm volatile("s_nop 15\n\ts_nop 7":"+v"(pA0),"+v"(pA1));MASKT(pA0,pA1,0);
  START(pA0,pA1);
  _Pragma("unroll") for(int r=0;r<16;++r)pA1[r]=__builtin_amdgcn_exp2f(pA1[r]);
  WAIT_BAR(0);
  DMA_K(3,0);DMA_V(1,SLOTB);
  ROT();
  kload8(kf,kp0+sl_cur);
  WAIT_BAR(2);
  s16x4 vlo[8],vhi[8]; u32x4 pw0,pw1,pw2,pw3;
  #define PKW(P,B) cvtpk_s(P[B],P[B+1])
  #define PAF(k) __builtin_bit_cast(bf16x8,pw##k)
  #define VFR(i) (bf16x8){vlo[i][0],vlo[i][1],vlo[i][2],vlo[i][3],vhi[i][0],vhi[i][1],vhi[i][2],vhi[i][3]}
  #define PIN(x) asm volatile("":"+v"(x))
  #define MX3(a,b,c) __builtin_fmaxf(__builtin_fmaxf((a),(b)),(c))
  #define GAPA(MF,A0,A1,A2,A3,W0,W1,PW) do{ MF; sacc+=A0; sacc+=A1; sacc+=A2; sacc+=A3; PIN(sacc); W0; W1; PIN(PW); SBAR(); }while(0)
  #define EX(v) __builtin_amdgcn_exp2f(v)
  #define GAPB(MF,X,B) do{ MF; X[B]=EX(X[B]); X[B+1]=EX(X[B+1]); X[B+2]=EX(X[B+2]); X[B+3]=EX(X[B+3]); PIN(X); SBAR(); }while(0)
  #define VRD(i) do{ vlo[i]=vtr(vp_+(((i)>>2)*4096+((i)&3)*1024)); vhi[i]=vtr(vp_+(((i)>>2)*4096+((i)&3)*1024+512)); }while(0)
  #define KRD(G,j) do{ if(G){ kload2(kf,kp0+sl_next,j); SBAR(); } }while(0)
  #define STEP(C0,C1,P0,P1,t,GK,GV,GL) do{ SBAR(); \
    const lds_cptr vp_=vp0+sl_prev; \
    VRD(0); SBAR(); float sacc=(P0[0]+P0[1]); \
    GAPA(C0=__builtin_amdgcn_mfma_f32_32x32x16_bf16(kf[0],qr[0],negm,0,0,0), P0[2],P0[3],P0[4],P0[5],     pw0[0]=PKW(P0,0), pw0[1]=PKW(P0,2), pw0); \
    VRD(4); SBAR(); GAPA(C1=__builtin_amdgcn_mfma_f32_32x32x16_bf16(kf[1],qr[0],negm,0,0,0), P0[6],P0[7],P0[8],P0[9],     pw0[2]=PKW(P0,4), pw0[3]=PKW(P0,6), pw0); \
    VRD(1); SBAR(); GAPA(C0=__builtin_amdgcn_mfma_f32_32x32x16_bf16(kf[2],qr[1],C0,0,0,0),   P0[10],P0[11],P0[12],P0[13], pw1[0]=PKW(P0,8), pw1[1]=PKW(P0,10), pw1); \
    VRD(5); SBAR(); GAPA(C1=__builtin_amdgcn_mfma_f32_32x32x16_bf16(kf[3],qr[1],C1,0,0,0),   P0[14],P0[15],P1[0],P1[1],   pw1[2]=PKW(P0,12),pw1[3]=PKW(P0,14), pw1); \
    VRD(2); SBAR(); GAPA(C0=__builtin_amdgcn_mfma_f32_32x32x16_bf16(kf[4],qr[2],C0,0,0,0),   P1[2],P1[3],P1[4],P1[5],     pw2[0]=PKW(P1,0), pw2[1]=PKW(P1,2), pw2); \
    VRD(6); SBAR(); GAPA(C1=__builtin_amdgcn_mfma_f32_32x32x16_bf16(kf[5],qr[2],C1,0,0,0),   P1[6],P1[7],P1[8],P1[9],     pw2[2]=PKW(P1,4), pw2[3]=PKW(P1,6), pw2); \
    VRD(3); SBAR(); GAPA(C0=__builtin_amdgcn_mfma_f32_32x32x16_bf16(kf[6],qr[3],C0,0,0,0),   P1[10],P1[11],P1[12],P1[13], pw3[0]=PKW(P1,8), pw3[1]=PKW(P1,10), pw3); \
    VRD(7); SBAR(); GAPA(C1=__builtin_amdgcn_mfma_f32_32x32x16_bf16(kf[7],qr[3],C1,0,0,0),   P1[14],P1[15],0.f,0.f,       pw3[2]=PKW(P1,12),pw3[3]=PKW(P1,14), pw3); \
    l_reg+=sacc; \
    if(GK){DMA_K((t)+3,sl_cur);} if(GV){DMA_V((t)+1,sl_next);} \
    _Pragma("unroll") for(int r=0;r<16;++r){C0[r]-=mhat;C1[r]-=mhat;} \
    MASKT(C0,C1,t); \
    { float a=MX3(C0[0],C0[1],C1[0]),b=MX3(C0[2],C0[3],C1[1]); a=MX3(a,C1[2],C1[3]); \
      _Pragma("unroll") for(int r=4;r<16;r+=4){a=MX3(a,C0[r],C0[r+1]);b=MX3(b,C0[r+2],C0[r+3]);a=MX3(a,C1[r],C1[r+1]);b=MX3(b,C1[r+2],C1[r+3]);} \
      float rm=__builtin_fmaxf(a,b); { auto rr=__builtin_amdgcn_permlane32_swap(__float_as_uint(rm),__float_as_uint(rm),false,false); rm=__builtin_fmaxf(__uint_as_float(rr[0]),__uint_as_float(rr[1])); } \
      resc=false; \
      if(__builtin_expect(__any(rm>(float)THRL),0)){ const float dl=__builtin_fmaxf(rm,0.f); mhat+=dl; \
        _Pragma("unroll") for(int r=0;r<16;++r){C0[r]-=dl;C1[r]-=dl;} \
        const float f=__builtin_amdgcn_exp2f(-dl); l_reg*=f; if(hi==0)wsf[r32]=f; resc=true; } } \
    SBAR(); \
    GAPB(o[0]=__builtin_amdgcn_mfma_f32_32x32x16_bf16(PAF(0),VFR(0),o[0],0,0,0), C0,0); \
    GAPB(o[1]=__builtin_amdgcn_mfma_f32_32x32x16_bf16(PAF(0),VFR(4),o[1],0,0,0), C0,4); \
    KRD(GL,0); GAPB(o[0]=__builtin_amdgcn_mfma_f32_32x32x16_bf16(PAF(1),VFR(1),o[0],0,0,0), C0,8); \
    KRD(GL,1); GAPB(o[1]=__builtin_amdgcn_mfma_f32_32x32x16_bf16(PAF(1),VFR(5),o[1],0,0,0), C0,12); \
    KRD(GL,2); GAPB(o[0]=__builtin_amdgcn_mfma_f32_32x32x16_bf16(PAF(2),VFR(2),o[0],0,0,0), C1,0); \
    KRD(GL,3); GAPB(o[1]=__builtin_amdgcn_mfma_f32_32x32x16_bf16(PAF(2),VFR(6),o[1],0,0,0), C1,4); \
    GAPB(o[0]=__builtin_amdgcn_mfma_f32_32x32x16_bf16(PAF(3),VFR(3),o[0],0,0,0), C1,8); \
    GAPB(o[1]=__builtin_amdgcn_mfma_f32_32x32x16_bf16(PAF(3),VFR(7),o[1],0,0,0), C1,12); \
    }while(0)
  int t=1;
  for(;t+5<NT;t+=2){
    STEP(pB0,pB1,pA0,pA1,t,true,true,true);     WAIT_BAR(2); RESC(); ROT();
    STEP(pA0,pA1,pB0,pB1,t+1,true,true,true);   WAIT_BAR(2); RESC(); ROT();
  }
  #define ENDW(tt) do{ if((tt)+3<NT){WAIT_BAR(2);} else if((tt)+2<NT){WAIT_BAR(1);} else {WAIT_BAR(0);} }while(0)
  for(;t+1<NT;t+=2){
    STEP(pB0,pB1,pA0,pA1,t,(t+3<NT),(t+1<NT),(t+1<NT));       ENDW(t);   RESC(); ROT();
    STEP(pA0,pA1,pB0,pB1,t+1,(t+4<NT),(t+2<NT),(t+2<NT));     ENDW(t+1); RESC(); ROT();
  }
  STEP(pB0,pB1,pA0,pA1,NT-1,false,false,false); RESC();
  { float sacc=pB0[0]+pB0[1]; _Pragma("unroll") for(int r=2;r<16;++r)sacc+=pB0[r]; _Pragma("unroll") for(int r=0;r<16;++r)sacc+=pB1[r]; l_reg+=sacc;
    pw0=(u32x4){PKW(pB0,0),PKW(pB0,2),PKW(pB0,4),PKW(pB0,6)};pw1=(u32x4){PKW(pB0,8),PKW(pB0,10),PKW(pB0,12),PKW(pB0,14)};pw2=(u32x4){PKW(pB1,0),PKW(pB1,2),PKW(pB1,4),PKW(pB1,6)};pw3=(u32x4){PKW(pB1,8),PKW(pB1,10),PKW(pB1,12),PKW(pB1,14)};
    const int vb0=(int)(lds0+LDS_V)+((lane>>4)&1)*32+(lane&3)*8+(4*hi+((lane&15)>>2))*64;
    SBAR(); pv(o,vb0+sl_cur,PAF(0),PAF(1),PAF(2),PAF(3)); }
  #undef PKW
  #undef PAF
  #undef VFR
  #undef PIN
  #undef MX3
  #undef GAPA
  #undef GAPB
  #undef EX
  #undef VRD
  #undef KRD
  #undef STEP
  #undef ENDW
  {auto rr=__builtin_amdgcn_permlane32_swap(__float_as_uint(l_reg),__float_as_uint(l_reg),false,false);l_reg=__uint_as_float(rr[0])+__uint_as_float(rr[1]);}
  if(hi==0)wsf[32+r32]=l_reg;
  asm volatile("s_waitcnt lgkmcnt(0)\n\ts_barrier":::"memory");
  float rli[16];
  #pragma unroll
  for(int r=0;r<16;++r)rli[r]=__builtin_amdgcn_rcpf(wsf[32+crow(r,hi)]);
  bf16*Ow=O+(rowbase+q0+wid*QBLK)*DM+h*D;
  { bf16*stg=(bf16*)(shm+LDS_OST)+wid*2048;
    #pragma unroll
    for(int r=0;r<16;++r){const int orow=crow(r,hi);
      #pragma unroll
      for(int d0=0;d0<2;++d0)stg[orow*64+d0*32+r32]=__float2bfloat16(o[d0][r]*rli[r]);}
    asm volatile("s_waitcnt lgkmcnt(0)":::"memory");
    #pragma unroll
    for(int i=0;i<4;++i){const int row=i*8+(lane>>3),ch=lane&7; const u32x4 v=*(const u32x4*)(stg+row*64+ch*8); *(u32x4*)(Ow+(long)row*DM+ch*8)=v;} }
  asm volatile("s_waitcnt lgkmcnt(0)\n\ts_barrier":::"memory");
  #undef DMA_K
  #undef DMA_V
  #undef MASKT
  #undef START
  #undef RESC
  #undef ROT
}
constexpr int ATTN_LDS_BYTES=LDS_BYTES;
#undef SBAR
#undef WAIT_BAR
}
constexpr int NB = 8, SEQ = 2048, T = NB * SEQ, D = 1024;
constexpr int DIN = 5704, DINP = 5888;
constexpr int NEXP = 64, DEXP = 256, TOPK = 8;
constexpr int NCHUNK = 2, CHTOK = T / NCHUNK, CHROWS = CHTOK * TOPK;
constexpr float LN_EPS = 1e-5f;
constexpr float DN_ALPHA = 1.189207115002721f;
constexpr float LOG2E = 1.4426950408889634f;
constexpr int NWAVES = 8;
constexpr int NPHASE = 13;

constexpr size_t MiB = 1u << 20;
constexpr size_t WS_CTL = 0, CTL_ZERO_BYTES = 1 * MiB;
static_assert((40960 + 128 * 1088) * 4 <= (int)(1 * MiB), "CTL words inside the memset region");
constexpr size_t WS_MOD = 1 * MiB, WS_STATS = 1 * MiB + 256 * 1024, WS_ROPE = 2 * MiB, WS_XCH = 3 * MiB;
constexpr size_t WS_EGU = 4 * MiB, WS_ED = 68 * MiB, WS_SHGU = 100 * MiB, WS_SHD = 101 * MiB;
constexpr size_t WS_WA = 102 * MiB, WS_WB = 103 * MiB, WS_WOUT = 104 * MiB, WS_WIN = 106 * MiB;
constexpr size_t WS_XN = 118 * MiB;
constexpr size_t WS_QA = 150 * MiB, WS_QB = 166 * MiB, WS_KA = 182 * MiB, WS_VA = 198 * MiB, WS_KB = 214 * MiB, WS_VB = 230 * MiB;
constexpr size_t WS_QI = 246 * MiB, WS_KIW = 262 * MiB, WS_KI = 270 * MiB, WS_WI = 272 * MiB, WS_SEL = 273 * MiB;
constexpr size_t WS_TMP = 182 * MiB, WS_MERGED = 246 * MiB;
constexpr size_t WS_NVO = 277 * MiB;
constexpr size_t WS_HSH = 102 * MiB, WS_TAB = 110 * MiB, WS_HEXP = 150 * MiB, WS_YEXP = 182 * MiB, WS_END = 310 * MiB;
constexpr size_t TAB_ER = 0, TAB_W = 512 * 1024, TAB_LIST = 1 * MiB;
constexpr int CW_TMO = 0, CW_CODE = 1, CW_BAR = 4096, CW_SEAM = 16384, SEAM_BANK = 128 * 64, CW_CNT = 40960, CNT_STRIDE = 1088;

constexpr int RING_OFF = 0, RING_BYTES = 131072;
constexpr int LDSCTL_OFF = RING_BYTES, MISC_OFF = LDSCTL_OFF + 320;
constexpr int XTAB_OFF = MISC_OFF + 128;
constexpr int LDS_BYTES = 147456;
static_assert(XTAB_OFF + 1024 <= LDS_BYTES, "LDS map");

#define GAS __attribute__((address_space(1)))
#define LAS __attribute__((address_space(3)))
typedef unsigned short bf16;
typedef unsigned v4u __attribute__((ext_vector_type(4)));
typedef unsigned v2u __attribute__((ext_vector_type(2)));
typedef float f32x4 __attribute__((ext_vector_type(4)));
typedef float f32x2 __attribute__((ext_vector_type(2)));
typedef short bf16x8 __attribute__((ext_vector_type(8)));
typedef float f32x16 __attribute__((ext_vector_type(16)));
typedef GAS unsigned gu32;
#define RLX_AGENT __ATOMIC_RELAXED, __HIP_MEMORY_SCOPE_AGENT
#define LDS_WAIT() asm volatile("s_waitcnt lgkmcnt(0)" ::: "memory")
#define VM_WAIT() asm volatile("s_waitcnt vmcnt(0)" ::: "memory")
__device__ __forceinline__ unsigned f2bf(float f) { unsigned u = __builtin_bit_cast(unsigned, f); return (u + 0x7fffu + ((u >> 16) & 1u)) >> 16; }
__device__ __forceinline__ unsigned pk2(float lo, float hi) { return f2bf(lo) | (f2bf(hi) << 16); }
__device__ __forceinline__ float bf2f(unsigned short h) { return __uint_as_float((unsigned)h << 16); }
__device__ __forceinline__ float bflo(unsigned w) { return __uint_as_float(w << 16); }
__device__ __forceinline__ float bfhi(unsigned w) { return __uint_as_float(w & 0xffff0000u); }
__device__ __forceinline__ float sigmoidf_(float v) { return __builtin_amdgcn_rcpf(1.0f + __builtin_amdgcn_exp2f(-v * LOG2E)); }

#define XB_TMO      128
#define XB_XCNT(j)  (256  + 64 * (j))
#define XB_XSUB(j)  (1280 + 64 * (j))
#define XB_XGEN(j)  (2304 + 64 * (j))
#define XB_TOP      3328
#define XB_TOPGEN   3392
#define XCD_BAR_WORDS 3456
#define XB_SPIN_CAP (1u << 18)
__device__ __forceinline__ unsigned xb_ld(unsigned* p)              { return __hip_atomic_load(p, __ATOMIC_RELAXED, __HIP_MEMORY_SCOPE_AGENT); }
__device__ __forceinline__ unsigned xb_add(unsigned* p, unsigned v) { return __hip_atomic_fetch_add(p, v, __ATOMIC_RELAXED, __HIP_MEMORY_SCOPE_AGENT); }
__device__ __forceinline__ unsigned xb_xcc_id() { return (unsigned)__builtin_amdgcn_s_getreg((3 << 11) | 20) & 0xFu; }
#define XB_SPIN(cond, bar) do { unsigned _sp = 0; while (cond) { __builtin_amdgcn_s_sleep(1); \
    if ((++_sp & 255u) == 0u) { if (xb_ld(&(bar)[XB_TMO])) break; if (_sp > XB_SPIN_CAP) { atomicAdd(&(bar)[XB_TMO], 1u); break; } } } } while (0)
struct XcdBarrier { unsigned* bar; unsigned x; volatile LAS unsigned* st; };
__device__ __forceinline__ XcdBarrier xcd_barrier_post(unsigned* bar, volatile LAS unsigned* st) {
    XcdBarrier b; b.bar = bar; b.x = xb_xcc_id(); b.st = st;
    if (threadIdx.x == 0) (void)xb_add(&bar[XB_XCNT(b.x)], 1u);
    return b;
}
__device__ __forceinline__ void xcd_barrier_complete(unsigned* bar, unsigned x, unsigned& nloc, unsigned& nx) {
    const unsigned G = gridDim.x * gridDim.y * gridDim.z;
    unsigned sum, cnt, mine, sp = 0u;
    for (;;) {
        sum = 0u; cnt = 0u; mine = 0u;
#pragma unroll
        for (unsigned j = 0; j < 16; ++j) { const unsigned c = xb_ld(&bar[XB_XCNT(j)]); sum += c; cnt += (c > 0u) ? 1u : 0u; mine = (j == x) ? c : mine; }
        if (sum == G) break;
        __builtin_amdgcn_s_sleep(1);
        if ((++sp & 255u) == 0u) { if (xb_ld(&bar[XB_TMO])) break; if (sp > XB_SPIN_CAP) { atomicAdd(&bar[XB_TMO], 1u); break; } }
    }
    nloc = mine > 0u ? mine : 1u; nx = cnt > 0u ? cnt : 1u;
}
__device__ __forceinline__ void xcd_barrier(const XcdBarrier& b) {
    asm volatile("s_waitcnt vmcnt(0)" ::: "memory");
    __syncthreads();
    if (threadIdx.x == 0) {
        unsigned* bar = b.bar;
        __builtin_amdgcn_s_waitcnt(0);
        unsigned nloc = b.st[0], nx = b.st[1];
        if (nloc == 0u) { xcd_barrier_complete(bar, b.x, nloc, nx); b.st[0] = nloc; b.st[1] = nx; }
        const unsigned old = xb_add(&bar[XB_XSUB(b.x)], 1u);
        const unsigned gen = old / nloc;
        if (old + 1u == (gen + 1u) * nloc) {
            __builtin_amdgcn_fence(__ATOMIC_RELEASE, "agent");
            asm volatile("s_waitcnt vmcnt(0)" ::: "memory");
            const unsigned og = xb_add(&bar[XB_TOP], 1u);
            const unsigned tg = og / nx;
            if (og + 1u == (tg + 1u) * nx) xb_add(&bar[XB_TOPGEN], 1u);
            else XB_SPIN(xb_ld(&bar[XB_TOPGEN]) == tg, bar);
            __builtin_amdgcn_fence(__ATOMIC_ACQUIRE, "agent");
            xb_add(&bar[XB_XGEN(b.x)], 1u);
            asm volatile("s_waitcnt vmcnt(0)" ::: "memory");
        } else {
            XB_SPIN(xb_ld(&bar[XB_XGEN(b.x)]) == gen, bar);
            __builtin_amdgcn_fence(__ATOMIC_ACQUIRE, "agent");
            asm volatile("s_waitcnt vmcnt(0)" ::: "memory");
        }
    }
    __syncthreads();
}

__device__ __forceinline__ float wave_sum(float v) {
#pragma unroll
    for (int o = 1; o < 64; o <<= 1) v += __shfl_xor(v, o);
    return v;
}

struct Args {
    const float* x; const float* c; const int* positions; const float* w_ada; const float* b_ada; const float* w_in; const float* rel_bias;
    const float* ikn_g; const float* ikn_b; const float* w_branch_a; const float* w_branch_b; const float* w_out; const float* ln1_g; const float* ln1_b;
    const float* w_router; const float* router_bias; const float* w_exp_gate; const float* w_exp_up; const float* w_exp_down;
    const float* w_sh_gate; const float* w_sh_up; const float* w_sh_down; const float* ln2_g; const float* ln2_b;
    float* out; unsigned char* ws;
    double inv_freq_rev[8];
    int ph_lo, ph_hi, li, flags;
};
using pg8::Unit; using pg8::cvt_pk_bf16;
__device__ __forceinline__ v4u pack8(const f32x4& v0, const f32x4& v1) { v4u w; w.x = cvt_pk_bf16(v0[0], v0[1]); w.y = cvt_pk_bf16(v0[2], v0[3]); w.z = cvt_pk_bf16(v1[0], v1[1]); w.w = cvt_pk_bf16(v1[2], v1[3]); return w; }

__device__ __forceinline__ void kidx_rows(unsigned char* ws, const float* ikn_g, const float* ikn_b, const float* cosT, const float* sinT, int row0, int tid) {
    const float* kiw = (const float*)(ws + WS_KIW); bf16* KI = (bf16*)(ws + WS_KI); float* WI = (float*)(ws + WS_WI);
    asm volatile("" : "+v"(tid));
    const int sub = tid & 15;
#pragma unroll 1
    for (int pass = 0; pass < 8; ++pass) { const int t = row0 + pass * 32 + (tid >> 4); const f32x4 g = *(const f32x4*)(ikn_g + 4 * sub), bb = *(const f32x4*)(ikn_b + 4 * sub);
        const f32x4 q = __builtin_nontemporal_load((const f32x4*)(kiw + (size_t)t * 128 + 4 * sub));
        float s = (q.x + q.y) + (q.z + q.w); s += __shfl_xor(s, 1); s += __shfl_xor(s, 2); s += __shfl_xor(s, 4); s += __shfl_xor(s, 8);
        const float mean = s * (1.f / 64.f); const f32x4 d = q - mean;
        float s2 = (d.x * d.x + d.y * d.y) + (d.z * d.z + d.w * d.w); s2 += __shfl_xor(s2, 1); s2 += __shfl_xor(s2, 2); s2 += __shfl_xor(s2, 4); s2 += __shfl_xor(s2, 8);
        const float rstd = 1.f / sqrtf(s2 * (1.f / 64.f) + LN_EPS);
        const f32x4 v = d * rstd * g + bb;
        f32x4 pv; pv.x = __shfl_xor(v.x, 2); pv.y = __shfl_xor(v.y, 2); pv.z = __shfl_xor(v.z, 2); pv.w = __shfl_xor(v.w, 2);
        if (sub < 2) { const f32x4 c = *(const f32x4*)(cosT + (size_t)t * 8 + 4 * sub), sn = *(const f32x4*)(sinT + (size_t)t * 8 + 4 * sub);
            v4u w; w.x = pk2(v.x * c.x - pv.x * sn.x, pv.x * c.x + v.x * sn.x); w.y = pk2(v.y * c.y - pv.y * sn.y, pv.y * c.y + v.y * sn.y);
            w.z = pk2(v.z * c.z - pv.z * sn.z, pv.z * c.z + v.z * sn.z); w.w = pk2(v.w * c.w - pv.w * sn.w, pv.w * c.w + v.w * sn.w);
            *(v4u*)(KI + (size_t)t * 64 + 8 * sub) = w;
            const f32x4 wr_ = __builtin_nontemporal_load((const f32x4*)(kiw + (size_t)t * 128 + 64 + 4 * sub)); *(f32x4*)(WI + (size_t)t * 8 + 4 * sub) = wr_ * (0.35355339059327373f * 0.125f); }
        else if (sub >= 4) { v2u w; w.x = pk2(v.x, v.y); w.y = pk2(v.z, v.w); *(v2u*)(KI + (size_t)t * 64 + 4 * sub) = w; }
    }
}

struct EpiInProj {
    static constexpr bool PERM = true, AFTER_DRAIN = false, HAS_MID = false;
    unsigned char* ws; bf16* gates; const float* cosT; const float* sinT; const float* ikn_g; const float* ikn_b;
    __device__ __forceinline__ void operator()(const f32x4 (&acc)[2][2][4][2], const Unit& u, int wr, int wc, int fr, int fq) const {
        const int pn = u.pn, row0 = u.pm * 256 + wr * 64 + fr, ct = wc * 32 + 8 * fq;
        if (pn < 14) {
            size_t off; float sc = 1.f; bool rope = false; int colbase = (pn & 1) * 256;
            if (pn < 12) { const int seg = pn >> 1;
                off = seg == 0 ? WS_QA : seg == 1 ? WS_KA : seg == 2 ? WS_VA : seg == 3 ? WS_QB : seg == 4 ? WS_KB : WS_VB;
                sc = (seg == 0 || seg == 3) ? attn_body::C2 : 1.f; rope = (seg == 3 || seg == 4); }
            else { off = WS_QI; rope = true; }
            bf16* base = (bf16*)(ws + off);
            const bool dor = rope && ((wc & 1) == 0) && (fq < 2);
#pragma unroll
            for (int ai = 0; ai < 2; ++ai)
#pragma unroll
                for (int m = 0; m < 4; ++m) { const int row = row0 + ai * 128 + m * 16;
                    f32x4 c4 = (f32x4){1.f, 1.f, 1.f, 1.f}, s4 = (f32x4){0.f, 0.f, 0.f, 0.f};
                    if (dor) { c4 = *(const f32x4*)(cosT + (size_t)row * 8 + 4 * fq); s4 = *(const f32x4*)(sinT + (size_t)row * 8 + 4 * fq); }
#pragma unroll
                    for (int bj = 0; bj < 2; ++bj) { f32x4 v0 = acc[ai][bj][m][0], v1 = acc[ai][bj][m][1];
                        { f32x4 r0, r1;
                          r0[0] = v0[0] * c4[0] - v0[1] * s4[0]; r0[1] = v0[1] * c4[0] + v0[0] * s4[0]; r0[2] = v0[2] * c4[1] - v0[3] * s4[1]; r0[3] = v0[3] * c4[1] + v0[2] * s4[1];
                          r1[0] = v1[0] * c4[2] - v1[1] * s4[2]; r1[1] = v1[1] * c4[2] + v1[0] * s4[2]; r1[2] = v1[2] * c4[3] - v1[3] * s4[3]; r1[3] = v1[3] * c4[3] + v1[2] * s4[3];
                          v0 = r0 * sc; v1 = r1 * sc; }
                        *(v4u*)(base + (size_t)row * 512 + colbase + bj * 128 + ct) = pack8(v0, v1); } }
        } else if (pn == 14) {
            float* kiw = (float*)(ws + WS_KIW);
#pragma unroll
            for (int ai = 0; ai < 2; ++ai)
#pragma unroll
                for (int m = 0; m < 4; ++m) { const int row = row0 + ai * 128 + m * 16;
                    *(f32x4*)(kiw + (size_t)row * 128 + ct) = acc[ai][0][m][0]; *(f32x4*)(kiw + (size_t)row * 128 + ct + 4) = acc[ai][0][m][1]; }
            asm volatile("s_waitcnt vmcnt(0)" ::: "memory"); __builtin_amdgcn_s_barrier(); asm volatile("" ::: "memory");
            int tid = (wr * 4 + wc) * 64 + fq * 16 + fr;
            kidx_rows(ws, ikn_g, ikn_b, cosT, sinT, u.pm * 256, tid);
        } else {
            const int colbase = (pn - 15) * 256;
#pragma unroll
            for (int ai = 0; ai < 2; ++ai)
#pragma unroll
                for (int m = 0; m < 4; ++m) { const int row = row0 + ai * 128 + m * 16;
#pragma unroll
                    for (int bj = 0; bj < 2; ++bj) { f32x4 v0 = acc[ai][bj][m][0], v1 = acc[ai][bj][m][1];
#pragma unroll
                        for (int i = 0; i < 4; ++i) { v0[i] = sigmoidf_(v0[i]); v1[i] = sigmoidf_(v1[i]); }
                        *(v4u*)(gates + (size_t)row * 2048 + colbase + bj * 128 + ct) = pack8(v0, v1); } }
        }
    }
};

struct EpiGateM {
    static constexpr bool PERM = true, AFTER_DRAIN = false, HAS_MID = true;
    const bf16* gates; bf16* merged;
    __device__ __forceinline__ void mid(f32x4 (&acc)[2][2][4][2], const Unit& u, int wr, int wc, int fr, int fq) const {
        asm volatile("" : "+v"(fr), "+v"(fq));
        const int row0 = u.pm * 256 + wr * 64 + fr, c0 = u.pn * 256 + wc * 32 + 8 * fq;
#pragma unroll
        for (int ai = 0; ai < 2; ++ai)
#pragma unroll
            for (int m = 0; m < 4; ++m) { const int row = row0 + ai * 128 + m * 16;
#pragma unroll
                for (int bj = 0; bj < 2; ++bj) { const int c = c0 + bj * 128;
                    const v4u ga = *(const v4u*)(gates + (size_t)row * 2048 + c), gb = *(const v4u*)(gates + (size_t)row * 2048 + 1024 + c);
                    f32x4& v0 = acc[ai][bj][m][0]; f32x4& v1 = acc[ai][bj][m][1];
#define GR(a_, b_) ((a_) * __builtin_amdgcn_rcpf(__builtin_fmaxf((b_), 1e-30f)))
                    v0[0] *= GR(bflo(ga.x), bflo(gb.x)); v0[1] *= GR(bfhi(ga.x), bfhi(gb.x)); v0[2] *= GR(bflo(ga.y), bflo(gb.y)); v0[3] *= GR(bfhi(ga.y), bfhi(gb.y));
                    v1[0] *= GR(bflo(ga.z), bflo(gb.z)); v1[1] *= GR(bfhi(ga.z), bfhi(gb.z)); v1[2] *= GR(bflo(ga.w), bflo(gb.w)); v1[3] *= GR(bfhi(ga.w), bfhi(gb.w));
#undef GR
                }
                asm volatile("" ::: "memory"); }
    }
    __device__ __forceinline__ void operator()(const f32x4 (&acc)[2][2][4][2], const Unit& u, int wr, int wc, int fr, int fq) const {
        const int row0 = u.pm * 256 + wr * 64 + fr, c0 = u.pn * 256 + wc * 32 + 8 * fq;
#pragma unroll
        for (int ai = 0; ai < 2; ++ai)
#pragma unroll
            for (int m = 0; m < 4; ++m) { const int row = row0 + ai * 128 + m * 16;
#pragma unroll
                for (int bj = 0; bj < 2; ++bj) { const int c = c0 + bj * 128;
                    const v4u g = *(const v4u*)(gates + (size_t)row * 2048 + 1024 + c);
                    f32x4 v0 = acc[ai][bj][m][0], v1 = acc[ai][bj][m][1];
                    v0[0] *= bflo(g.x); v0[1] *= bfhi(g.x); v0[2] *= bflo(g.y); v0[3] *= bfhi(g.y); v1[0] *= bflo(g.z); v1[1] *= bfhi(g.z); v1[2] *= bflo(g.w); v1[3] *= bfhi(g.w);
                    *(v4u*)(merged + (size_t)row * 1024 + c) = pack8(v0, v1); }
                asm volatile("" ::: "memory"); }
    }
};

__device__ __forceinline__ float silu_mul(float g, float u) { return g * sigmoidf_(g) * u; }
struct EpiSilu {
    static constexpr bool PERM = true, AFTER_DRAIN = false, HAS_MID = false;
    bf16* H;
    __device__ __forceinline__ void operator()(const f32x4 (&acc)[2][2][4][2], const Unit& u, int wr, int wc, int fr, int fq) const {
        const int row0 = u.pm * 256 + wr * 64 + fr, c0 = (u.pn * 256 + wc * 32 + 8 * fq) >> 1;
#pragma unroll
        for (int ai = 0; ai < 2; ++ai)
#pragma unroll
            for (int m = 0; m < 4; ++m) { const int row = row0 + ai * 128 + m * 16;
#pragma unroll
                for (int bj = 0; bj < 2; ++bj) { const f32x4 v0 = acc[ai][bj][m][0], v1 = acc[ai][bj][m][1];
                    v2u w; w.x = cvt_pk_bf16(silu_mul(v0[0], v0[1]), silu_mul(v0[2], v0[3])); w.y = cvt_pk_bf16(silu_mul(v1[0], v1[1]), silu_mul(v1[2], v1[3]));
                    *(v2u*)(H + (size_t)row * 256 + c0 + bj * 64) = w; } }
    }
};
struct EpiExpGU {
    static constexpr bool PERM = true, AFTER_DRAIN = false, HAS_MID = false;
    bf16* H; const LAS int* xt; const unsigned short* list; const float* rw; int chunk;
    __device__ __forceinline__ void operator()(const f32x4 (&acc)[2][2][4][2], const Unit& u, int wr, int wc, int fr, int fq) const {
        const int r0 = wr * 64 + fr, c0 = (u.pn * 256 + wc * 32 + 8 * fq) >> 1; const int pos0 = __builtin_amdgcn_readfirstlane(xt[144 + u.e]) + u.pm * 256;
#pragma unroll
        for (int ai = 0; ai < 2; ++ai)
#pragma unroll
            for (int m = 0; m < 4; ++m) { const int r = r0 + ai * 128 + m * 16;
                if (r < u.nrows) { const unsigned ent = list[(size_t)u.e * 8192 + u.pm * 256 + r]; const float w = rw[(size_t)(chunk * CHTOK + (int)(ent >> 3)) * 8 + (ent & 7u)];
#pragma unroll
                    for (int bj = 0; bj < 2; ++bj) { const f32x4 v0 = acc[ai][bj][m][0], v1 = acc[ai][bj][m][1];
                        v2u pk; pk.x = cvt_pk_bf16(w * silu_mul(v0[0], v0[1]), w * silu_mul(v0[2], v0[3])); pk.y = cvt_pk_bf16(w * silu_mul(v1[0], v1[1]), w * silu_mul(v1[2], v1[3]));
                        *(v2u*)(H + (size_t)(pos0 + r) * 256 + c0 + bj * 64) = pk; } } }
    }
};
struct EpiExpD {
    static constexpr bool PERM = true, AFTER_DRAIN = false, HAS_MID = false;
    bf16* Y; const LAS int* xt;
    __device__ __forceinline__ void operator()(const f32x4 (&acc)[2][2][4][2], const Unit& u, int wr, int wc, int fr, int fq) const {
        const int r0 = wr * 64 + fr, c0 = u.pn * 256 + wc * 32 + 8 * fq; const int pos0 = __builtin_amdgcn_readfirstlane(xt[144 + u.e]) + u.pm * 256;
#pragma unroll
        for (int ai = 0; ai < 2; ++ai)
#pragma unroll
            for (int m = 0; m < 4; ++m) { const int r = r0 + ai * 128 + m * 16;
                if (r < u.nrows) {
#pragma unroll
                    for (int bj = 0; bj < 2; ++bj) *(v4u*)(Y + (size_t)(pos0 + r) * 1024 + c0 + bj * 128) = pack8(acc[ai][bj][m][0], acc[ai][bj][m][1]); } }
    }
};
struct EpiShD {
    static constexpr bool PERM = true, AFTER_DRAIN = false, HAS_MID = false;
    float* z; const float* mod;
    __device__ __forceinline__ void operator()(const f32x4 (&acc)[2][2][4][2], const Unit& u, int wr, int wc, int fr, int fq) const {
        const int row0 = u.pm * 256 + wr * 64 + fr, c0 = u.pn * 256 + wc * 32 + 8 * fq; const float* g2 = mod + (size_t)(u.pm >> 3) * 6144 + 5120;
#pragma unroll
        for (int bj = 0; bj < 2; ++bj) { const int c = c0 + bj * 128; const f32x4 ga = *(const f32x4*)(g2 + c), gb = *(const f32x4*)(g2 + c + 4);
#pragma unroll
            for (int ai = 0; ai < 2; ++ai)
#pragma unroll
                for (int m = 0; m < 4; ++m) { float* p = z + (size_t)(row0 + ai * 128 + m * 16) * 1024 + c;
                    const f32x4 a = *(const f32x4*)p, b = *(const f32x4*)(p + 4);
                    *(f32x4*)p = a * DN_ALPHA + ga * acc[ai][bj][m][0]; *(f32x4*)(p + 4) = b * DN_ALPHA + gb * acc[ai][bj][m][1]; } }
    }
};
struct EpiResid {
    static constexpr bool PERM = true, AFTER_DRAIN = false, HAS_MID = false;
    const float* x; float* v; const float* mod;
    __device__ __forceinline__ void operator()(const f32x4 (&acc)[2][2][4][2], const Unit& u, int wr, int wc, int fr, int fq) const {
        const int row0 = u.pm * 256 + wr * 64 + fr, c0 = u.pn * 256 + wc * 32 + 8 * fq; const float* g1 = mod + (size_t)(u.pm >> 3) * 6144 + 2048;
#pragma unroll
        for (int bj = 0; bj < 2; ++bj) { const int c = c0 + bj * 128; const f32x4 ga = *(const f32x4*)(g1 + c), gb = *(const f32x4*)(g1 + c + 4);
#pragma unroll
            for (int ai = 0; ai < 2; ++ai)
#pragma unroll
                for (int m = 0; m < 4; ++m) { const size_t o = (size_t)(row0 + ai * 128 + m * 16) * 1024 + c;
                    const f32x4 a = *(const f32x4*)(x + o), b = *(const f32x4*)(x + o + 4);
                    *(f32x4*)(v + o) = a * DN_ALPHA + ga * acc[ai][bj][m][0]; *(f32x4*)(v + o + 4) = b * DN_ALPHA + gb * acc[ai][bj][m][1]; } }
    }
};

template <int MODE> struct ExpertOrder {
    static constexpr bool UNIFORM_A = false;
    const LAS int* xt; int nN, G, c, total, chunk; const unsigned short* list; const char* W; size_t wexp, btile;
    __device__ __forceinline__ bool next(int i, Unit& u) const {
        const long L = (long)i * G + c; if (L >= (long)total * nN) return false;
        const int lt = (int)(L / nN); u.pn = (int)(L - (long)lt * nN);
        int e = 0;
#pragma unroll
        for (int s = 32; s >= 1; s >>= 1) { const int v = __builtin_amdgcn_readfirstlane(xt[e + s]); if (v <= lt) e += s; }
        u.e = e; u.pm = lt - __builtin_amdgcn_readfirstlane(xt[e]); const int rem = __builtin_amdgcn_readfirstlane(xt[80 + e]) - u.pm * 256; u.nrows = rem < 256 ? rem : 256; return true;
    }
    __device__ __forceinline__ unsigned a_off(const Unit& u, int row) const {
        if (MODE == 0) { int idx = u.pm * 256 + row; const int last = __builtin_amdgcn_readfirstlane(xt[80 + u.e]) - 1; idx = idx < last ? idx : last;
            const unsigned ent = list[(size_t)u.e * 8192 + idx]; return (unsigned)(chunk * CHTOK + (int)(ent >> 3)) * 2048u; }
        int p = __builtin_amdgcn_readfirstlane(xt[144 + u.e]) + u.pm * 256 + row; p = p < CHROWS - 1 ? p : CHROWS - 1; return (unsigned)p * 512u;
    }
    __device__ __forceinline__ const char* b_ptr(const Unit& u) const { return W + (size_t)u.e * wexp + (size_t)u.pn * btile; }
};
__device__ __forceinline__ void build_xtab(LAS int* xt, const unsigned* ctl, int chunk) {
    int tid = threadIdx.x; asm volatile("" : "+v"(tid));
    if (tid < 64) xt[80 + tid] = (int)__hip_atomic_load(ctl + CW_CNT + (chunk * 64 + tid) * CNT_STRIDE, RLX_AGENT);
    LDS_WAIT(); __syncthreads();
    if (tid == 0) { int ts = 0, of = 0; for (int e = 0; e < 64; ++e) { const int c = xt[80 + e]; xt[e] = ts; xt[144 + e] = of; ts += (c + 255) >> 8; of += c; } xt[64] = ts; }
    LDS_WAIT(); __syncthreads();
}
struct Ctx { LAS unsigned char* lds; int tid, lane, wave, vcu, G; };

struct MapId { int base; __device__ __forceinline__ int operator()(int s) const { return base + s; } };
struct MapIl { int base, par; __device__ __forceinline__ int operator()(int s) const { return base + 2 * s + par; } };
__device__ __forceinline__ int dperm_inv(int d) { return d < 8 ? 2 * d : (d < 16 ? 2 * (d - 8) + 1 : d); }
struct MapIn { __device__ __forceinline__ int operator()(int s) const {
    if (s < 1536) return s;
    if (s < 3072) { const int q = s - 1536, seg = q >> 9, hh = (q >> 6) & 7, d = q & 63; return 1536 + seg * 512 + hh * 64 + (seg < 2 ? dperm_inv(d) : d); }
    if (s < 3584) { const int q = s - 3072, hh = q >> 6, d = q & 63; return 3072 + hh * 64 + dperm_inv(d); }
    if (s < 3656) return s;
    return 3840 + (s - 3656); } };
template <class Map> __device__ __forceinline__ void xpose_item(const float* W, int N, int K  , int item, bf16* WT  , const Map& map, LAS float* scr, int lane) {
    const int nblk = (N + 31) / 32, kb = item / nblk, nb = item % nblk, k0 = 64 * kb, n0 = 32 * nb;
    const bool cin = (n0 + (lane & 31)) < N;
#pragma unroll
    for (int i = 0; i < 32; ++i) { const int kk = 2 * i + (lane >> 5); scr[kk * 33 + (lane & 31)] = cin ? W[(size_t)(k0 + kk) * N + n0 + (lane & 31)] : 0.f; }
    LDS_WAIT(); asm volatile("" ::: "memory");
    const int c = lane & 7;
#pragma unroll
    for (int j = 0; j < 4; ++j) { const int n = (lane >> 3) + 8 * j; const LAS float* s = scr + (8 * c) * 33 + n;
        v4u o; o.x = pk2(s[0 * 33], s[1 * 33]); o.y = pk2(s[2 * 33], s[3 * 33]); o.z = pk2(s[4 * 33], s[5 * 33]); o.w = pk2(s[6 * 33], s[7 * 33]);
        if (n0 + n < N) *(GAS v4u*)(WT + (size_t)map(n0 + n) * K + k0 + 8 * c) = o; }
    LDS_WAIT(); asm volatile("" ::: "memory");
}

__device__ __forceinline__ void p0_prologue(const Args& a, const Ctx& F) {
    unsigned char* ws = a.ws;
    {
        LAS float* cact = (LAS float*)(F.lds);
        LAS float* red = (LAS float*)(F.lds + 32768);
        for (int i = F.tid; i < 8 * 1024; i += 512) { const float v = a.c[i]; cact[i] = v * sigmoidf_(v); }
        LDS_WAIT(); __syncthreads();
        float* mod = (float*)(ws + WS_MOD);
        for (int item = F.vcu; item < 6144 / 32; item += F.G) {
            const int n0 = item * 32, kk = F.tid >> 5, col = F.tid & 31; float acc[8];
#pragma unroll
            for (int b = 0; b < 8; ++b) acc[b] = 0.f;
#pragma unroll 4
            for (int k = kk; k < 1024; k += 16) { const float w = a.w_ada[(size_t)k * 6144 + n0 + col];
#pragma unroll
                for (int b = 0; b < 8; ++b) acc[b] += cact[b * 1024 + k] * w; }
#pragma unroll
            for (int b = 0; b < 8; ++b) red[(kk * 8 + b) * 32 + col] = acc[b];
            LDS_WAIT(); __syncthreads();
            if (F.tid < 256) { const int b = F.tid >> 5; float s = 0.f;
#pragma unroll
                for (int q = 0; q < 16; ++q) s += red[(q * 8 + b) * 32 + col];
                mod[(size_t)b * 6144 + n0 + col] = s + a.b_ada[n0 + col]; }
            LDS_WAIT(); __syncthreads();
        }
        LDS_WAIT(); __syncthreads();
    }
    const int gw = F.vcu * NWAVES + F.wave, NGW = F.G * NWAVES;
    {
        float* cosT = (float*)(ws + WS_ROPE); float* sinT = cosT + (size_t)T * 8;
        for (int i = gw * 64 + F.lane; i < T * 8; i += NGW * 64) { const int t = i >> 3, j = i & 7;
            const double rev = (double)a.positions[t] * a.inv_freq_rev[j]; const float fr = (float)(rev - __builtin_floor(rev));
            cosT[i] = __builtin_amdgcn_cosf(fr); sinT[i] = __builtin_amdgcn_sinf(fr); }
    }
    {
        v4u* z = (v4u*)((bf16*)(ws + WS_WIN) + (size_t)3656 * 1024); const int n16 = 184 * 1024 * 2 / 16;
        for (int i = gw * 64 + F.lane; i < n16; i += NGW * 64) z[i] = (v4u){0u, 0u, 0u, 0u};
    }
    LAS float* scr = (LAS float*)(F.lds + F.wave * 16384);
    constexpr int I_IN = 16 * 179, I_BR = 8 * 32, I_OUT = 16 * 32, I_SG = 16 * 8, I_SD = 4 * 32, I_EG = 64 * 16 * 8, I_EDN = 64 * 4 * 32;
    constexpr int NITEMS = I_IN + 2 * I_BR + I_OUT + 2 * I_SG + I_SD + 2 * I_EG + I_EDN;
    for (int it = gw; it < NITEMS; it += NGW) {
        int r = it;
        if (r < I_IN) { xpose_item(a.w_in, DIN, 1024, r, (bf16*)(ws + WS_WIN), MapIn{}, scr, F.lane); continue; } r -= I_IN;
        if (r < I_BR) { xpose_item(a.w_branch_a, 1024, 1024, r, (bf16*)(ws + WS_WA), MapId{0}, scr, F.lane); continue; } r -= I_BR;
        if (r < I_BR) { xpose_item(a.w_branch_b, 1024, 1024, r, (bf16*)(ws + WS_WA) + 512, MapId{0}, scr, F.lane); continue; } r -= I_BR;
        if (r < I_OUT) { xpose_item(a.w_out, 1024, 1024, r, (bf16*)(ws + WS_WOUT), MapId{0}, scr, F.lane); continue; } r -= I_OUT;
        if (r < I_SG) { xpose_item(a.w_sh_gate, 256, 1024, r, (bf16*)(ws + WS_SHGU), MapIl{0, 0}, scr, F.lane); continue; } r -= I_SG;
        if (r < I_SG) { xpose_item(a.w_sh_up, 256, 1024, r, (bf16*)(ws + WS_SHGU), MapIl{0, 1}, scr, F.lane); continue; } r -= I_SG;
        if (r < I_SD) { xpose_item(a.w_sh_down, 1024, 256, r, (bf16*)(ws + WS_SHD), MapId{0}, scr, F.lane); continue; } r -= I_SD;
        if (r < I_EG) { const int e = r >> 7; xpose_item(a.w_exp_gate + (size_t)e * 1024 * 256, 256, 1024, r & 127, (bf16*)(ws + WS_EGU) + (size_t)e * 512 * 1024, MapIl{0, 0}, scr, F.lane); continue; } r -= I_EG;
        if (r < I_EG) { const int e = r >> 7; xpose_item(a.w_exp_up + (size_t)e * 1024 * 256, 256, 1024, r & 127, (bf16*)(ws + WS_EGU) + (size_t)e * 512 * 1024, MapIl{0, 1}, scr, F.lane); continue; } r -= I_EG;
        { const int e = r >> 7; xpose_item(a.w_exp_down + (size_t)e * 256 * 1024, 1024, 256, r & 127, (bf16*)(ws + WS_ED) + (size_t)e * 1024 * 256, MapId{0}, scr, F.lane); }
    }
}

__device__ __forceinline__ void ln_stats(const f32x4 (&v)[4], float& mean, float& rstd) {
    float s = 0.f;
#pragma unroll
    for (int j = 0; j < 4; ++j) s += (v[j].x + v[j].y) + (v[j].z + v[j].w);
    mean = wave_sum(s) * (1.f / D); float s2 = 0.f;
#pragma unroll
    for (int j = 0; j < 4; ++j) { const f32x4 d = v[j] - mean; s2 += (d.x * d.x + d.y * d.y) + (d.z * d.z + d.w * d.w); }
    rstd = 1.f / sqrtf(wave_sum(s2) * (1.f / D) + LN_EPS);
}
__device__ __forceinline__ void p1_ln_mod(const Args& a, const Ctx& F) {
    const int gw = F.vcu * NWAVES + F.wave, NGW = F.G * NWAVES; const float* mod = (const float*)(a.ws + WS_MOD); bf16* XN = (bf16*)(a.ws + WS_XN);
    for (int m = gw; m < T; m += NGW) {
        const GAS f32x4* xr = (const GAS f32x4*)(a.x + (size_t)m * D) + F.lane; const float* mb = mod + (size_t)(m >> 11) * 6144;
        f32x4 v[4];
#pragma unroll
        for (int j = 0; j < 4; ++j) v[j] = xr[64 * j];
        float mean, rstd; ln_stats(v, mean, rstd);
        GAS unsigned long long* o8 = (GAS unsigned long long*)(XN + (size_t)m * D) + F.lane;
#pragma unroll
        for (int j = 0; j < 4; ++j) { const f32x4 sc = *(const f32x4*)(mb + 1024 + 4 * F.lane + 256 * j), sh = *(const f32x4*)(mb + 4 * F.lane + 256 * j);
            const f32x4 u = (v[j] - mean) * rstd * (sc + 1.0f) + sh;
            o8[64 * j] = (unsigned long long)pk2(u.x, u.y) | ((unsigned long long)pk2(u.z, u.w) << 32); }
    }
}
__device__ __forceinline__ void p_ln1_rows(const Args& a, const Ctx& F) {
    const int gw = F.vcu * NWAVES + F.wave, NGW = F.G * NWAVES; const float* mod = (const float*)(a.ws + WS_MOD); bf16* XN = (bf16*)(a.ws + WS_XN); float* stats = (float*)(a.ws + WS_STATS);
    for (int m = gw; m < T; m += NGW) {
        GAS f32x4* vr = (GAS f32x4*)(a.out + (size_t)m * D) + F.lane; const float* mb = mod + (size_t)(m >> 11) * 6144;
        f32x4 v[4];
#pragma unroll
        for (int j = 0; j < 4; ++j) v[j] = vr[64 * j];
        float mean, rstd; ln_stats(v, mean, rstd);
#pragma unroll
        for (int j = 0; j < 4; ++j) { const f32x4 lg = *(const f32x4*)(a.ln1_g + 4 * F.lane + 256 * j), lb = *(const f32x4*)(a.ln1_b + 4 * F.lane + 256 * j); v[j] = (v[j] - mean) * rstd * lg + lb; vr[64 * j] = v[j]; }
        ln_stats(v, mean, rstd);
        if (F.lane == 0) { stats[(size_t)m * 2] = mean; stats[(size_t)m * 2 + 1] = rstd; }
        GAS unsigned long long* o8 = (GAS unsigned long long*)(XN + (size_t)m * D) + F.lane;
#pragma unroll
        for (int j = 0; j < 4; ++j) { const f32x4 sc = *(const f32x4*)(mb + 4096 + 4 * F.lane + 256 * j), sh = *(const f32x4*)(mb + 3072 + 4 * F.lane + 256 * j);
            const f32x4 u = (v[j] - mean) * rstd * (sc + 1.0f) + sh;
            o8[64 * j] = (unsigned long long)pk2(u.x, u.y) | ((unsigned long long)pk2(u.z, u.w) << 32); }
    }
}
__device__ __forceinline__ unsigned fkey(float v) { const unsigned u = __float_as_uint(v + 0.0f);   return u ^ ((unsigned)((int)u >> 31) | 0x80000000u); }
__device__ __forceinline__ void half_sums(int v, int& s0, int& s1) {
    v += __builtin_amdgcn_update_dpp(0, v, 0x111, 0xf, 0xf, true); v += __builtin_amdgcn_update_dpp(0, v, 0x112, 0xf, 0xf, true);
    v += __builtin_amdgcn_update_dpp(0, v, 0x114, 0xf, 0xf, true); v += __builtin_amdgcn_update_dpp(0, v, 0x118, 0xf, 0xf, true);
    v += __builtin_amdgcn_update_dpp(0, v, 0x142, 0xa, 0xf, false);
    s0 = __builtin_amdgcn_readlane(v, 31); s1 = __builtin_amdgcn_readlane(v, 63);
}
__device__ __forceinline__ void idx_unit(const Args& a, const Ctx& F, int b, int c, int g) {
    const bf16* QI = (const bf16*)(a.ws + WS_QI); const bf16* KI = (const bf16*)(a.ws + WS_KI); const float* WI = (const float*)(a.ws + WS_WI);
    unsigned long long* SEL = (unsigned long long*)(a.ws + WS_SEL);
    const int lane = F.lane, wid = F.wave;
    const int L = 64 * (c + 1), t0 = b * SEQ + 64 * c + 16 * g + 2 * wid, kq = lane & 15, q = lane >> 4, tl = q >> 1, par = q & 1;
    if (c < 4) {
        const int w = lane & 31; SEL[(size_t)(t0 + (lane >> 5)) * 32 + w] = (64 * w + 64 <= L) ? ~0ull : 0ull; return; }
    bf16x8 af[2];
    { const int r = lane & 15; const bf16* qrow = QI + (size_t)(t0 + (r >> 3)) * 512 + (r & 7) * 64 + 8 * q; af[0] = *(const bf16x8*)qrow; af[1] = *(const bf16x8*)(qrow + 32); }
    const f32x4 wv = *(const f32x4*)(WI + (size_t)(t0 + tl) * 8 + 4 * par);
    const int ntile = L >> 4, nkb = (L + 255) >> 8;
    const bf16* kb0 = KI + (size_t)b * SEQ * 64;
    const unsigned lds0 = (unsigned)(uintptr_t)(unsigned char*)F.lds;
#define IDX_DMA(blk) do { _Pragma("unroll") for (int i_ = 0; i_ < 4; ++i_) { const int p_ = wid * 256 + i_ * 64 + lane, row_ = p_ >> 3; int kr_ = (blk) * 256 + row_; kr_ = kr_ < L ? kr_ : L - 1; \
        attn_body::glds16(kb0 + (size_t)kr_ * 64 + (((p_ & 7) ^ (row_ & 7)) << 3), (unsigned)__builtin_amdgcn_readfirstlane(lds0 + (((blk) & 3) << 15) + (wid * 256 + i_ * 64) * 16)); } } while (0)
    const bool pr_nodma = (a.flags & 16) != 0, pr_nocomp = (a.flags & 8) != 0;
    if (!pr_nodma) { IDX_DMA(0); if (nkb > 1) IDX_DMA(1); if (nkb > 2) IDX_DMA(2); }
    const int sw0 = ((q ^ (kq & 7)) << 4), sw1 = (((4 + q) ^ (kq & 7)) << 4);
    unsigned key[64];
#pragma unroll
    for (int e = 0; e < 64; ++e) key[e] = 0u;
#pragma unroll
    for (int blk = 0; blk < 8; ++blk) {
        if (blk < nkb) {
            const int ahead = (nkb - 1 - blk) < 2 ? (nkb - 1 - blk) : 2;
            if (ahead == 2) asm volatile("s_waitcnt vmcnt(8)" ::: "memory"); else if (ahead == 1) asm volatile("s_waitcnt vmcnt(4)" ::: "memory"); else asm volatile("s_waitcnt vmcnt(0)" ::: "memory");
            asm volatile("s_waitcnt lgkmcnt(0)\n\ts_barrier" ::: "memory");
            if (blk + 3 < nkb && !pr_nodma) IDX_DMA(blk + 3);
            const LAS unsigned char* kbuf = F.lds + ((blk & 3) << 15) + kq * 128;
            if (!pr_nocomp)
#pragma unroll
            for (int hb = 0; hb < 2; ++hb) {
                f32x4 acc[8];
#pragma unroll
                for (int j = 0; j < 8; ++j) { const bf16x8 b0 = *(const LAS bf16x8*)(kbuf + (hb * 8 + j) * 2048 + sw0); acc[j] = __builtin_amdgcn_mfma_f32_16x16x32_bf16(af[0], b0, (f32x4){0.f, 0.f, 0.f, 0.f}, 0, 0, 0); }
#pragma unroll
                for (int j = 0; j < 8; ++j) { const bf16x8 b1 = *(const LAS bf16x8*)(kbuf + (hb * 8 + j) * 2048 + sw1); acc[j] = __builtin_amdgcn_mfma_f32_16x16x32_bf16(af[1], b1, acc[j], 0, 0, 0); }
#pragma unroll
                for (int jj = 0; jj < 4; ++jj) { float pe[2];
#pragma unroll
                    for (int h2 = 0; h2 < 2; ++h2) { const f32x4 ac = acc[2 * jj + h2];
                        float p = wv[0] * __builtin_amdgcn_fmed3f(ac[0], 0.f, INFINITY) + wv[1] * __builtin_amdgcn_fmed3f(ac[1], 0.f, INFINITY) + wv[2] * __builtin_amdgcn_fmed3f(ac[2], 0.f, INFINITY) + wv[3] * __builtin_amdgcn_fmed3f(ac[3], 0.f, INFINITY);
                        { auto rr = __builtin_amdgcn_permlane16_swap(__float_as_uint(p), __float_as_uint(p), false, false); p = __uint_as_float(rr[0]) + __uint_as_float(rr[1]); } pe[h2] = p; }
                    const int kt0 = blk * 16 + hb * 8 + 2 * jj; const float s = par ? pe[1] : pe[0];
                    const unsigned vm = (unsigned)-(int)(kt0 < ntile);
                    key[blk * 8 + hb * 4 + jj] = fkey(s) & vm; }
            }
        }
    }
#undef IDX_DMA
    asm volatile("s_waitcnt lgkmcnt(0)\n\ts_barrier" ::: "memory");
    if (a.flags & 4) { SEL[(size_t)(t0 + tl) * 32 + (lane & 31)] = key[0] + key[17] + key[63]; return; }
    const int nblk = (ntile + 15) >> 4;
    unsigned T0 = 0u, T1 = 0u; bool d0 = false, d1 = false;
    for (int bit = 31; bit >= 0; --bit) {
        const unsigned bm = 1u << bit; const unsigned cand = tl ? (T1 | bm) : (T0 | bm); int cnt = 0;
#pragma unroll
        for (int blk = 0; blk < 8; ++blk) if (blk < nblk) {
#pragma unroll
            for (int e = 0; e < 8; ++e) cnt += (key[blk * 8 + e] >= cand) ? 1 : 0; }
        int s0, s1; half_sums(cnt, s0, s1);
        if (!d0 && s0 >= 256) T0 |= bm;
        if (!d1 && s1 >= 256) T1 |= bm;
        d0 = d0 || (s0 == 256); d1 = d1 || (s1 == 256);
        if (d0 && d1) break;
    }
    const unsigned Tk = tl ? T1 : T0; const int l32 = lane & 31; unsigned myw_lo = 0u, myw_hi = 0u;
    if (d0 && d1) {
#pragma unroll
        for (int e = 0; e < 64; ++e) { const unsigned long long sm = __ballot(key[e] >= Tk); const unsigned smh = tl ? (unsigned)(sm >> 32) : (unsigned)sm;
            if (l32 == (e >> 1)) { if (e & 1) myw_hi = smh; else myw_lo = smh; } }
    } else {
        int cg = 0;
#pragma unroll
        for (int e = 0; e < 64; ++e) cg += (key[e] > Tk) ? 1 : 0;
        int g0, g1; half_sums(cg, g0, g1);
        const int need = 256 - (tl ? g1 : g0); int taken = 0;
#pragma unroll
        for (int e = 0; e < 64; ++e) {
            const bool eq = key[e] == Tk; const unsigned long long em = __ballot(eq); const unsigned emh = tl ? (unsigned)(em >> 32) : (unsigned)em;
            const int rank = __builtin_popcount(emh & ((1u << l32) - 1u));
            const bool s = (key[e] > Tk) || (eq && (taken + rank < need)); const unsigned long long sm = __ballot(s); const unsigned smh = tl ? (unsigned)(sm >> 32) : (unsigned)sm;
            taken += __builtin_popcount(emh);
            if (l32 == (e >> 1)) { if (e & 1) myw_hi = smh; else myw_lo = smh; } }
    }
    SEL[(size_t)(t0 + tl) * 32 + l32] = ((unsigned long long)myw_hi << 32) | myw_lo;
}

__device__ __forceinline__ float wave_sum_dpp(float v) {
#define DPPF(x, ctrl, rm, bc) __builtin_bit_cast(float, __builtin_amdgcn_update_dpp(0, __builtin_bit_cast(int, x), ctrl, rm, 0xf, bc))
    v += DPPF(v, 0x111, 0xf, true); v += DPPF(v, 0x112, 0xf, true); v += DPPF(v, 0x114, 0xf, true); v += DPPF(v, 0x118, 0xf, true);
    v += DPPF(v, 0x142, 0xa, false); v += DPPF(v, 0x143, 0xc, false);
#undef DPPF
    return __uint_as_float(__builtin_amdgcn_readlane(__float_as_uint(v), 63));
}
__device__ __forceinline__ void ln_stats_dpp(const f32x4 (&v)[4], float& mean, float& rstd) {
    float s = 0.f;
#pragma unroll
    for (int j = 0; j < 4; ++j) s += (v[j].x + v[j].y) + (v[j].z + v[j].w);
    mean = wave_sum_dpp(s) * (1.f / D); float s2 = 0.f;
#pragma unroll
    for (int j = 0; j < 4; ++j) { const f32x4 d = v[j] - mean; s2 += (d.x * d.x + d.y * d.y) + (d.z * d.z + d.w * d.w); }
    rstd = 1.f / sqrtf(wave_sum_dpp(s2) * (1.f / D) + LN_EPS);
}
__device__ __forceinline__ void router_unit(const Args& a, const Ctx& F, int tb) {
    const float* mod = (const float*)(a.ws + WS_MOD);
    unsigned* ctl = (unsigned*)(a.ws + WS_CTL); unsigned* ER = (unsigned*)(a.ws + WS_TAB + TAB_ER); float* RW = (float*)(a.ws + WS_TAB + TAB_W); unsigned short* LIST = (unsigned short*)(a.ws + WS_TAB + TAB_LIST);
    bf16* XN = (bf16*)(a.ws + WS_XN);
    int tid_ = F.tid; asm volatile("" : "+v"(tid_));
    const int tid = tid_, lane = tid & 63, wid = F.wave; const int t0 = tb * 64, b = t0 >> 11;
    LAS float* U = (LAS float*)F.lds;
    LAS float* Wc = (LAS float*)(F.lds + 65792);
    LAS float* Lg = (LAS float*)F.lds;
    const float* mb = mod + (size_t)b * 6144;
#pragma unroll
    for (int i = 0; i < 8; ++i) __builtin_amdgcn_global_load_lds((const unsigned*)(a.w_router + tid * 4 + 2048 * i), (LAS unsigned*)(Wc + (tid & ~63) * 4 + 2048 * i), 16, 0, 0);
    f32x4 v[8][4];
#pragma unroll
    for (int j = 0; j < 8; ++j) { const GAS f32x4* vr = (const GAS f32x4*)(a.out + (size_t)(t0 + wid * 8 + j) * D) + lane;
#pragma unroll
        for (int jj = 0; jj < 4; ++jj) v[j][jj] = vr[64 * jj]; }
#pragma unroll
    for (int j = 0; j < 8; ++j) { const int m = t0 + wid * 8 + j;
        asm volatile("" ::: "memory");
        float mean, rstd; ln_stats_dpp(v[j], mean, rstd);
        GAS f32x4* xr = (GAS f32x4*)(a.out + (size_t)m * D) + lane;
#pragma unroll
        for (int jj = 0; jj < 4; ++jj) { const f32x4 lg = *(const f32x4*)(a.ln1_g + 4 * lane + 256 * jj), lb = *(const f32x4*)(a.ln1_b + 4 * lane + 256 * jj); v[j][jj] = (v[j][jj] - mean) * rstd * lg + lb; xr[64 * jj] = v[j][jj]; }
        ln_stats_dpp(v[j], mean, rstd);
        GAS unsigned long long* o8 = (GAS unsigned long long*)(XN + (size_t)m * D) + lane;
#pragma unroll
        for (int jj = 0; jj < 4; ++jj) { const f32x4 sc = *(const f32x4*)(mb + 4096 + 4 * lane + 256 * jj), sh = *(const f32x4*)(mb + 3072 + 4 * lane + 256 * jj);
            v[j][jj] = (v[j][jj] - mean) * rstd * (sc + 1.0f) + sh;
            o8[64 * jj] = (unsigned long long)pk2(v[j][jj].x, v[j][jj].y) | ((unsigned long long)pk2(v[j][jj].z, v[j][jj].w) << 32); }
    }
    if (a.flags & 32) { LDS_WAIT(); __syncthreads(); return; }
    const int rh = wid & 1, eh = (wid >> 1) & 1, kh = wid >> 2, r32 = lane & 31, kk = lane >> 5;
    f32x16 acc = f32x16{};
#pragma unroll
    for (int j = 0; j < 8; ++j) { LAS float* d = U + (wid * 8 + j) * 257 + 4 * lane; d[0] = v[j][0].x; d[1] = v[j][0].y; d[2] = v[j][0].z; d[3] = v[j][0].w; }
    LDS_WAIT(); __syncthreads();
#pragma unroll
    for (int qd = 0; qd < 4; ++qd) {
        f32x4 wreg[8];
        if (qd < 3) {
#pragma unroll
            for (int i = 0; i < 8; ++i) wreg[i] = *(const f32x4*)(a.w_router + (size_t)(qd + 1) * 256 * 64 + tid * 4 + 2048 * i); }
#pragma unroll 8
        for (int s = 0; s < 64; ++s) { const int k = kh * 128 + 2 * s + kk;
            acc = __builtin_amdgcn_mfma_f32_32x32x2f32(U[(rh * 32 + r32) * 257 + k], Wc[k * 64 + eh * 32 + r32], acc, 0, 0, 0); }
        if (qd < 3) {
            LDS_WAIT(); __syncthreads();
#pragma unroll
            for (int j = 0; j < 8; ++j) { LAS float* d = U + (wid * 8 + j) * 257 + 4 * lane; d[0] = v[j][qd + 1].x; d[1] = v[j][qd + 1].y; d[2] = v[j][qd + 1].z; d[3] = v[j][qd + 1].w; }
#pragma unroll
            for (int i = 0; i < 8; ++i) *(LAS f32x4*)(Wc + tid * 4 + 2048 * i) = wreg[i];
            LDS_WAIT(); __syncthreads(); }
    }
    LDS_WAIT(); __syncthreads();
#pragma unroll
    for (int i = 0; i < 16; ++i) { const int row = (i & 3) + 8 * (i >> 2) + 4 * kk; Lg[(kh * 64 + rh * 32 + row) * 65 + eh * 32 + r32] = acc[i]; }
    LDS_WAIT(); __syncthreads();
    if (a.flags & 64) { LDS_WAIT(); __syncthreads(); return; }
    const float rbias = a.router_bias[lane]; const int e = lane, g = e >> 3;
    bool selv[8]; int rkv[8]; float wgt[8];
#define DPPMX(x, ctrl, rm) __builtin_fmaxf(x, __builtin_bit_cast(float, __builtin_amdgcn_update_dpp(__builtin_bit_cast(int, -INFINITY), __builtin_bit_cast(int, x), ctrl, rm, 0xf, false)))
#define GROUP8_MAX(x) do { x = DPPMX(x, 0xB1, 0xf); x = DPPMX(x, 0x4E, 0xf); x = DPPMX(x, 0x141, 0xf); } while (0)
#define WAVE_MAX(x) do { x = DPPMX(x, 0x111, 0xf); x = DPPMX(x, 0x112, 0xf); x = DPPMX(x, 0x114, 0xf); x = DPPMX(x, 0x118, 0xf); x = DPPMX(x, 0x142, 0xa); x = DPPMX(x, 0x143, 0xc); \
        x = __uint_as_float(__builtin_amdgcn_readlane(__float_as_uint(x), 63)); } while (0)
#pragma unroll
    for (int j = 0; j < 8; ++j) { const int tl = wid * 8 + j;
        const float logit = Lg[tl * 65 + e] + Lg[(64 + tl) * 65 + e];
        const float aff = 1.0f / (1.0f + __expf(-logit)); const float bsd = aff + rbias;
        float m1 = bsd; GROUP8_MAX(m1);
        const unsigned long long em = __ballot(bsd == m1); const unsigned gm = (unsigned)(em >> (8 * g)) & 0xffu; const int first = 8 * g + __builtin_ctz(gm);
        float m2 = (e == first) ? -INFINITY : bsd; GROUP8_MAX(m2);
        float gs = m1 + m2;
        bool gsel = false;
#pragma unroll
        for (int r = 0; r < 4; ++r) { float mx = gs; WAVE_MAX(mx); const unsigned long long bm = __ballot(gs == mx); const int fl = __builtin_ctzll(bm); const bool win = (g == (fl >> 3)); gsel = gsel || win; gs = win ? -INFINITY : gs; }
        float mv = gsel ? bsd : -INFINITY; bool sel = false; int rk = 0;
#pragma unroll
        for (int r = 0; r < 8; ++r) { float mx = mv; WAVE_MAX(mx); const unsigned long long bm = __ballot(mv == mx); const int fl = __builtin_ctzll(bm); const bool win = (e == fl); sel = sel || win; rk = win ? r : rk; mv = win ? -INFINITY : mv; }
        const float sa = wave_sum_dpp(sel ? aff : 0.f);
        selv[j] = sel; rkv[j] = rk; wgt[j] = aff / sa; }
#undef DPPMX
#undef GROUP8_MAX
#undef WAVE_MAX
    LAS unsigned* cw = (LAS unsigned*)(F.lds + 40000);
    unsigned mycnt = 0u;
#pragma unroll
    for (int j = 0; j < 8; ++j) mycnt += selv[j] ? 1u : 0u;
    cw[wid * 64 + e] = mycnt;
    LDS_WAIT(); __syncthreads();
    const int chunk = t0 / CHTOK;
    if (wid == 0) { unsigned tot = 0u;
#pragma unroll
        for (int w = 0; w < 8; ++w) tot += cw[w * 64 + e];
        unsigned base = 0u; if (tot) base = __hip_atomic_fetch_add(ctl + CW_CNT + (chunk * 64 + e) * CNT_STRIDE, tot, RLX_AGENT);
        cw[512 + e] = base; }
    LDS_WAIT(); __syncthreads();
    unsigned rbase = cw[512 + e];
#pragma unroll
    for (int w = 0; w < 8; ++w) rbase += (w < wid) ? cw[w * 64 + e] : 0u;
#pragma unroll
    for (int j = 0; j < 8; ++j) { const int t = t0 + wid * 8 + j, tk = t - chunk * CHTOK;
        if (selv[j]) { ER[(size_t)t * 8 + rkv[j]] = ((unsigned)e << 16) | rbase; RW[(size_t)t * 8 + rkv[j]] = wgt[j];
            LIST[((size_t)chunk * 64 + e) * 8192 + rbase] = (unsigned short)((tk << 3) | rkv[j]); ++rbase; } }
    LDS_WAIT(); __syncthreads();
}

__device__ __forceinline__ void combine_rows(const Args& a, const Ctx& F, int chunk, const LAS int* xt) {
    const int gw = F.vcu * NWAVES + F.wave, NGW = F.G * NWAVES; const float* mod = (const float*)(a.ws + WS_MOD); const bf16* Y = (const bf16*)(a.ws + WS_YEXP);
    const unsigned* ER = (const unsigned*)(a.ws + WS_TAB + TAB_ER);
    for (int m = chunk * CHTOK + gw; m < (chunk + 1) * CHTOK; m += NGW) {
        GAS f32x4* zr = (GAS f32x4*)(a.out + (size_t)m * D) + F.lane; const float* g2 = mod + (size_t)(m >> 11) * 6144 + 5120;
        f32x4 y[4];
#pragma unroll
        for (int j = 0; j < 4; ++j) y[j] = (f32x4){0.f, 0.f, 0.f, 0.f};
#pragma unroll
        for (int s = 0; s < 8; ++s) { const unsigned er = ER[(size_t)m * 8 + s]; const int pos = xt[144 + (int)(er >> 16)] + (int)(er & 0xffffu);
            const v2u* yr = (const v2u*)(Y + (size_t)pos * 1024) + F.lane;
#pragma unroll
            for (int j = 0; j < 4; ++j) { const v2u w = yr[64 * j]; y[j].x += bflo(w.x); y[j].y += bfhi(w.x); y[j].z += bflo(w.y); y[j].w += bfhi(w.y); } }
        f32x4 v[4];
#pragma unroll
        for (int j = 0; j < 4; ++j) { const f32x4 g = *(const f32x4*)(g2 + 4 * F.lane + 256 * j); v[j] = zr[64 * j] + g * y[j]; }
        float mean, rstd; ln_stats(v, mean, rstd);
#pragma unroll
        for (int j = 0; j < 4; ++j) { const f32x4 lg = *(const f32x4*)(a.ln2_g + 4 * F.lane + 256 * j), lb = *(const f32x4*)(a.ln2_b + 4 * F.lane + 256 * j);
            zr[64 * j] = (v[j] - mean) * rstd * lg + lb; }
    }
}
#ifndef MK_N_LAUNCHES
#define MK_N_LAUNCHES 1
#endif
__global__ void __launch_bounds__(NWAVES * 64, 2) mk_fwd(Args a) {
    extern __shared__ __attribute__((aligned(16))) unsigned char lds[];
    Ctx F; F.lds = (LAS unsigned char*)lds; F.tid = threadIdx.x; F.lane = F.tid & 63; F.wave = __builtin_amdgcn_readfirstlane(F.tid >> 6);
    F.G = gridDim.x; { const int bx = blockIdx.x; F.vcu = (F.G % 8 == 0) ? (bx % 8) * (F.G / 8) + bx / 8 : bx; }
    volatile LAS unsigned* MISC = (volatile LAS unsigned*)(F.lds + MISC_OFF);
    LAS int* xt = (LAS int*)(F.lds + XTAB_OFF);
    unsigned char* ws = a.ws; unsigned* ctl = (unsigned*)(ws + WS_CTL);
    for (int u = F.tid; u < (LDS_BYTES - LDSCTL_OFF) / 4; u += NWAVES * 64) ((LAS unsigned*)(F.lds + LDSCTL_OFF))[u] = 0u;
    __syncthreads();
    const int lo = a.ph_lo, hi = a.ph_hi;
    XcdBarrier bar; bar.bar = ctl + CW_BAR; bar.x = 0; bar.st = nullptr;
    if (hi - lo > 1) bar = xcd_barrier_post(ctl + CW_BAR, MISC + 8);
#ifndef PHM
#define PHM 0xffff
#endif
#define IN(k) (((PHM >> (k)) & 1) && lo <= (k) && (k) < hi)
#define SEAM(k) do { if (IN(k) && IN((k) + 1)) xcd_barrier(bar); { int t_ = threadIdx.x; asm volatile("" : "+v"(t_)); F.tid = t_; F.lane = t_ & 63; F.wave = __builtin_amdgcn_readfirstlane(t_ >> 6); } } while (0)
    const float* mod = (const float*)(ws + WS_MOD);
    bf16* XN = (bf16*)(ws + WS_XN);

    if (IN(0)) { p0_prologue(a, F); } SEAM(0);
    if (IN(1)) { p1_ln_mod(a, F); } SEAM(1);
    if (IN(2)) {
        pg8::Gemm g{XN, 1024, 1 << 30, 0u}; pg8::DenseOrder S; S.init(T, DINP, 1024, ws + WS_WIN, F.G, (int)blockIdx.x);
        EpiInProj E{ws, (bf16*)a.out, (const float*)(ws + WS_ROPE), (const float*)(ws + WS_ROPE) + (size_t)T * 8, a.ikn_g, a.ikn_b};
        pg8::gemm_phase<EpiInProj, pg8::DenseOrder, true>(F.lds + RING_OFF, g, S, E);
    } SEAM(2);
    if (IN(3)) {
        if (!(a.flags & 1)) for (int uix = F.vcu; uix < 1024; uix += F.G) { const int r = uix >> 8, w = uix & 255, b = w >> 5, i = w & 31; idx_unit(a, F, b, r < 2 ? i : 31 - i, r); }
        __syncthreads();
        if (!(a.flags & 2)) for (int uix = F.vcu; uix < 512; uix += F.G) { const int r = uix >> 8, w = uix & 255, bh = w >> 2, s = w & 3; const int qb = s == 0 ? (r ? 2 : 0) : s == 1 ? (r ? 3 : 1) : s == 2 ? (r ? 5 : 4) : (r ? 7 : 6);
            attn_body::attn_unit<0, 8>(bh >> 3, bh & 7, qb, (const attn_body::bf16*)(ws + WS_QA), (const attn_body::bf16*)(ws + WS_KA), (const attn_body::bf16*)(ws + WS_VA), (attn_body::bf16*)(ws + WS_QA), a.rel_bias, (char*)lds + RING_OFF); }
    } SEAM(3);
    if (IN(4)) {
        for (int uix = F.vcu; uix < 512; uix += F.G) { const int r = uix >> 8, w = uix & 255, bh = w >> 2, s = w & 3; const int qb = r ? 7 - s : s;
            attn_body::attn_unit<1, 8>(bh >> 3, bh & 7, qb, (const attn_body::bf16*)(ws + WS_QB), (const attn_body::bf16*)(ws + WS_KB), (const attn_body::bf16*)(ws + WS_VB), (attn_body::bf16*)(ws + WS_QB), ws + WS_SEL, (char*)lds + RING_OFF); }
    } SEAM(4);
    if (IN(5)) {
        pg8::Gemm g{(const bf16*)(ws + WS_QA), 1024, 8, (unsigned)((WS_QB - WS_QA) - 512 * 2)}; pg8::DenseOrder S; S.init(T, 1024, 1024, ws + WS_WA, F.G, (int)blockIdx.x); S.arow = 512 * 2;
        EpiGateM E{(const bf16*)a.out, (bf16*)(ws + WS_MERGED)}; pg8::gemm_phase<EpiGateM, pg8::DenseOrder, true>(F.lds + RING_OFF, g, S, E);
    } SEAM(5);
    if (IN(6)) {
        pg8::Gemm g{(const bf16*)(ws + WS_MERGED), 1024, 1 << 30, 0u}; pg8::DenseOrder S; S.init(T, 1024, 1024, ws + WS_WOUT, F.G, (int)blockIdx.x);
        EpiResid E{a.x, a.out, mod}; pg8::gemm_phase<EpiResid, pg8::DenseOrder, true>(F.lds + RING_OFF, g, S, E);
    } SEAM(6);
    if (IN(7)) {
        for (int tb = F.vcu; tb < T / 64; tb += F.G) router_unit(a, F, tb);
    } SEAM(7);
#pragma unroll 1
    for (int ch = 0; ch < NCHUNK; ++ch) {
        const int pgu = 8 + 2 * ch, pd = 9 + 2 * ch;
        if (IN(pgu)) {
            if (ch > 0) { build_xtab(xt, ctl, ch - 1); combine_rows(a, F, ch - 1, xt); __syncthreads(); }
            build_xtab(xt, ctl, ch);
            { pg8::Gemm g{XN, 1024, 1 << 30, 0u}; ExpertOrder<0> S{xt, 2, F.G, F.vcu, __builtin_amdgcn_readfirstlane(xt[64]), ch, (const unsigned short*)(ws + WS_TAB + TAB_LIST) + (size_t)ch * 64 * 8192, (const char*)(ws + WS_EGU), (size_t)512 * 1024 * 2, (size_t)256 * 1024 * 2};
              EpiExpGU E{(bf16*)(ws + WS_HEXP), xt, (const unsigned short*)(ws + WS_TAB + TAB_LIST) + (size_t)ch * 64 * 8192, (const float*)(ws + WS_TAB + TAB_W), ch};
              pg8::gemm_phase<EpiExpGU, ExpertOrder<0>, true>(F.lds + RING_OFF, g, S, E); }
            if (ch == 0) { VM_WAIT(); __syncthreads();
              pg8::Gemm g{XN, 1024, 1 << 30, 0u}; pg8::DenseOrder S; S.init(T, 512, 1024, ws + WS_SHGU, F.G, F.G - 1 - F.vcu);
              EpiSilu E{(bf16*)(ws + WS_HSH)}; pg8::gemm_phase<EpiSilu, pg8::DenseOrder, true>(F.lds + RING_OFF, g, S, E); }
        } SEAM(pgu);
        if (IN(pd)) {
            build_xtab(xt, ctl, ch);
            { pg8::Gemm g{(const bf16*)(ws + WS_HEXP), 256, 1 << 30, 0u}; ExpertOrder<1> S{xt, 4, F.G, F.vcu, __builtin_amdgcn_readfirstlane(xt[64]), ch, nullptr, (const char*)(ws + WS_ED), (size_t)1024 * 256 * 2, (size_t)256 * 256 * 2};
              EpiExpD E{(bf16*)(ws + WS_YEXP), xt}; pg8::gemm_phase<EpiExpD, ExpertOrder<1>, true>(F.lds + RING_OFF, g, S, E); }
            if (ch == 0) { VM_WAIT(); __syncthreads();
              pg8::Gemm g{(const bf16*)(ws + WS_HSH), 256, 1 << 30, 0u}; pg8::DenseOrder S; S.init(T, 1024, 256, ws + WS_SHD, F.G, F.G - 1 - F.vcu);
              EpiShD E{a.out, mod}; pg8::gemm_phase<EpiShD, pg8::DenseOrder, true>(F.lds + RING_OFF, g, S, E); }
        } SEAM(pd);
    }
    if (IN(12)) { build_xtab(xt, ctl, NCHUNK - 1); combine_rows(a, F, NCHUNK - 1, xt); }
#undef IN
#undef SEAM
}
extern "C" void kernel_launch(void* const* d_in, const int* in_sizes, int n_in, void* d_out, int out_size, void* d_ws, size_t ws_size, hipStream_t stream) {
    static int grid = 0;
    if (grid == 0) {
        if (n_in != 24 || in_sizes[0] != T * D || out_size != T * D || ws_size < WS_END) { fprintf(stderr, "kernel_launch: unexpected shapes (n_in %d, in0 %d, out %d, ws %zu, need %zu); nothing launched\n", n_in, n_in > 0 ? in_sizes[0] : -1, out_size, ws_size, (size_t)WS_END); grid = -1; return; }
        int dev = 0, cus = 0, per_cu = 0;
        if (hipGetDevice(&dev) != hipSuccess || hipDeviceGetAttribute(&cus, hipDeviceAttributeMultiprocessorCount, dev) != hipSuccess) { grid = -1; return; }
        if (hipFuncSetAttribute((const void*)mk_fwd, hipFuncAttributeMaxDynamicSharedMemorySize, LDS_BYTES) != hipSuccess) { fprintf(stderr, "kernel_launch: hipFuncSetAttribute failed\n"); grid = -1; return; }
        if (hipOccupancyMaxActiveBlocksPerMultiprocessor(&per_cu, (const void*)mk_fwd, NWAVES * 64, LDS_BYTES) != hipSuccess || per_cu < 1) { fprintf(stderr, "kernel_launch: occupancy query reports %d\n", per_cu); per_cu = 1; }
        (void)hipGetLastError();
        grid = cus * 1;
        if (grid != 256) fprintf(stderr, "kernel_launch: %d CUs; this kernel is built for 256\n", grid);
    }
    if (grid < 0) return;
    (void)hipMemsetAsync((char*)d_ws + WS_CTL, 0, CTL_ZERO_BYTES, stream);
    Args a{};
    a.x = (const float*)d_in[0]; a.c = (const float*)d_in[1]; a.positions = (const int*)d_in[2]; a.w_ada = (const float*)d_in[3]; a.b_ada = (const float*)d_in[4]; a.w_in = (const float*)d_in[5];
    a.rel_bias = (const float*)d_in[6]; a.ikn_g = (const float*)d_in[7]; a.ikn_b = (const float*)d_in[8]; a.w_branch_a = (const float*)d_in[9]; a.w_branch_b = (const float*)d_in[10]; a.w_out = (const float*)d_in[11];
    a.ln1_g = (const float*)d_in[12]; a.ln1_b = (const float*)d_in[13]; a.w_router = (const float*)d_in[14]; a.router_bias = (const float*)d_in[15]; a.w_exp_gate = (const float*)d_in[16]; a.w_exp_up = (const float*)d_in[17];
    a.w_exp_down = (const float*)d_in[18]; a.w_sh_gate = (const float*)d_in[19]; a.w_sh_up = (const float*)d_in[20]; a.w_sh_down = (const float*)d_in[21]; a.ln2_g = (const float*)d_in[22]; a.ln2_b = (const float*)d_in[23];
    a.out = (float*)d_out; a.ws = (unsigned char*)d_ws;
    for (int j = 0; j < 8; ++j) { const float inv = (float)std::pow(500000.0, -(double)(2 * j) / 16.0); a.inv_freq_rev[j] = (double)inv / 6.283185307179586476925286766559; }
    auto run = [&](int lo, int hi, int flags) { a.ph_lo = lo; a.ph_hi = hi; a.li = 0; a.flags = flags; hipLaunchKernelGGL(mk_fwd, dim3(grid), dim3(NWAVES * 64), LDS_BYTES, stream, a); };
#if defined(PROBE_K)
#ifndef PROBE_FLAGS
#define PROBE_FLAGS 0
#endif
    run(0, PROBE_K + 1, PROBE_FLAGS);
    (void)hipMemsetAsync((char*)d_ws + WS_CTL, 0, CTL_ZERO_BYTES, stream);
    run(0, NPHASE, 0);
#elif MK_NAIVE_MASK == 0 && MK_N_LAUNCHES == 1
    run(0, NPHASE, 0);
#elif MK_NAIVE_MASK == 0
    for (int k = 0; k < NPHASE; ++k) run(k, k + 1, 0);
#else
    constexpr int mask = MK_NAIVE_MASK;
    a.flags = 0;
    run(0, 1, 0); run(1, 2, 0);
    if (mask & 1) hipLaunchKernelGGL(nv_inproj, dim3(12, T), dim3(256), 0, stream, a); else run(2, 3, 0);
    run(3, 4, 0);
    run(4, 5, ((mask & 2) ? 1 : 0) | ((mask & 4) ? 2 : 0));
    if (mask & 2) hipLaunchKernelGGL(nv_index, dim3(T), dim3(256), 0, stream, a);
    if (mask & 4) { hipLaunchKernelGGL(nv_attn<0>, dim3(T * 8 / 4), dim3(256), 0, stream, a); hipLaunchKernelGGL(nv_copy_o, dim3(T * 512 * 2 / 16 / 256), dim3(256), 0, stream, a, 0); }
    if (mask & 8) { hipLaunchKernelGGL(nv_attn<1>, dim3(T * 8 / 4), dim3(256), 0, stream, a); hipLaunchKernelGGL(nv_copy_o, dim3(T * 512 * 2 / 16 / 256), dim3(256), 0, stream, a, 1); } else run(5, 6, 0);
    if (mask & 16) hipLaunchKernelGGL(nv_merge, dim3(2, T), dim3(256), 0, stream, a); else run(6, 7, 0);
    if (mask & 32) { hipLaunchKernelGGL(nv_outproj, dim3(2, T), dim3(256), 0, stream, a); hipLaunchKernelGGL(nv_ln1, dim3(T / 4), dim3(256), 0, stream, a); } else { run(7, 8, 0); run(8, 9, 0); }
    run(9, 10, 0);
    if (mask & 64) hipLaunchKernelGGL(nv_shgu, dim3(1, T), dim3(256), 0, stream, a);
    if (mask & 128) { hipLaunchKernelGGL(nv_expgu, dim3(T * 8), dim3(256), 0, stream, a); hipLaunchKernelGGL(nv_down, dim3(4, T), dim3(256), 0, stream, a); hipLaunchKernelGGL(nv_ln2, dim3(T / 4), dim3(256), 0, stream, a); }
    else { for (int k = 10; k < NPHASE; ++k) run(k, k + 1, 0); }
#endif
}
```
